# Optimizing an MI355X kernel written in HIP

```python
import math
import jax, jax.numpy as jnp
from jax import lax
import numpy as np

D_MODEL = 2048
BATCH = 4
SEQ = 2048
DEPTH = 4

D_MIX = D_MODEL
ATT_WIDTH = D_MIX // 2
CONV_WIDTH = D_MIX // 4
RNN_WIDTH = D_MIX // 4
ATT_HEADS = 4
ATT_HEAD_DIM = ATT_WIDTH // (2 * ATT_HEADS)
ROPE_THETA = 10000.0
Q_BLOCK = 128
CONV_KERNEL = 31
RNN_CONV = 4
RNN_BLOCKS = 4
RNN_BLOCK_DIM = RNN_WIDTH // RNN_BLOCKS
RG_C = 8.0

Q_OFF = 0
K_OFF = Q_OFF + ATT_WIDTH
V_OFF = K_OFF + ATT_WIDTH
CONV_OFF = V_OFF + ATT_WIDTH
RNN_X_OFF = CONV_OFF + 2 * CONV_WIDTH
RNN_G_OFF = RNN_X_OFF + RNN_WIDTH
D_IN = RNN_G_OFF + RNN_WIDTH

N_EXPERTS = 16
N_GROUPS = 4
EXPERTS_PER_GROUP = N_EXPERTS // N_GROUPS
TOP_K = 2
D_EXPERT = D_MODEL // 2

ALPHA = (2 * DEPTH) ** 0.25
BETA = (8 * DEPTH) ** -0.25
EPS = 1e-5

kernel_name = "hybrid_diffattn_conformer_rglru_moe"


def layer_norm(x, g, b):
    xf = x.astype(jnp.float32)
    mu = jnp.mean(xf, axis=-1, keepdims=True)
    var = jnp.mean(jnp.square(xf - mu), axis=-1, keepdims=True)
    y = (xf - mu) * lax.rsqrt(var + EPS) * g.astype(jnp.float32) + b.astype(jnp.float32)
    return y.astype(x.dtype)


def rms_norm(x, g):
    xf = x.astype(jnp.float32)
    y = xf * lax.rsqrt(jnp.mean(jnp.square(xf), axis=-1, keepdims=True) + EPS) * g.astype(jnp.float32)
    return y.astype(x.dtype)


def rope_tables(seq_len):
    pos = jnp.arange(seq_len, dtype=jnp.float32)
    inv_freq = ROPE_THETA ** (-jnp.arange(0, ATT_HEAD_DIM, 2, dtype=jnp.float32) / ATT_HEAD_DIM)
    ang = pos[:, None] * inv_freq[None, :]
    return jnp.cos(ang), jnp.sin(ang)


def apply_rope(t, cos, sin):
    c = cos[None, :, None, None, :]
    s = sin[None, :, None, None, :]
    tf = t.astype(jnp.float32)
    t1, t2 = jnp.split(tf, 2, axis=-1)
    out = jnp.concatenate([t1 * c - t2 * s, t2 * c + t1 * s], axis=-1)
    return out.astype(t.dtype)


def diff_attention(q, k, v, lam):
    B, S = q.shape[0], q.shape[1]
    n_blocks = S // Q_BLOCK
    scale = ATT_HEAD_DIM ** -0.5
    k_pos = jnp.arange(S)

    def block(i):
        start = i * Q_BLOCK
        qb = lax.dynamic_slice_in_dim(q, start, Q_BLOCK, axis=1)
        s = jnp.einsum('bqhcd,bkhcd->bhcqk', qb, k).astype(jnp.float32) * scale
        q_pos = start + jnp.arange(Q_BLOCK)
        mask = k_pos[None, :] <= q_pos[:, None]
        p = jax.nn.softmax(jnp.where(mask, s, -jnp.inf), axis=-1)
        a = p[:, :, 0] - lam * p[:, :, 1]
        return jnp.einsum('bhqk,bkhe->bqhe', a.astype(v.dtype), v)

    o = lax.map(block, jnp.arange(n_blocks))
    return jnp.moveaxis(o, 0, 1).reshape(B, S, ATT_HEADS, 2 * ATT_HEAD_DIM)


def causal_depthwise_conv(x, w):
    kw, c = w.shape
    return lax.conv_general_dilated(
        x, w[:, None, :].astype(x.dtype), window_strides=(1,), padding=[(kw - 1, 0)],
        dimension_numbers=('NWC', 'WIO', 'NWC'), feature_group_count=c)


def conformer_conv(u, dw, ln_g, ln_b, pw):
    g = u[..., :CONV_WIDTH] * jax.nn.sigmoid(u[..., CONV_WIDTH:])
    g = causal_depthwise_conv(g, dw)
    g = jax.nn.silu(layer_norm(g, ln_g, ln_b))
    return g @ pw


def _linear_combine(c1, c2):
    a1, b1 = c1
    a2, b2 = c2
    return a1 * a2, a2 * b1 + b2


def rglru_block(xr, gate, conv_w, conv_b, wa, ba, wx, bx, lam):
    B, S, _ = xr.shape
    xc = causal_depthwise_conv(xr, conv_w) + conv_b
    xb = xc.reshape(B, S, RNN_BLOCKS, RNN_BLOCK_DIM)
    r = jax.nn.sigmoid(jnp.einsum('bsni,nij->bsnj', xb, wa).reshape(B, S, RNN_WIDTH) + ba)
    i = jax.nn.sigmoid(jnp.einsum('bsni,nij->bsnj', xb, wx).reshape(B, S, RNN_WIDTH) + bx)
    log_a = -RG_C * r.astype(jnp.float32) * jax.nn.softplus(-lam.astype(jnp.float32))
    a = jnp.exp(log_a)
    b = jnp.sqrt(-jnp.expm1(2.0 * log_a)) * (i * xc).astype(jnp.float32)
    _, h = lax.associative_scan(_linear_combine, (a, b), axis=1)
    return h.astype(xr.dtype) * jax.nn.gelu(gate)


def grouped_moe(x, router_w, router_b, wg, wu, wd):
    B, S, D = x.shape
    xt = x.reshape(B * S, D)
    scores = jax.nn.sigmoid((xt @ router_w).astype(jnp.float32))
    biased = scores + router_b.astype(jnp.float32)
    grp = biased.reshape(-1, N_GROUPS, EXPERTS_PER_GROUP)
    group_score = jnp.sum(lax.top_k(grp, 2)[0], axis=-1)
    sel_group = jnp.argmax(group_score, axis=-1)
    in_group = (jnp.arange(N_EXPERTS) // EXPERTS_PER_GROUP)[None, :] == sel_group[:, None]
    _, idx = lax.top_k(jnp.where(in_group, biased, -jnp.inf), TOP_K)
    w_sel = jnp.take_along_axis(scores, idx, axis=1)
    w_sel = w_sel / jnp.sum(w_sel, axis=-1, keepdims=True)
    combine = jnp.einsum('nk,nke->ne', w_sel, jax.nn.one_hot(idx, N_EXPERTS, dtype=jnp.float32))
    combine = combine.astype(x.dtype)
    y = jnp.zeros_like(xt)
    for e in range(N_EXPERTS):
        h = jax.nn.silu(xt @ wg[e]) * (xt @ wu[e])
        y = y + combine[:, e:e + 1] * (h @ wd[e])
    return y.reshape(B, S, D)


def hybrid_mixer(h, layer, w_in, lq1, lk1, lq2, lk2, subln_g, conv_dw, conv_ln_g, conv_ln_b,
                 conv_pw, rg_conv_w, rg_conv_b, rg_wa, rg_ba, rg_wx, rg_bx, rg_lambda, w_out):
    B, S, _ = h.shape
    z = h @ w_in
    q = z[..., Q_OFF:K_OFF].reshape(B, S, ATT_HEADS, 2, ATT_HEAD_DIM)
    k = z[..., K_OFF:V_OFF].reshape(B, S, ATT_HEADS, 2, ATT_HEAD_DIM)
    v = z[..., V_OFF:CONV_OFF].reshape(B, S, ATT_HEADS, 2 * ATT_HEAD_DIM)
    cos, sin = rope_tables(S)
    q = apply_rope(q, cos, sin)
    k = apply_rope(k, cos, sin)
    lam_init = 0.8 - 0.6 * math.exp(-0.3 * layer)
    lam = (jnp.exp(jnp.sum(lq1.astype(jnp.float32) * lk1.astype(jnp.float32)))
           - jnp.exp(jnp.sum(lq2.astype(jnp.float32) * lk2.astype(jnp.float32))) + lam_init)
    o = diff_attention(q, k, v, lam)
    attn_out = (rms_norm(o, subln_g) * (1.0 - lam_init)).reshape(B, S, ATT_WIDTH)
    conv_out = conformer_conv(z[..., CONV_OFF:RNN_X_OFF], conv_dw, conv_ln_g, conv_ln_b, conv_pw)
    rnn_out = rglru_block(z[..., RNN_X_OFF:RNN_G_OFF], z[..., RNN_G_OFF:D_IN], rg_conv_w, rg_conv_b,
                          rg_wa, rg_ba, rg_wx, rg_bx, rg_lambda)
    cat = jnp.concatenate([attn_out, conv_out, rnn_out], axis=-1)
    return cat @ w_out


def setup_inputs(seed: int = 0) -> dict:
    key = jax.random.key(seed)
    ks = jax.random.split(key, 32)
    f32 = jnp.float32
    nrm = lambda k, shape, s: jax.random.normal(k, shape, f32) * s
    u = jax.random.uniform(ks[17], (DEPTH, RNN_WIDTH), f32, minval=0.9, maxval=0.999)
    a0 = u ** (1.0 / RG_C)
    return {
        "x": nrm(ks[0], (BATCH, SEQ, D_MODEL), 1.0),
        "w_in": nrm(ks[1], (DEPTH, D_MODEL, D_IN), D_MODEL ** -0.5),
        "lam_q1": nrm(ks[2], (DEPTH, ATT_HEAD_DIM), 0.1),
        "lam_k1": nrm(ks[3], (DEPTH, ATT_HEAD_DIM), 0.1),
        "lam_q2": nrm(ks[4], (DEPTH, ATT_HEAD_DIM), 0.1),
        "lam_k2": nrm(ks[5], (DEPTH, ATT_HEAD_DIM), 0.1),
        "subln_g": 1.0 + nrm(ks[6], (DEPTH, 2 * ATT_HEAD_DIM), 0.02),
        "conv_dw": nrm(ks[7], (DEPTH, CONV_KERNEL, CONV_WIDTH), CONV_KERNEL ** -0.5),
        "conv_ln_g": 1.0 + nrm(ks[8], (DEPTH, CONV_WIDTH), 0.02),
        "conv_ln_b": nrm(ks[9], (DEPTH, CONV_WIDTH), 0.02),
        "conv_pw": nrm(ks[10], (DEPTH, CONV_WIDTH, CONV_WIDTH), CONV_WIDTH ** -0.5),
        "rg_conv_w": nrm(ks[11], (DEPTH, RNN_CONV, RNN_WIDTH), RNN_CONV ** -0.5),
        "rg_conv_b": nrm(ks[12], (DEPTH, RNN_WIDTH), 0.02),
        "rg_wa": nrm(ks[13], (DEPTH, RNN_BLOCKS, RNN_BLOCK_DIM, RNN_BLOCK_DIM), RNN_BLOCK_DIM ** -0.5),
        "rg_ba": nrm(ks[14], (DEPTH, RNN_WIDTH), 0.02),
        "rg_wx": nrm(ks[15], (DEPTH, RNN_BLOCKS, RNN_BLOCK_DIM, RNN_BLOCK_DIM), RNN_BLOCK_DIM ** -0.5),
        "rg_bx": nrm(ks[16], (DEPTH, RNN_WIDTH), 0.02),
        "rg_lambda": jnp.log(a0) - jnp.log1p(-a0),
        "w_out": nrm(ks[18], (DEPTH, D_MIX, D_MODEL), D_MIX ** -0.5 * BETA),
        "ln1_g": 1.0 + nrm(ks[19], (DEPTH, D_MODEL), 0.02),
        "ln1_b": nrm(ks[20], (DEPTH, D_MODEL), 0.02),
        "router_w": nrm(ks[21], (D_MODEL, N_EXPERTS), D_MODEL ** -0.5),
        "router_b": nrm(ks[22], (N_EXPERTS,), 0.01),
        "exp_wg": nrm(ks[23], (DEPTH, N_EXPERTS, D_MODEL, D_EXPERT), D_MODEL ** -0.5),
        "exp_wu": nrm(ks[24], (DEPTH, N_EXPERTS, D_MODEL, D_EXPERT), D_MODEL ** -0.5),
        "exp_wd": nrm(ks[25], (DEPTH, N_EXPERTS, D_EXPERT, D_MODEL), D_EXPERT ** -0.5 * BETA),
        "ln2_g": 1.0 + nrm(ks[26], (DEPTH, D_MODEL), 0.02),
        "ln2_b": nrm(ks[27], (DEPTH, D_MODEL), 0.02),
    }


def reference(x, w_in, lam_q1, lam_k1, lam_q2, lam_k2, subln_g, conv_dw, conv_ln_g, conv_ln_b,
              conv_pw, rg_conv_w, rg_conv_b, rg_wa, rg_ba, rg_wx, rg_bx, rg_lambda, w_out,
              ln1_g, ln1_b, router_w, router_b, exp_wg, exp_wu, exp_wd, ln2_g, ln2_b):
    for l in range(DEPTH):
        mix = hybrid_mixer(x, l, w_in[l], lam_q1[l], lam_k1[l], lam_q2[l], lam_k2[l], subln_g[l],
                           conv_dw[l], conv_ln_g[l], conv_ln_b[l], conv_pw[l], rg_conv_w[l],
                           rg_conv_b[l], rg_wa[l], rg_ba[l], rg_wx[l], rg_bx[l], rg_lambda[l], w_out[l])
        x = layer_norm(ALPHA * x + mix, ln1_g[l], ln1_b[l])
        ffn = grouped_moe(x, router_w, router_b, exp_wg[l], exp_wu[l], exp_wd[l])
        x = layer_norm(ALPHA * x + ffn, ln2_g[l], ln2_b[l])
    return x
```

```cpp
#include <hip/hip_runtime.h>
#include <cstdio>
#include <cstdint>

#ifndef N_LAUNCH_MODE
#define N_LAUNCH_MODE 1
#endif

#define GAS __attribute__((address_space(1)))
#define LAS __attribute__((address_space(3)))
typedef unsigned short bf16_t;
typedef short bf16x8 __attribute__((ext_vector_type(8)));
typedef short s16x4 __attribute__((ext_vector_type(4)));
typedef float f32x2 __attribute__((ext_vector_type(2)));
typedef float f32x4 __attribute__((ext_vector_type(4)));
typedef float f32x16 __attribute__((ext_vector_type(16)));
typedef unsigned u32x2 __attribute__((ext_vector_type(2)));
typedef unsigned u32x4 __attribute__((ext_vector_type(4)));
typedef int i32x4 __attribute__((ext_vector_type(4)));
typedef int i32x8 __attribute__((ext_vector_type(8)));

constexpr int DM = 2048, NBATCH = 4, SEQ = 2048, NLAYER = 4, MTOK = NBATCH * SEQ;
constexpr int DIN = 5120, ZK_OFF = 1024, ZV_OFF = 2048, ZC_OFF = 3072, ZRX_OFF = 4096, ZRG_OFF = 4608;
constexpr int CW = 512, RW = 512, NEXP = 16, DEXP = 1024, CK = 31;
constexpr float ALPHA = 1.6817928305074290f;
constexpr float LN_EPS = 1e-5f;
constexpr int NWAVES = 8, NTHREADS = 512;
constexpr int MOE_ROWS = 20480;
constexpr float W1_SCALE = 32.f, W2_SCALE = 64.f, H_SCALE = 4.f, WIN_SCALE = 32.f, WOUT_SCALE = 64.f, CAT_SCALE = 4.f, Y2_SCALE = 16.f;

constexpr size_t MiB = 1u << 20;
constexpr size_t WS_CTL = 0, CTL_ZERO_BYTES = 1 * MiB;
constexpr size_t WS_COS = 1 * MiB;
constexpr size_t WS_SIN = WS_COS + 512 * 1024;
constexpr size_t WS_SP8 = 2 * MiB;
constexpr size_t WS_TOKE = WS_SP8 + 64 * 1024;
constexpr size_t WS_TOKW = WS_TOKE + 64 * 1024;
constexpr size_t WS_TOKS = WS_TOKW + 64 * 1024;
constexpr size_t WS_SLOTW = WS_TOKS + 64 * 1024;
constexpr size_t WS_CNT = WS_SLOTW + 128 * 1024;
constexpr size_t WS_SUMA = 3 * MiB;
constexpr size_t WS_SUMH = WS_SUMA + 512 * 1024;
constexpr size_t WS_WIN = 8 * MiB;
constexpr size_t WS_WOUT = 88 * MiB;
constexpr size_t WS_PW = 120 * MiB;
constexpr size_t WS_WRG = 122 * MiB;
constexpr size_t WS_W1 = 128 * MiB;
constexpr size_t WS_W2 = 640 * MiB;
constexpr size_t WS_XA = 896 * MiB;
constexpr size_t WS_X1 = 960 * MiB;
constexpr size_t WS_XB = 1024 * MiB;
constexpr size_t WS_X1B = 1056 * MiB;
constexpr size_t WS_Z = 1088 * MiB;
constexpr size_t WS_OC = 1168 * MiB;
constexpr size_t WS_SCONV = 1232 * MiB;
constexpr size_t WS_XC = 1240 * MiB;
constexpr size_t WS_SA = 1248 * MiB;
constexpr size_t WS_SB = 1264 * MiB;
constexpr size_t WS_CAT = 1280 * MiB;
constexpr size_t WS_YBUF = 1312 * MiB;
constexpr size_t WS_XG = 1376 * MiB;
constexpr size_t WS_HB = 1456 * MiB;
constexpr size_t WS_Y2 = 1496 * MiB;
constexpr size_t WS_END = 1576 * MiB;
constexpr int CW_TMO = 0, CW_BAR = 4096, CW_FILL = 8192, CW_TICK = 9216;
constexpr int CW_TMO_ = 0;
constexpr size_t WS_LIST = 5 * MiB;
constexpr size_t WS_LISTW = 6 * MiB;
constexpr size_t WS_RWT = 7 * MiB;

constexpr int RING_BYTES = 131072;
constexpr int META_OFF = 132096;
constexpr int MISC_OFF = 132608;
constexpr int LDS_BYTES = 147456;

__device__ __forceinline__ unsigned cvt_pk_bf16(float lo, float hi) { unsigned r; asm volatile("v_cvt_pk_bf16_f32 %0, %1, %2" : "=v"(r) : "v"(lo), "v"(hi)); return r; }
__device__ __forceinline__ unsigned cvt4_fp8(float a, float b, float c, float d) {
    a = __builtin_amdgcn_fmed3f(a, -448.f, 448.f); b = __builtin_amdgcn_fmed3f(b, -448.f, 448.f); c = __builtin_amdgcn_fmed3f(c, -448.f, 448.f); d = __builtin_amdgcn_fmed3f(d, -448.f, 448.f);
    int w = 0; w = __builtin_amdgcn_cvt_pk_fp8_f32(a, b, w, false); w = __builtin_amdgcn_cvt_pk_fp8_f32(c, d, w, true); return (unsigned)w; }
__device__ __forceinline__ float bf2f(unsigned short b) { return __uint_as_float((unsigned)b << 16); }
__device__ __forceinline__ float bflo(unsigned w) { return __uint_as_float(w << 16); }
__device__ __forceinline__ float bfhi(unsigned w) { return __uint_as_float(w & 0xffff0000u); }
__device__ __forceinline__ float wave_sum(float v) {
#define WS_STEP(o) v += __int_as_float(__builtin_amdgcn_ds_swizzle(__float_as_int(v), ((o) << 10) | 0x1f))
    WS_STEP(1); WS_STEP(2); WS_STEP(4); WS_STEP(8); WS_STEP(16);
#undef WS_STEP
    const auto rr = __builtin_amdgcn_permlane32_swap(__float_as_uint(v), __float_as_uint(v), false, false);
    return __uint_as_float(rr[0]) + __uint_as_float(rr[1]);
}
__device__ __forceinline__ float sigmoidf_(float x) { return __builtin_amdgcn_rcpf(1.f + __expf(-x)); }
#define LDS_WAIT() asm volatile("s_waitcnt lgkmcnt(0)" ::: "memory")
constexpr int PTAB_OFF = 132736;
__device__ __forceinline__ const float* ldptr(LAS unsigned char* lds, int k) {
    int off = PTAB_OFF + 8 * k; asm volatile("" : "+s"(off));
    const unsigned long long v = *(volatile LAS unsigned long long*)(lds + off);
    const unsigned lo = __builtin_amdgcn_readfirstlane((unsigned)v), hi = __builtin_amdgcn_readfirstlane((unsigned)(v >> 32));
    return (const float*)(const GAS float*)(((unsigned long long)hi << 32) | lo);
}
template <class T> __device__ __forceinline__ T* opaque_p(T* p) { asm volatile("" : "+s"(p)); return p; }
__device__ __forceinline__ int tidx(int wid) { int l; asm volatile("v_mbcnt_lo_u32_b32 %0, -1, 0\n\tv_mbcnt_hi_u32_b32 %0, -1, %0" : "=v"(l)); return (wid << 6) + l; }
__device__ __forceinline__ int opaque_s(int v) { asm volatile("" : "+s"(v)); return v; }

#define XB_TMO      128
#define XB_XCNT(j)  (256  + 64 * (j))
#define XB_XSUB(j)  (1280 + 64 * (j))
#define XB_XGEN(j)  (2304 + 64 * (j))
#define XB_TOP      3328
#define XB_TOPGEN   3392
#define XCD_BAR_WORDS 3456
#define XB_SPIN_CAP (1u << 18)
__device__ __forceinline__ unsigned xb_ld(unsigned* p)              { return __hip_atomic_load(p, __ATOMIC_RELAXED, __HIP_MEMORY_SCOPE_AGENT); }
__device__ __forceinline__ unsigned xb_add(unsigned* p, unsigned v) { return __hip_atomic_fetch_add(p, v, __ATOMIC_RELAXED, __HIP_MEMORY_SCOPE_AGENT); }
__device__ __forceinline__ unsigned xb_xcc_id() { return (unsigned)__builtin_amdgcn_s_getreg((3 << 11) | 20) & 0xFu; }
#define XB_SPIN(cond, bar) do { unsigned _sp = 0; while (cond) { __builtin_amdgcn_s_sleep(1); \
    if ((++_sp & 255u) == 0u) { if (xb_ld(&(bar)[XB_TMO])) break; if (_sp > XB_SPIN_CAP) { atomicAdd(&(bar)[XB_TMO], 1u); break; } } } } while (0)
struct XcdBarrier { unsigned* bar; unsigned x; volatile LAS unsigned* st; };
__device__ __forceinline__ XcdBarrier xcd_barrier_post(unsigned* bar, volatile LAS unsigned* st) {
    XcdBarrier b; b.bar = bar; b.x = xb_xcc_id(); b.st = st;
    if (threadIdx.x == 0) (void)xb_add(&bar[XB_XCNT(b.x)], 1u);
    return b;
}
__device__ __forceinline__ void xcd_barrier_complete(unsigned* bar, unsigned x, unsigned& nloc, unsigned& nx) {
    const unsigned G = gridDim.x * gridDim.y * gridDim.z;
    asm volatile("" : "+s"(x));
    unsigned sum, cnt, mine, sp = 0u;
    for (;;) {
        sum = 0u; cnt = 0u; mine = 0u;
#pragma unroll
        for (unsigned j = 0; j < 16; ++j) { const unsigned c = xb_ld(&bar[XB_XCNT(j)]); sum += c; cnt += (c > 0u) ? 1u : 0u; mine = (j == x) ? c : mine; }
        if (sum == G) break;
        __builtin_amdgcn_s_sleep(1);
        if ((++sp & 255u) == 0u) { if (xb_ld(&bar[XB_TMO])) break; if (sp > XB_SPIN_CAP) { atomicAdd(&bar[XB_TMO], 1u); break; } }
    }
    nloc = mine > 0u ? mine : 1u; nx = cnt > 0u ? cnt : 1u;
}
__device__ __forceinline__ void xcd_barrier(const XcdBarrier& b, int wid0) {
    asm volatile("s_waitcnt vmcnt(0)" ::: "memory");
    __syncthreads();
    if (tidx(wid0) == 0) {
        unsigned* bar = opaque_p(b.bar);
        __builtin_amdgcn_s_waitcnt(0);
        unsigned nloc = b.st[0], nx = b.st[1];
        if (nloc == 0u) { xcd_barrier_complete(bar, b.x, nloc, nx); b.st[0] = nloc; b.st[1] = nx; }
        const unsigned old = xb_add(&bar[XB_XSUB(b.x)], 1u);
        const unsigned gen = old / nloc;
        if (old + 1u == (gen + 1u) * nloc) {
            __builtin_amdgcn_fence(__ATOMIC_RELEASE, "agent");
            asm volatile("s_waitcnt vmcnt(0)" ::: "memory");
            const unsigned og = xb_add(&bar[XB_TOP], 1u);
            const unsigned tg = og / nx;
            if (og + 1u == (tg + 1u) * nx) xb_add(&bar[XB_TOPGEN], 1u);
            else XB_SPIN(xb_ld(&bar[XB_TOPGEN]) == tg, bar);
            __builtin_amdgcn_fence(__ATOMIC_ACQUIRE, "agent");
            xb_add(&bar[XB_XGEN(b.x)], 1u);
            asm volatile("s_waitcnt vmcnt(0)" ::: "memory");
        } else {
            XB_SPIN(xb_ld(&bar[XB_XGEN(b.x)]) == gen, bar);
            __builtin_amdgcn_fence(__ATOMIC_ACQUIRE, "agent");
            asm volatile("s_waitcnt vmcnt(0)" ::: "memory");
        }
    }
    __syncthreads();
}

namespace pg8 {
constexpr int BM = 256, BK = 64, HALF = 128, HTB = HALF * BK * 2, STAGE_BYTES = 8 * HTB, NXCD = 8, WGM = 8;
__host__ __device__ __forceinline__ int lds_byte(int r, int c) { const int st = (r >> 4) * 2 + (c >> 5), rr = r & 15, cc = c & 31, ob = rr * 64 + cc * 2; return st * 1024 + (ob ^ (((ob >> 9) & 1) << 5)); }
__host__ __device__ __forceinline__ void stage_rc(int b, int& R, int& C) { const int st = b / 1024, sb = b % 1024, swz = sb ^ (((sb >> 9) & 1) << 5); R = (st >> 1) * 16 + swz / 64; C = (st & 1) * 32 + (swz % 64) / 2; }
__host__ __device__ __forceinline__ int perm32(int rho) { const int n = rho >> 4, i = rho & 15; return 8 * (i >> 2) + 4 * n + (i & 3); }

struct Unit { int pm, pn; unsigned aoff, boff; int pb, cnt, lb; };
struct Gemm { const unsigned char* base; unsigned A, Bt; int lda, ldb, K; };

struct GridOrder {
    int nM, nN, nwg, G, c; unsigned atile, btile;
    __device__ void init(int M, int N, int lda, int ldb, int G_, int c_) { nM = M / BM; nN = N / BM; nwg = nM * nN; G = G_; c = c_; atile = (unsigned)BM * lda * 2; btile = (unsigned)BM * ldb * 2; }
    __device__ bool next(int i, Unit& u) const {
        const long L = (long)i * G + c; if (L >= nwg) return false;
        int wgid = (int)L; { const int q = nwg / NXCD, r = nwg % NXCD, xcd = wgid % NXCD, off = wgid / NXCD; wgid = (xcd < r ? xcd * (q + 1) : r * (q + 1) + (xcd - r) * q) + off; }
        const int nig = WGM * nN, gid = wgid / nig, fm = gid * WGM, gsz = (nM - fm) < WGM ? (nM - fm) : WGM;
        u.pm = fm + ((wgid % nig) % gsz); u.pn = (wgid % nig) / gsz; u.aoff = (unsigned)u.pm * atile; u.boff = (unsigned)u.pn * btile; return true;
    }
    static constexpr bool GATHER = false;
    __device__ __forceinline__ unsigned arow(const Unit&, int) const { return 0u; }
    __device__ __forceinline__ void a_ready(const Unit&) const {}
    __device__ __forceinline__ void done(const Unit&) const {}
};

template <class Epi, class Sched, bool ALIGN_EPI, bool F8 = false, int COPY = 0>
__device__ __forceinline__ void gemm_phase(LAS unsigned char* lds, const Gemm g, const Sched& S, const Epi& E, int wid0) {
    const int tid = tidx(wid0), wid = __builtin_amdgcn_readfirstlane(tid >> 6), lane = tid & 63, wr = wid >> 2, wc = wid & 3, fr = lane & 15, fq = lane >> 4;
    const int K = g.K, nt = K / BK;
    unsigned vA0[2], vA1[2], nA0[2], nA1[2], voffB[2]; int Rr[2], Cc[2];
    const unsigned hsA_ = (unsigned)HALF * g.lda * 2;
#pragma unroll
    for (int i = 0; i < 2; ++i) { int R, C; stage_rc(tid * 16 + i * 8192, R, C); const int Rb = Epi::PERM ? ((R & ~31) + perm32(R & 31)) : R;
        Rr[i] = R; Cc[i] = C * 2; vA0[i] = (unsigned)(R * g.lda + C) * 2u; vA1[i] = vA0[i] + hsA_; voffB[i] = (unsigned)(Rb * g.ldb + C) * 2u; }
#define PG8_GATHER(d0, d1, U) do { _Pragma("unroll") for (int _i = 0; _i < 2; ++_i) { d0[_i] = S.arow(U, Rr[_i]) * (unsigned)(g.lda * 2) + (unsigned)Cc[_i]; d1[_i] = S.arow(U, Rr[_i] + HALF) * (unsigned)(g.lda * 2) + (unsigned)Cc[_i]; } } while (0)
    const unsigned kstep = (unsigned)(BK * 2);
    const unsigned hsB = (unsigned)HALF * g.ldb * 2;
    const __amdgpu_buffer_rsrc_t rs = __builtin_amdgcn_make_buffer_rsrc((void*)g.base, (short)0, 0x7fffffff, 0x00020000);
    const unsigned ldsw = (unsigned)wid * 1024u;
    const int aoff = lds_byte(wr * 64 + fr, fq * 8), boff = lds_byte(wc * 32 + fr, fq * 8);
#define PG8_SA(b, h) (((b) * 2 + (h)) * HTB)
#define PG8_SB(b, h) ((4 + (b) * 2 + (h)) * HTB)
#define PG8_STAGE(bufoff, soff, voff) do { _Pragma("unroll") for (int _i = 0; _i < 2; ++_i) \
        __builtin_amdgcn_raw_ptr_buffer_load_lds(rs, (LAS void*)(lds + (bufoff) + ldsw + _i * 8192), 16, (int)(voff)[_i], (int)(soff), 0, 0); } while (0)
#define PG8_LDA(dst, b, h) do { _Pragma("unroll") for (int m = 0; m < 4; ++m) { if constexpr (F8) { \
        dst##8[m].lo = *(const LAS i32x4*)(lds + PG8_SA(b, h) + aoff + m * 2048); dst##8[m].hi = *(const LAS i32x4*)(lds + PG8_SA(b, h) + aoff + m * 2048 + 1024); } else { \
        _Pragma("unroll") for (int k = 0; k < 2; ++k) dst[m][k] = *(const LAS bf16x8*)(lds + PG8_SA(b, h) + aoff + m * 2048 + k * 1024); } } } while (0)
#define PG8_LDB(dst, b, h) do { _Pragma("unroll") for (int n = 0; n < 2; ++n) { if constexpr (F8) { \
        dst##8[n].lo = *(const LAS i32x4*)(lds + PG8_SB(b, h) + boff + n * 2048); dst##8[n].hi = *(const LAS i32x4*)(lds + PG8_SB(b, h) + boff + n * 2048 + 1024); } else { \
        _Pragma("unroll") for (int k = 0; k < 2; ++k) dst[n][k] = *(const LAS bf16x8*)(lds + PG8_SB(b, h) + boff + n * 2048 + k * 1024); } } } while (0)
#define PG8_MMA(ai, bj, At, Bt) do { __builtin_amdgcn_s_setprio(1); _Pragma("unroll") for (int m = 0; m < 4; ++m) _Pragma("unroll") for (int n = 0; n < 2; ++n) _Pragma("unroll") for (int k = 0; k < 2; ++k) \
        acc[ai][bj][m][n] = __builtin_amdgcn_mfma_f32_16x16x32_bf16(Bt[n][k], At[m][k], acc[ai][bj][m][n], 0, 0, 0); __builtin_amdgcn_s_setprio(0); } while (0)
#define PG8_MMA8(ai, bj, At, Bt) do { __builtin_amdgcn_s_setprio(1); _Pragma("unroll") for (int m = 0; m < 4; ++m) _Pragma("unroll") for (int n = 0; n < 2; ++n) \
        asm volatile("v_mfma_f32_16x16x128_f8f6f4 %0, %1, %2, %0" : "+v"(acc[ai][bj][m][n]) : "v"(Bt##8[n]), "v"(At##8[m])); __builtin_amdgcn_s_setprio(0); } while (0)
#define PG8_MM(ai, bj, At, Bt) do { if constexpr (F8) PG8_MMA8(ai, bj, At, Bt); else PG8_MMA(ai, bj, At, Bt); } while (0)
#define PG8_WAIT_V(n) asm volatile("s_waitcnt vmcnt(" #n ")" ::: "memory")
#define PG8_WAIT_L(n) asm volatile("s_waitcnt lgkmcnt(" #n ")" ::: "memory")
#define PG8_BAR __builtin_amdgcn_s_barrier()
#define PG8_SCHED __builtin_amdgcn_sched_barrier(0)
    Unit cur, nxt; int ui = 0;
    if (!S.next(0, cur)) return;
    f32x4 acc[2][2][4][2];
#pragma unroll
    for (int a = 0; a < 2; ++a)
#pragma unroll
        for (int b = 0; b < 2; ++b)
#pragma unroll
            for (int m = 0; m < 4; ++m)
#pragma unroll
                for (int n = 0; n < 2; ++n) acc[a][b][m][n] = (f32x4){0.f, 0.f, 0.f, 0.f};
    bf16x8 At[4][2], B0[2][2], B1[2][2]; i32x8 At8[4], B08[2], B18[2];
    unsigned cA = g.A + cur.aoff, cB = g.Bt + cur.boff;
    S.a_ready(cur);
    if constexpr (Sched::GATHER) PG8_GATHER(vA0, vA1, cur);
    PG8_STAGE(PG8_SB(0, 0), cB, voffB); PG8_STAGE(PG8_SB(0, 1), cB + hsB, voffB); PG8_STAGE(PG8_SA(0, 0), cA, vA0); PG8_STAGE(PG8_SA(0, 1), cA, vA1);
    if (wr == 1) PG8_BAR;
    PG8_WAIT_V(2); PG8_BAR;
    PG8_STAGE(PG8_SB(1, 0), cB + kstep, voffB); PG8_STAGE(PG8_SA(1, 0), cA + kstep, vA0); PG8_STAGE(PG8_SB(1, 1), cB + hsB + kstep, voffB);
    PG8_WAIT_V(6); PG8_BAR;
    for (;;) {
        const bool has_next = S.next(ui + 1, nxt);
        const unsigned nA = has_next ? g.A + nxt.aoff : cA, nB = has_next ? g.Bt + nxt.boff : cB;
        if (Sched::GATHER && has_next) PG8_GATHER(nA0, nA1, nxt);
        else {
#pragma unroll
            for (int _i = 0; _i < 2; ++_i) { nA0[_i] = vA0[_i]; nA1[_i] = vA1[_i]; } }
        for (int t = 0; t < nt; t += 2) {
            const bool last = (t == nt - 2);
            const unsigned a1 = cA + (unsigned)(t + 1) * kstep;
            const unsigned a2 = last ? nA : cA + (unsigned)(t + 2) * kstep, b2 = last ? nB : cB + (unsigned)(t + 2) * kstep;
            const unsigned a3 = a2 + kstep, b3 = b2 + kstep;
            if (last && has_next) S.a_ready(nxt);
            const unsigned w0[2] = {last ? nA0[0] : vA0[0], last ? nA0[1] : vA0[1]}, w1[2] = {last ? nA1[0] : vA1[0], last ? nA1[1] : vA1[1]};
            PG8_LDB(B0, 0, 0); PG8_LDB(B1, 0, 1); PG8_SCHED; PG8_LDA(At, 0, 0); PG8_STAGE(PG8_SA(1, 1), a1, vA1);
            PG8_WAIT_V(8); PG8_WAIT_L(0); PG8_BAR; PG8_MM(0, 0, At, B0); PG8_MM(0, 1, At, B1); PG8_BAR; PG8_SCHED;
            PG8_LDA(At, 0, 1); PG8_STAGE(PG8_SB(0, 0), b2, voffB); PG8_STAGE(PG8_SB(0, 1), b2 + hsB, voffB); PG8_STAGE(PG8_SA(0, 0), a2, w0);
            PG8_WAIT_V(8); PG8_WAIT_L(0); PG8_BAR; PG8_MM(1, 0, At, B0); PG8_MM(1, 1, At, B1); PG8_BAR; PG8_SCHED;
            PG8_LDB(B0, 1, 0); PG8_LDB(B1, 1, 1); PG8_SCHED; PG8_LDA(At, 1, 0); PG8_STAGE(PG8_SA(0, 1), a2, w1);
            PG8_WAIT_V(8); PG8_WAIT_L(0); PG8_BAR; PG8_MM(0, 0, At, B0); PG8_MM(0, 1, At, B1); PG8_BAR; PG8_SCHED;
            PG8_LDA(At, 1, 1); PG8_STAGE(PG8_SB(1, 0), b3, voffB); PG8_STAGE(PG8_SB(1, 1), b3 + hsB, voffB); PG8_STAGE(PG8_SA(1, 0), a3, w0);
            PG8_WAIT_V(8); PG8_WAIT_L(0); PG8_BAR; PG8_MM(1, 0, At, B0); PG8_MM(1, 1, At, B1); PG8_BAR; PG8_SCHED;
        }
        if constexpr (ALIGN_EPI) { if (wr == 0) PG8_BAR; }
        if constexpr (F8) asm volatile("s_nop 15\n\ts_nop 15" ::: "memory");
        E(acc, cur, wr, wc, fr, fq); S.done(cur);
        if (!has_next) break;
#pragma unroll
        for (int a = 0; a < 2; ++a)
#pragma unroll
            for (int b = 0; b < 2; ++b)
#pragma unroll
                for (int m = 0; m < 4; ++m)
#pragma unroll
                    for (int n = 0; n < 2; ++n) acc[a][b][m][n] = (f32x4){0.f, 0.f, 0.f, 0.f};
        cur = nxt; cA = nA; cB = nB; ++ui;
#pragma unroll
        for (int _i = 0; _i < 2; ++_i) { vA0[_i] = nA0[_i]; vA1[_i] = nA1[_i]; }
        if constexpr (ALIGN_EPI) { if (wr == 1) PG8_BAR; }
    }
    PG8_WAIT_V(0);
    if constexpr (!ALIGN_EPI) { if (wr == 0) PG8_BAR; }
    PG8_BAR;
#undef PG8_SA
#undef PG8_SB
#undef PG8_STAGE
#undef PG8_GATHER
#undef PG8_LDA
#undef PG8_LDB
#undef PG8_MMA
#undef PG8_MMA8
#undef PG8_MM
#undef PG8_WAIT_V
#undef PG8_WAIT_L
#undef PG8_BAR
#undef PG8_SCHED
}
}

typedef const f32x4 (&AccRef)[2][2][4][2];

struct EpiZ {
    static constexpr bool PERM = true;
    bf16_t* Z; const float* cosT; const float* sinT;
    __device__ __forceinline__ void operator()(AccRef acc, const pg8::Unit& u, int wr, int wc, int fr, int fq) const {
        asm volatile("" : "+v"(fr), "+v"(fq));
        const int row0 = u.pm * 256 + wr * 64 + fr, col0 = u.pn * 256 + wc * 32 + 8 * fq;
        const bool rope = u.pn < 8;
#pragma unroll
        for (int ai = 0; ai < 2; ++ai)
#pragma unroll
            for (int m = 0; m < 4; ++m) {
                const int row = row0 + ai * 128 + m * 16, pos = row & (SEQ - 1);
                f32x4 cs = {1.f, 1.f, 1.f, 1.f}, sn = {0.f, 0.f, 0.f, 0.f};
                if (rope) { cs = *(const f32x4*)(cosT + pos * 64 + 16 * wc + 4 * fq); sn = *(const f32x4*)(sinT + pos * 64 + 16 * wc + 4 * fq); }
                bf16_t* rowp = Z + (size_t)row * DIN + col0;
#pragma unroll
                for (int bj = 0; bj < 2; ++bj) {
                    const f32x4 v0 = acc[ai][bj][m][0] * (1.f / WIN_SCALE), v1 = acc[ai][bj][m][1] * (1.f / WIN_SCALE);
                    u32x4 w;
                    w.x = cvt_pk_bf16(v0[0] * cs[0] - v0[1] * sn[0], v0[1] * cs[0] + v0[0] * sn[0]);
                    w.y = cvt_pk_bf16(v0[2] * cs[1] - v0[3] * sn[1], v0[3] * cs[1] + v0[2] * sn[1]);
                    w.z = cvt_pk_bf16(v1[0] * cs[2] - v1[1] * sn[2], v1[1] * cs[2] + v1[0] * sn[2]);
                    w.w = cvt_pk_bf16(v1[2] * cs[3] - v1[3] * sn[3], v1[3] * cs[3] + v1[2] * sn[3]);
                    *(u32x4*)(rowp + bj * 128) = w;
                }
            }
    }
};
struct EpiBf16Off {
    static constexpr bool PERM = true;
    unsigned char* O; int ldc, coloff;
    __device__ __forceinline__ void operator()(AccRef acc, const pg8::Unit& u, int wr, int wc, int fr, int fq) const {
        const int row0 = u.pm * 256 + wr * 64 + fr, col0 = coloff + u.pn * 256 + wc * 32 + 8 * fq;
#pragma unroll
        for (int ai = 0; ai < 2; ++ai)
#pragma unroll
            for (int m = 0; m < 4; ++m) { unsigned char* rowp = O + (size_t)(row0 + ai * 128 + m * 16) * ldc + col0;
#pragma unroll
                for (int bj = 0; bj < 2; ++bj) { const f32x4 v0 = acc[ai][bj][m][0] * CAT_SCALE, v1 = acc[ai][bj][m][1] * CAT_SCALE;
                    u32x2 w; w.x = cvt4_fp8(v0[0], v0[1], v0[2], v0[3]); w.y = cvt4_fp8(v1[0], v1[1], v1[2], v1[3]);
                    *(u32x2*)(rowp + bj * 128) = w; } }
    }
};
struct EpiResBf16 {
    static constexpr bool PERM = true;
    bf16_t* C; const bf16_t* res;
    __device__ __forceinline__ void operator()(AccRef acc, const pg8::Unit& u, int wr, int wc, int fr, int fq) const {
        const int row0 = u.pm * 256 + wr * 64 + fr, col0 = u.pn * 256 + wc * 32 + 8 * fq;
#pragma unroll
        for (int ai = 0; ai < 2; ++ai)
#pragma unroll
            for (int m = 0; m < 4; ++m) { const size_t ro = (size_t)(row0 + ai * 128 + m * 16) * DM + col0;
#pragma unroll
                for (int bj = 0; bj < 2; ++bj) { const u32x4 r = *(const u32x4*)(res + ro + bj * 128);
                    const f32x4 v0 = acc[ai][bj][m][0] * (1.f / (CAT_SCALE * WOUT_SCALE)), v1 = acc[ai][bj][m][1] * (1.f / (CAT_SCALE * WOUT_SCALE));
                    u32x4 w;
                    w.x = cvt_pk_bf16(v0[0] + ALPHA * bflo(r.x), v0[1] + ALPHA * bfhi(r.x)); w.y = cvt_pk_bf16(v0[2] + ALPHA * bflo(r.y), v0[3] + ALPHA * bfhi(r.y));
                    w.z = cvt_pk_bf16(v1[0] + ALPHA * bflo(r.z), v1[1] + ALPHA * bfhi(r.z)); w.w = cvt_pk_bf16(v1[2] + ALPHA * bflo(r.w), v1[3] + ALPHA * bfhi(r.w));
                    *(u32x4*)(C + ro + bj * 128) = w; } }
    }
};
__device__ __forceinline__ float dpp_shr(float v, float oldv, int d) {
    const int o = __float_as_int(oldv), x = __float_as_int(v);
    return __int_as_float(d == 1 ? __builtin_amdgcn_update_dpp(o, x, 0x111, 0xf, 0xf, false) : d == 2 ? __builtin_amdgcn_update_dpp(o, x, 0x112, 0xf, 0xf, false)
                        : d == 4 ? __builtin_amdgcn_update_dpp(o, x, 0x114, 0xf, 0xf, false) : __builtin_amdgcn_update_dpp(o, x, 0x118, 0xf, 0xf, false));
}
struct EpiGate {
    static constexpr bool PERM = false;
    float* SA; float* SB; const bf16_t* XC; const float* ba; const float* bx; const float* sp8; float* sumA; float* sumH;
    __device__ __forceinline__ void operator()(AccRef acc, const pg8::Unit& u, int wr, int wc, int fr, int fq) const {
        const int row0 = u.pm * 256 + wr * 64 + fr, ch0 = u.pn * 128 + wc * 32 + 4 * fq;
        const int l15 = (fq * 16 + 15) * 4;
#pragma unroll
        for (int n = 0; n < 2; ++n) {
            const int ch = ch0 + 16 * n;
            const f32x4 vba = *(const f32x4*)(ba + ch), vbx = *(const f32x4*)(bx + ch), vsp = *(const f32x4*)(sp8 + ch);
#pragma unroll
            for (int ai = 0; ai < 2; ++ai)
#pragma unroll
                for (int mp = 0; mp < 2; ++mp) {
                    f32x4 A[2], B[2];
#pragma unroll
                    for (int sg = 0; sg < 2; ++sg) { const int m = 2 * mp + sg;
                        const size_t ro = (size_t)(row0 + ai * 128 + m * 16) * RW + ch;
                        const u32x2 xw = *(const u32x2*)(XC + ro);
                        const float xc[4] = {bflo(xw.x), bfhi(xw.x), bflo(xw.y), bfhi(xw.y)};
                        const f32x4 ar = acc[ai][0][m][n], ain = acc[ai][1][m][n];
#pragma unroll
                        for (int q = 0; q < 4; ++q) {
                            const float r = sigmoidf_(ar[q] + vba[q]), ig = sigmoidf_(ain[q] + vbx[q]);
                            const float la = -r * vsp[q];
                            const float a = __expf(la);
                            A[sg][q] = a; B[sg][q] = sqrtf((1.f - a) * (1.f + a)) * (ig * xc[q]);
                        }
                    }
#pragma unroll
                    for (int d = 1; d < 16; d <<= 1)
#pragma unroll
                        for (int sg = 0; sg < 2; ++sg)
#pragma unroll
                            for (int q = 0; q < 4; ++q) { const float Ap = dpp_shr(A[sg][q], 1.f, d), Bp = dpp_shr(B[sg][q], 0.f, d);
                                B[sg][q] = fmaf(A[sg][q], Bp, B[sg][q]); A[sg][q] *= Ap; }
#pragma unroll
                    for (int q = 0; q < 4; ++q) {
                        const float A1 = __int_as_float(__builtin_amdgcn_ds_bpermute(l15, __float_as_int(A[0][q]))), H1 = __int_as_float(__builtin_amdgcn_ds_bpermute(l15, __float_as_int(B[0][q])));
                        B[1][q] = fmaf(A[1][q], H1, B[1][q]); A[1][q] *= A1; }
#pragma unroll
                    for (int sg = 0; sg < 2; ++sg) { const size_t ro = (size_t)(row0 + ai * 128 + (2 * mp + sg) * 16) * RW + ch;
                        *(f32x4*)(SA + ro) = A[sg]; *(f32x4*)(SB + ro) = B[sg]; }
                    if (fr == 15) { const size_t so = (size_t)(u.pm * 8 + ai * 4 + wr * 2 + mp) * RW + ch;
                        *(f32x4*)(sumA + so) = A[1]; *(f32x4*)(sumH + so) = B[1]; }
                    asm volatile("" ::: "memory");
                }
        }
    }
};
struct EpiSwiGLU {
    static constexpr bool PERM = true;
    unsigned char* H;
    __device__ __forceinline__ void operator()(AccRef acc, const pg8::Unit& u, int wr, int wc, int fr, int fq) const {
        const int row0 = u.pm * 256 + wr * 64 + fr, j0 = (u.pn * 256 + wc * 32 + 8 * fq) >> 1;
        constexpr float ds = 1.f / W1_SCALE;
#pragma unroll
        for (int ai = 0; ai < 2; ++ai)
#pragma unroll
            for (int m = 0; m < 4; ++m) { unsigned char* rowp = H + (size_t)(row0 + ai * 128 + m * 16) * DEXP + j0;
#pragma unroll
                for (int bj = 0; bj < 2; ++bj) { const f32x4 v0 = acc[ai][bj][m][0] * ds, v1 = acc[ai][bj][m][1] * ds;
                    const float h0 = v0[0] * sigmoidf_(v0[0]) * v0[1], h1 = v0[2] * sigmoidf_(v0[2]) * v0[3];
                    const float h2 = v1[0] * sigmoidf_(v1[0]) * v1[1], h3 = v1[2] * sigmoidf_(v1[2]) * v1[3];
                    *(unsigned*)(rowp + bj * 64) = cvt4_fp8(h0 * H_SCALE, h1 * H_SCALE, h2 * H_SCALE, h3 * H_SCALE); } }
    }
};
struct EpiScaleBf16 {
    static constexpr bool PERM = true;
    unsigned char* O; const float* sw;
    __device__ __forceinline__ void operator()(AccRef acc, const pg8::Unit& u, int wr, int wc, int fr, int fq) const {
        const int row0 = u.pm * 256 + wr * 64 + fr, col0 = u.pn * 256 + wc * 32 + 8 * fq;
#pragma unroll
        for (int ai = 0; ai < 2; ++ai)
#pragma unroll
            for (int m = 0; m < 4; ++m) { const int row = row0 + ai * 128 + m * 16; const float s = sw[u.lb + u.pb - u.pm * 256 + row] * (Y2_SCALE / (H_SCALE * W2_SCALE)); unsigned char* rowp = O + (size_t)row * DM + col0;
#pragma unroll
                for (int bj = 0; bj < 2; ++bj) { const f32x4 v0 = acc[ai][bj][m][0] * s, v1 = acc[ai][bj][m][1] * s;
                    u32x2 w; w.x = cvt4_fp8(v0[0], v0[1], v0[2], v0[3]); w.y = cvt4_fp8(v1[0], v1[1], v1[2], v1[3]);
                    *(u32x2*)(rowp + bj * 128) = w; } }
    }
};
struct RgOrder {
    static constexpr bool GATHER = false;
    __device__ __forceinline__ unsigned arow(const pg8::Unit&, int) const { return 0u; }
    int G, c;
    __device__ bool next(int i, pg8::Unit& u) const {
        const int L = i * G + c; if (L >= 128) return false;
        u.pm = L >> 2; u.pn = L & 3; u.aoff = ((unsigned)u.pm * 256 * RW + (unsigned)u.pn * 128) * 2; u.boff = (unsigned)u.pn * 256 * 128 * 2; return true;
    }
    __device__ __forceinline__ void a_ready(const pg8::Unit&) const {}
    __device__ __forceinline__ void done(const pg8::Unit&) const {}
};
template <bool GATHER_>
struct MoeOrder {
    static constexpr bool GATHER = GATHER_;
    int Gp, c, lo, hi, lda, ldb; const volatile LAS int* meta; unsigned estride; bool xcdmap; const int* list;
    __device__ bool next(int i, pg8::Unit& u) const {
        int L = lo + i * Gp + c; if (c < 0 || L >= hi) return false;
        if (xcdmap) {
            const int x = c & 7, r = c >> 3; L = (((i * 8 + x) * 4 + (r >> 3)) << 3) | (r & 7); }
        u.pm = L >> 3; u.pn = L & 7; const int e = __builtin_amdgcn_readfirstlane(meta[48 + u.pm]);
        u.cnt = __builtin_amdgcn_readfirstlane(meta[e]); u.pb = u.pm * 256 - __builtin_amdgcn_readfirstlane(meta[16 + e]); u.lb = e * MTOK;
        u.aoff = GATHER_ ? 0u : (unsigned)u.pm * 256 * lda * 2; u.boff = (unsigned)e * estride + (unsigned)u.pn * 256 * ldb * 2; return true;
    }
    __device__ __forceinline__ unsigned arow(const pg8::Unit& u, int r) const { const int p = u.pb + r; return (p < u.cnt) ? (unsigned)list[u.lb + p] : 0u; }
    __device__ __forceinline__ void a_ready(const pg8::Unit&) const {}
    __device__ __forceinline__ void done(const pg8::Unit&) const {}
};

namespace att {
constexpr int D = 128, PQ = DIN, PO = 1024;
constexpr float SCALE = 0.08838834764831845f;
constexpr float THR = 8.f;
constexpr int NW = 8, QBLK = 32, KVBLK = 64, QB = NW * QBLK;
constexpr int SHM_V = KVBLK * D * 2, SHM_K = KVBLK * D * 2;
constexpr int LDS_ATT = 2 * SHM_V + 2 * SHM_K + NW * 64 * 4;
#define KSWZ(row, colB) ((row) * 256 + ((colB) ^ (((row) & 7) << 4)))
#define SBAR() __builtin_amdgcn_sched_barrier(0)
__device__ __forceinline__ int v_st(int k, int c) { const int kk = (k & ~0xC) | ((k & 4) << 1) | ((k & 8) >> 1); return ((kk >> 3) * 4 + (c >> 5)) * 512 + ((kk & 7) * 32 + (c & 31)) * 2; }
__device__ __forceinline__ int v_rd_base(int lane) { return ((lane & 3) << 3) | (((lane >> 2) & 3) << 6) | (((lane >> 4) & 1) << 5) | (((lane >> 5) & 1) << 8); }
constexpr int v_rd_off(int d0, int ks, int half) { return d0 * 512 + ks * 4096 + half * 2048; }
__device__ __forceinline__ int crow(int r, int hi) { return (r & 3) + 8 * (r >> 2) + 4 * hi; }
__device__ __forceinline__ unsigned cvtpk(float lo, float hi) { unsigned r; asm volatile("v_cvt_pk_bf16_f32 %0, %1, %2" : "=v"(r) : "v"(lo), "v"(hi)); return r; }
__device__ __forceinline__ bf16x8 load8(const bf16_t* p) { return *reinterpret_cast<const bf16x8*>(p); }
__device__ __forceinline__ void mask_tile(f32x16& p0, f32x16& p1, int dq, unsigned W) {
    const float NEG = -__builtin_inff();
#pragma unroll
    for (int r = 0; r < 16; ++r) {
        const int c = (r & 3) + 8 * (r >> 2);
        if ((unsigned)(dq - c) >= W) p0[r] = NEG;
        if ((unsigned)(dq - c - 32) >= W) p1[r] = NEG;
    }
}
__device__ __forceinline__ void partialSM(f32x16& p0, f32x16& p1, float& m_reg, float& mn, float& alpha) {
    float pmax = p0[0]; for (int r = 1; r < 16; ++r) pmax = fmaxf(pmax, p0[r]); for (int r = 0; r < 16; ++r) pmax = fmaxf(pmax, p1[r]);
    { auto rr = __builtin_amdgcn_permlane32_swap(__float_as_uint(pmax), __float_as_uint(pmax), false, false);
      pmax = fmaxf(__uint_as_float(rr[0]), __uint_as_float(rr[1])); }
    constexpr float C2 = 1.4426950408889634f * SCALE;
    if (__builtin_expect(__all((pmax - m_reg) * SCALE <= THR), 1)) { mn = m_reg; alpha = 1.f; }
    else { mn = fmaxf(m_reg, pmax); alpha = __builtin_amdgcn_exp2f((m_reg - mn) * C2); m_reg = mn; }
    const float mnL = -mn * C2;
    for (int r = 0; r < 16; ++r) p0[r] = fmaf(p0[r], C2, mnL); for (int r = 0; r < 16; ++r) p1[r] = fmaf(p1[r], C2, mnL);
    for (int r = 0; r < 16; ++r) p0[r] = __builtin_amdgcn_exp2f(p0[r]);
}
__device__ __forceinline__ void finishSM(f32x16& p0, f32x16& p1, float alpha, float& l_reg, bf16x8& pa0, bf16x8& pa1, bf16x8& pa2, bf16x8& pa3) {
    for (int r = 0; r < 16; ++r) p1[r] = __builtin_amdgcn_exp2f(p1[r]);
    float ps = 0; for (int r = 0; r < 16; ++r) ps += p0[r]; for (int r = 0; r < 16; ++r) ps += p1[r];
    { auto rr = __builtin_amdgcn_permlane32_swap(__float_as_uint(ps), __float_as_uint(ps), false, false);
      ps = __uint_as_float(rr[0]) + __uint_as_float(rr[1]); }
    l_reg = l_reg * alpha + ps;
#define PK4(P, B_, OUT) do { unsigned a0 = cvtpk(P[B_+0], P[B_+1]), a1 = cvtpk(P[B_+2], P[B_+3]);                          \
        unsigned b0 = cvtpk(P[B_+4], P[B_+5]), b1 = cvtpk(P[B_+6], P[B_+7]);                                             \
        auto r0 = __builtin_amdgcn_permlane32_swap(a0, b0, false, false); auto r1 = __builtin_amdgcn_permlane32_swap(a1, b1, false, false); \
        u32x4 w = {r0[0], r1[0], r0[1], r1[1]}; OUT = *reinterpret_cast<bf16x8*>(&w); } while (0)
    PK4(p0, 0, pa0); PK4(p0, 8, pa1); PK4(p1, 0, pa2); PK4(p1, 8, pa3);
#undef PK4
}
template <int KB>
__device__ __forceinline__ void qkt(f32x16& p0, f32x16& p1, const char* K_lds, int r32, int hi, const bf16x8* qr) {
    p0 = f32x16{}; p1 = f32x16{};
    const char* kb[4];
#pragma unroll
    for (int dd = 0; dd < 4; ++dd) kb[dd] = K_lds + KB * SHM_K + KSWZ(r32, (dd * 16 + hi * 8) * 2);
#pragma unroll
    for (int d0 = 0; d0 < 8; ++d0) { const char* a = kb[d0 & 3] + (d0 >> 2) * 128;
        bf16x8 b0 = *reinterpret_cast<const bf16x8*>(a);
        bf16x8 b1 = *reinterpret_cast<const bf16x8*>(a + 32 * 256);
        p0 = __builtin_amdgcn_mfma_f32_32x32x16_bf16(b0, qr[d0], p0, 0, 0, 0);
        p1 = __builtin_amdgcn_mfma_f32_32x32x16_bf16(b1, qr[d0], p1, 0, 0, 0); }
}
template <int VB>
__device__ __forceinline__ void pv_tile(f32x16* o, int vb0, bf16x8 pa0, bf16x8 pa1, bf16x8 pa2, bf16x8 pa3) {
#define TRRD(dst, off) asm volatile("ds_read_b64_tr_b16 %0, %1 offset:%2" : "=&v"(dst) : "v"(vb0), "i"(off) : "memory")
#define PV_D0(d0) do { s16x4 l0, l1, l2, l3, h0, h1, h2, h3; constexpr int b_ = VB * SHM_V + v_rd_off(d0, 0, 0); \
        TRRD(l0, b_); TRRD(h0, b_ + 2048); TRRD(l1, b_ + 4096); TRRD(h1, b_ + 6144); TRRD(l2, b_ + 8192); TRRD(h2, b_ + 10240); TRRD(l3, b_ + 12288); TRRD(h3, b_ + 14336); \
        asm volatile("s_waitcnt lgkmcnt(0)" ::: "memory"); SBAR();   \
        o[d0] = __builtin_amdgcn_mfma_f32_32x32x16_bf16(pa0, (bf16x8){l0[0], l0[1], l0[2], l0[3], h0[0], h0[1], h0[2], h0[3]}, o[d0], 0, 0, 0);   \
        o[d0] = __builtin_amdgcn_mfma_f32_32x32x16_bf16(pa1, (bf16x8){l1[0], l1[1], l1[2], l1[3], h1[0], h1[1], h1[2], h1[3]}, o[d0], 0, 0, 0);   \
        o[d0] = __builtin_amdgcn_mfma_f32_32x32x16_bf16(pa2, (bf16x8){l2[0], l2[1], l2[2], l2[3], h2[0], h2[1], h2[2], h2[3]}, o[d0], 0, 0, 0);   \
        o[d0] = __builtin_amdgcn_mfma_f32_32x32x16_bf16(pa3, (bf16x8){l3[0], l3[1], l3[2], l3[3], h3[0], h3[1], h3[2], h3[3]}, o[d0], 0, 0, 0); } while (0)
    PV_D0(0); PV_D0(1); PV_D0(2); PV_D0(3);
#undef PV_D0
#undef TRRD
}
struct BlockRef { const bf16_t* Q; const bf16_t* K; const bf16_t* V; bf16_t* O; int P0; };
struct Seam { bf16x8 qr[8]; bf16x8 st_v0, st_v1, st_k0, st_k1; };
#define ROW(p, k0, rr) ((p) + (size_t)((k0) + (rr)) * PQ + sc)
#define VMW() asm volatile("s_waitcnt vmcnt(0)" ::: "memory")
#define VMWN(n) asm volatile("s_waitcnt vmcnt(%0)" :: "i"(n) : "memory")
#define SLOAD_H(Kp, Vp, k0) do { S.st_v0 = load8(ROW(Vp, k0, sr)); S.st_v1 = load8(ROW(Vp, k0, 32 + sr));              \
                         S.st_k0 = load8(ROW(Kp, k0, sr)); S.st_k1 = load8(ROW(Kp, k0, 32 + sr)); } while (0)
#define SWRITE_HK(bf) do { *(bf16x8*)(K_lds + (bf) * SHM_K + kws) = S.st_k0; *(bf16x8*)(K_lds + (bf) * SHM_K + kws + 32 * 256) = S.st_k1; } while (0)
#define SWRITE_HV(bf) do { *(bf16x8*)(V_lds + (bf) * SHM_V + vst0) = S.st_v0; *(bf16x8*)(V_lds + (bf) * SHM_V + vst1) = S.st_v1; } while (0)
#define SWRITE_H(bf) do { SWRITE_HV(bf); SWRITE_HK(bf); } while (0)
__device__ __forceinline__ void causal_prime(const BlockRef& cur, char* lds, Seam& S, int wid0) {
    const int tid = tidx(wid0), wid = __builtin_amdgcn_readfirstlane(tid >> 6), lane = tid & 63, r32 = lane & 31, hi = lane >> 5;
    const int sr = tid >> 4, sc = (tid & 15) * 8, kws = KSWZ(sr, sc * 2); char* K_lds = lds + 2 * SHM_V;
    const int kb0 = 0;
    for (int d0 = 0; d0 < 8; ++d0) S.qr[d0] = load8(cur.Q + (size_t)(wid * QBLK + r32) * PQ + d0 * 16 + hi * 8);
    SLOAD_H(cur.K, cur.V, kb0); VMW(); SWRITE_HK(0);
    __syncthreads();
}
__device__ __forceinline__ void causal_block(const BlockRef& cur, const BlockRef& nxt, char* lds, Seam& S, int wid0) {
    const int tid = tidx(wid0), wid = __builtin_amdgcn_readfirstlane(tid >> 6), lane = tid & 63, r32 = lane & 31, hi = lane >> 5;
    const int W = 1 << 30;
    const int j_lo = 0;
    const int j_hi = (cur.P0 + QB - 1) / KVBLK + 1;
    const int NT = j_hi - j_lo;
    const int kbn = 0;
    const int qlo = cur.P0 + wid * QBLK, qm = qlo + r32 - 4 * hi;
    char* V_lds = lds; char* K_lds = lds + 2 * SHM_V;
    float* ws = (float*)(lds + 2 * SHM_V + 2 * SHM_K) + wid * 64; float* li_l = ws, * al_l = ws + 32;
    float m_reg = -1e30f, l_reg = 0; f32x16 o[4] = {};
    const int sr = tid >> 4, sc = (tid & 15) * 8, vst0 = v_st(sr, sc), vst1 = v_st(32 + sr, sc), kws = KSWZ(sr, sc * 2);
    const int vb0 = (int)(uintptr_t)V_lds + v_rd_base(lane);
    const bf16_t* Kh = cur.K; const bf16_t* Vh = cur.V;
#define RESC(a) do { if (__any((a) < 1.f)) { if (hi == 0) al_l[r32] = (a); asm volatile("s_waitcnt lgkmcnt(0)" ::: "memory");              \
                     for (int d_ = 0; d_ < 4; ++d_) for (int r = 0; r < 16; ++r) o[d_][r] *= al_l[crow(r, hi)]; } } while (0)
#define KBASE(t) ((j_lo + (t)) * KVBLK)
#define MASKT(P0_, P1_, t) do { const int kb_ = KBASE(t); if (kb_ + KVBLK - 1 > qlo) mask_tile(P0_, P1_, qm - kb_, (unsigned)W); } while (0)
    constexpr int NQL = 8;
#define SEAM_K0() do { VMWN(NQL); SWRITE_HK(0); SBAR(); } while (0)
    f32x16 pA0, pA1, pB0, pB1; float mnA, mnB, alA, alB; bf16x8 pa0, pa1, pa2, pa3;
    SWRITE_HV(0); SBAR();
    if (NT > 1) { SLOAD_H(Kh, Vh, KBASE(1)); }
    SBAR(); qkt<0>(pA0, pA1, K_lds, r32, hi, S.qr);
    MASKT(pA0, pA1, 0); partialSM(pA0, pA1, m_reg, mnA, alA);
    if (NT > 1) { VMW(); SWRITE_H(1); }
    __syncthreads();
#define HALF_STEP(PX0, PX1, mnX, alX, PY0, PY1, alY, t, KB, VB, SB) do {                                                      \
        SBAR(); qkt<KB>(PX0, PX1, K_lds, r32, hi, S.qr);                                                         \
        finishSM(PY0, PY1, alY, l_reg, pa0, pa1, pa2, pa3); SBAR();                                                           \
        if ((t) + 1 < NT) { SLOAD_H(Kh, Vh, KBASE((t) + 1)); SBAR(); }                                                        \
        pv_tile<VB>(o, vb0, pa0, pa1, pa2, pa3); MASKT(PX0, PX1, (t)); partialSM(PX0, PX1, m_reg, mnX, alX);                  \
        __syncthreads();                                                                                                      \
        if ((t) + 1 < NT) { VMW(); SWRITE_H(SB); }                                                                            \
        RESC(alX); __syncthreads(); } while (0)
    for (int t = 1; t + 1 < NT; t += 2) {
        HALF_STEP(pB0, pB1, mnB, alB, pA0, pA1, alA, t, 1, 0, 0);
        HALF_STEP(pA0, pA1, mnA, alA, pB0, pB1, alB, t + 1, 0, 1, 1);
    }
    const bool even = (NT & 1) == 0;
    if (even) { SBAR(); qkt<1>(pB0, pB1, K_lds, r32, hi, S.qr); SBAR(); }
    SLOAD_H(nxt.K, nxt.V, kbn); SBAR();
#pragma unroll
    for (int d0 = 0; d0 < 8; ++d0) S.qr[d0] = load8(nxt.Q + (size_t)(wid * QBLK + r32) * PQ + d0 * 16 + hi * 8);
    SBAR();
    finishSM(pA0, pA1, alA, l_reg, pa0, pa1, pa2, pa3); SBAR();
    pv_tile<0>(o, vb0, pa0, pa1, pa2, pa3);
    if (even) { MASKT(pB0, pB1, NT - 1); partialSM(pB0, pB1, m_reg, mnB, alB); __syncthreads(); RESC(alB);
        finishSM(pB0, pB1, alB, l_reg, pa0, pa1, pa2, pa3); SBAR(); pv_tile<1>(o, vb0, pa0, pa1, pa2, pa3); }
    SBAR(); SEAM_K0();
    if (hi == 0) li_l[r32] = l_reg; asm volatile("s_waitcnt lgkmcnt(0)" ::: "memory");
    float rli[16];
#pragma unroll
    for (int r = 0; r < 16; ++r) rli[r] = __builtin_amdgcn_rcpf(li_l[crow(r, hi)]);
    bf16_t* Ow = cur.O + (size_t)(wid * QBLK) * PO;
#pragma unroll
    for (int r = 0; r < 16; ++r) { const int orow = crow(r, hi);
#pragma unroll
        for (int d0 = 0; d0 < 4; ++d0) { const float v = o[d0][r] * rli[r];
            const float vn = __int_as_float(__builtin_amdgcn_mov_dpp(__float_as_int(v), 0xB1, 0xf, 0xf, true));
            if ((r32 & 1) == 0) *(unsigned*)(Ow + (size_t)orow * PO + d0 * 32 + r32) = cvtpk(v, vn); } }
    __syncthreads();
#undef RESC
#undef KBASE
#undef MASKT
#undef SEAM_K0
#undef HALF_STEP
}
#undef ROW
#undef VMW
#undef VMWN
#undef SLOAD_H
#undef SWRITE_HK
#undef SWRITE_HV
#undef SWRITE_H
__device__ __forceinline__ BlockRef make_ref(int L, int pass, const bf16_t* Z, bf16_t* OC) {
    const int bh = L >> 2, x = L & 3, b = bh >> 4, vh = bh & 15, h = vh >> 2, c = (vh >> 1) & 1, vhalf = vh & 1;
    const int qb = pass ? 7 - x : x;
    const size_t row0 = (size_t)b * SEQ;
    BlockRef r;
    r.Q = Z + (row0 + (size_t)qb * QB) * PQ + h * 256 + c * 128;
    r.K = Z + row0 * PQ + ZK_OFF + h * 256 + c * 128;
    r.V = Z + row0 * PQ + ZV_OFF + h * 256 + vhalf * 128;
    r.O = OC + (size_t)c * MTOK * PO + (row0 + (size_t)qb * QB) * PO + h * 256 + vhalf * 128;
    r.P0 = qb * QB;
    return r;
}
__device__ __forceinline__ void attn_phase(char* lds, const bf16_t* Z, bf16_t* OC, int G, int c0, int wid0) {
    constexpr int total = 256;
    int L = c0; if (L >= total) return;
    int pass = 0;
    BlockRef cur = make_ref(L, 0, Z, OC);
    Seam S;
    causal_prime(cur, lds, S, wid0);
    for (;;) {
        const bool more_pass = pass == 0, more_item = L + G < total, last = !more_pass && !more_item;
        int passn = pass + 1, Ln = L;
        if (!more_pass) { passn = 0; Ln = more_item ? L + G : L; }
        const BlockRef nxt = last ? cur : make_ref(Ln, passn, Z, OC);
        causal_block(cur, nxt, lds, S, wid0);
        if (last) break;
        cur = nxt; pass = passn; L = Ln;
    }
}
}

#define AIN(k) ldptr(lds, (k))
struct Args { const float* in[28]; float* out; unsigned char* ws; int ph_lo, ph_hi; };
enum { I_X = 0, I_WIN, I_LQ1, I_LK1, I_LQ2, I_LK2, I_SUBLN, I_CDW, I_CLNG, I_CLNB, I_CPW, I_RCW, I_RCB, I_RWA, I_RBA, I_RWX, I_RBX, I_RLAM, I_WOUT,
       I_LN1G, I_LN1B, I_RTW, I_RTB, I_EWG, I_EWU, I_EWD, I_LN2G, I_LN2B };
constexpr int NPH = 12;
constexpr int NPHASES = 1 + NLAYER * NPH;

template <bool F8>
__device__ __forceinline__ void cvt_tile(const float* src, int ld, unsigned char* dst, int dpitch, float scale, LAS unsigned char* scr, int lane) {
    constexpr int NB = F8 ? 4 : 2;
    float va[32], vb[32];
#define CT_LOAD(v, b) do { _Pragma("unroll") for (int r = 0; r < 32; ++r) v[r] = src[(size_t)((b) * 32 + r) * ld]; } while (0)
#define CT_CONV(v, b) do { if constexpr (F8) { _Pragma("unroll") for (int i = 0; i < 4; ++i) { u32x2 w; \
            w.x = cvt4_fp8(v[8 * i + 0] * scale, v[8 * i + 1] * scale, v[8 * i + 2] * scale, v[8 * i + 3] * scale); \
            w.y = cvt4_fp8(v[8 * i + 4] * scale, v[8 * i + 5] * scale, v[8 * i + 6] * scale, v[8 * i + 7] * scale); \
            *(LAS u32x2*)(scr + lane * 136 + (b) * 32 + i * 8) = w; } } \
        else { _Pragma("unroll") for (int i = 0; i < 8; ++i) { u32x2 w; w.x = cvt_pk_bf16(v[4 * i + 0], v[4 * i + 1]); w.y = cvt_pk_bf16(v[4 * i + 2], v[4 * i + 3]); \
            *(LAS u32x2*)(scr + lane * 136 + (b) * 64 + i * 8) = w; } } } while (0)
    CT_LOAD(va, 0);
#pragma unroll
    for (int b = 0; b < NB; b += 2) {
        CT_LOAD(vb, b + 1);
        __builtin_amdgcn_sched_barrier(0);
        CT_CONV(va, b);
        if (b + 2 < NB) CT_LOAD(va, b + 2);
        __builtin_amdgcn_sched_barrier(0);
        CT_CONV(vb, b + 1);
    }
#undef CT_LOAD
#undef CT_CONV
    LDS_WAIT();
#pragma unroll
    for (int it = 0; it < 8; ++it) { const int id = it * 64 + lane, n = id >> 3, c = id & 7;
        const u32x2 a = *(const LAS u32x2*)(scr + n * 136 + c * 16), b = *(const LAS u32x2*)(scr + n * 136 + c * 16 + 8);
        u32x4 o; o.x = a.x; o.y = a.y; o.z = b.x; o.w = b.y;
        *(u32x4*)(dst + (size_t)n * dpitch + c * 16) = o; }
    LDS_WAIT();
}

struct F8Tile { const float* src; unsigned char* dst; int ld, dpitch, drow, dstep; float scale; };
__device__ __forceinline__ F8Tile f8_tile(const Args& a, LAS unsigned char* lds, unsigned char* ws, int t, int lane, int wave) {
    F8Tile T;
    if (t < 640) {
        const int l = t / 160, r = t % 160, kt = r / 20, nt = r % 20, sc = 4 * lane;
        T.src = AIN(I_WIN) + (size_t)l * DM * DIN + (size_t)(kt * 256 + 32 * wave) * DIN + nt * 256 + sc; T.ld = DIN; T.scale = WIN_SCALE;
        T.dst = ws + WS_WIN + (size_t)l * DIN * DM + (size_t)(nt * 256) * DM + kt * 256; T.dpitch = DM;
        if (nt < 8) { const int d = sc & 127; T.drow = (sc & 128) + 2 * (d & 63) + (d >> 6); T.dstep = 2; } else { T.drow = sc; T.dstep = 1; }
    } else if (t < 640 + 4096) {
        t -= 640; const int le = t / 64, r = t % 64, kt = r / 8, nt = r % 8, half = lane >> 5, lc = lane & 31;
        T.src = (half ? AIN(I_EWU) : AIN(I_EWG)) + (size_t)le * DM * DEXP + (size_t)(kt * 256 + 32 * wave) * DEXP + nt * 128 + 4 * lc; T.ld = DEXP; T.scale = W1_SCALE;
        T.dst = ws + WS_W1 + (size_t)le * 2048 * DM + (size_t)(nt * 256) * DM + kt * 256; T.dpitch = DM;
        T.drow = 8 * lc + half; T.dstep = 2;
    } else if (t >= 640 + 4096 + 2048) {
        t -= 640 + 4096 + 2048; const int l = t / 64, r = t % 64, kt = r / 8, nt = r % 8;
        T.src = AIN(I_WOUT) + (size_t)l * DM * DM + (size_t)(kt * 256 + 32 * wave) * DM + nt * 256 + 4 * lane; T.ld = DM; T.scale = WOUT_SCALE;
        T.dst = ws + WS_WOUT + (size_t)l * DM * DM + (size_t)(nt * 256) * DM + kt * 256; T.dpitch = DM;
        T.drow = 4 * lane; T.dstep = 1;
    } else {
        t -= 640 + 4096; const int le = t / 32, r = t % 32, kt = r / 8, nt = r % 8;
        T.src = AIN(I_EWD) + (size_t)le * DEXP * DM + (size_t)(kt * 256 + 32 * wave) * DM + nt * 256 + 4 * lane; T.ld = DM; T.scale = W2_SCALE;
        T.dst = ws + WS_W2 + (size_t)le * DM * DEXP + (size_t)(nt * 256) * DEXP + kt * 256; T.dpitch = DEXP;
        T.drow = 4 * lane; T.dstep = 1;
    }
    return T;
}
__device__ __forceinline__ int f8_tile_of(int l, int k) { return k < 160 ? l * 160 + k : (k < 1184 ? 640 + l * 1024 + (k - 160) : (k < 1696 ? 640 + 4096 + l * 512 + (k - 1184) : 640 + 4096 + 2048 + l * 64 + (k - 1696))); }
constexpr int F8_TILES_PER_LAYER = 1760;
template <bool STEAL>
__device__ __forceinline__ void f8_convert(const Args& a, LAS unsigned char* lds, unsigned char* ws, int l, int first, int stride, int quota, unsigned* ticket, int tid, int lane, int wave) {
    volatile LAS int* word = (volatile LAS int*)(lds + MISC_OFF) + 16;
    f32x4 v[32];
    int k, n = 0;
    if constexpr (STEAL) {
        __syncthreads();
        if (tid == 0) word[0] = (quota > 0) ? (int)__hip_atomic_fetch_add(ticket, 1u, __ATOMIC_RELAXED, __HIP_MEMORY_SCOPE_AGENT) : F8_TILES_PER_LAYER;
        __syncthreads();
        k = word[0];
    } else k = first;
    F8Tile T = f8_tile(a, lds, ws, f8_tile_of(l, k < F8_TILES_PER_LAYER ? k : 0), lane, wave);
#define F8_LOADS() do { _Pragma("unroll") for (int q = 0; q < 32; ++q) v[q] = __builtin_nontemporal_load((const f32x4*)(T.src + (size_t)q * T.ld)); } while (0)
    if (k < F8_TILES_PER_LAYER) F8_LOADS();
    while (k < F8_TILES_PER_LAYER) {
        LAS unsigned char* buf = lds + (n & 1) * 65536;
        if constexpr (STEAL) { if (tid == 0) word[(n + 1) & 1] = (n + 1 < quota) ? (int)__hip_atomic_fetch_add(ticket, 1u, __ATOMIC_RELAXED, __HIP_MEMORY_SCOPE_AGENT) : F8_TILES_PER_LAYER; }
        const float sc = T.scale;
#pragma unroll
        for (int c = 0; c < 4; ++c) {
            const int R = T.drow + c * T.dstep, sw = (R >> 2) & 15;
            u32x4 lo, hi;
            lo.x = cvt4_fp8(v[0][c] * sc, v[1][c] * sc, v[2][c] * sc, v[3][c] * sc);     lo.y = cvt4_fp8(v[4][c] * sc, v[5][c] * sc, v[6][c] * sc, v[7][c] * sc);
            lo.z = cvt4_fp8(v[8][c] * sc, v[9][c] * sc, v[10][c] * sc, v[11][c] * sc);   lo.w = cvt4_fp8(v[12][c] * sc, v[13][c] * sc, v[14][c] * sc, v[15][c] * sc);
            hi.x = cvt4_fp8(v[16][c] * sc, v[17][c] * sc, v[18][c] * sc, v[19][c] * sc); hi.y = cvt4_fp8(v[20][c] * sc, v[21][c] * sc, v[22][c] * sc, v[23][c] * sc);
            hi.z = cvt4_fp8(v[24][c] * sc, v[25][c] * sc, v[26][c] * sc, v[27][c] * sc); hi.w = cvt4_fp8(v[28][c] * sc, v[29][c] * sc, v[30][c] * sc, v[31][c] * sc);
            *(LAS u32x4*)(buf + R * 256 + (((2 * wave) ^ sw) << 4)) = lo;
            *(LAS u32x4*)(buf + R * 256 + (((2 * wave + 1) ^ sw) << 4)) = hi;
        }
        __syncthreads();
        unsigned char* const dst = T.dst; const int dpitch = T.dpitch;
        int kn; if constexpr (STEAL) kn = word[(n + 1) & 1]; else kn = k + stride;
        if (kn < F8_TILES_PER_LAYER) { T = f8_tile(a, lds, ws, f8_tile_of(l, kn), lane, wave); F8_LOADS(); }
        __builtin_amdgcn_sched_barrier(0);
#pragma unroll
        for (int it = 0; it < 8; ++it) { const int id = it * NTHREADS + tid, R = id >> 4, cl = id & 15;
            const u32x4 o = *(const LAS u32x4*)(buf + R * 256 + ((cl ^ ((R >> 2) & 15)) << 4));
            *(u32x4*)(dst + (size_t)R * dpitch + cl * 16) = o; }
        k = kn; ++n;
    }
#undef F8_LOADS
    __syncthreads();
}
__device__ __forceinline__ void phase_prologue(const Args& a, LAS unsigned char* lds, int G, int tid, int lane, int wave) {
    unsigned char* ws = a.ws;
    f8_convert<false>(a, lds, ws, 0, (int)blockIdx.x, G, 0, nullptr, tid, lane, wave);
    LAS unsigned char* scr = lds + wave * 8704;
    const int gw = blockIdx.x * NWAVES + wave, NGW = G * NWAVES;
    constexpr int nB = 4 * 32 * 32, nE = 4 * 8 * 8, nF = 16 * 2 * 4;
    constexpr int NITEMS = nB + nE + nF;
    for (int it0 = gw; it0 < NITEMS; it0 += NGW) {
        int it = it0; const float* src; unsigned char* dst; int ld, dpitch;
        if (it < nB) { continue;
            const int l = it / 1024, r = it % 1024, kt = r / 32, nt = r % 32;
            src = AIN(I_WOUT) + (size_t)l * DM * DM + (size_t)(kt * 64) * DM + nt * 64 + lane; ld = DM;
            dst = ws + WS_WOUT + ((size_t)l * DM * DM + (size_t)(nt * 64) * DM + kt * 64) * 2; dpitch = DM * 2; }
        else if ((it -= nB) < nE) { const int l = it / 64, r = it % 64, kt = r / 8, nt = r % 8;
            src = AIN(I_CPW) + (size_t)l * CW * CW + (size_t)(kt * 64) * CW + nt * 64 + lane; ld = CW;
            dst = ws + WS_PW + ((size_t)l * CW * CW + (size_t)(nt * 64) * CW + kt * 64) * 2; dpitch = CW * 2; }
        else { it -= nE; const int lb = it / 8, r = it % 8, kt = r / 4, nt = r % 4, np = nt * 64 + lane;
            src = ((np < 128) ? AIN(I_RWA) : AIN(I_RWX)) + (size_t)lb * 128 * 128 + (size_t)(kt * 64) * 128 + (np & 127); ld = 128;
            dst = ws + WS_WRG + ((size_t)lb * 256 * 128 + (size_t)(nt * 64) * 128 + kt * 64) * 2; dpitch = 128 * 2; }
        cvt_tile<false>(src, ld, dst, dpitch, 1.f, scr, lane);
    }
    const int gt = blockIdx.x * NTHREADS + tid, NGT = G * NTHREADS;
    { const float* x = AIN(I_X); unsigned char* xb = ws + WS_XB;
      for (int i = gt; i < MTOK * DM / 8; i += NGT) { const f32x4 v0 = *(const f32x4*)(x + (size_t)i * 8), v1 = *(const f32x4*)(x + (size_t)i * 8 + 4);
          u32x2 w; w.x = cvt4_fp8(v0[0], v0[1], v0[2], v0[3]); w.y = cvt4_fp8(v1[0], v1[1], v1[2], v1[3]);
          *(u32x2*)(xb + (size_t)i * 8) = w;
          u32x4 h; h.x = cvt_pk_bf16(v0[0], v0[1]); h.y = cvt_pk_bf16(v0[2], v0[3]); h.z = cvt_pk_bf16(v1[0], v1[1]); h.w = cvt_pk_bf16(v1[2], v1[3]);
          *(u32x4*)((bf16_t*)(ws + WS_XA) + (size_t)i * 8) = h; } }
    { const float* rtw = AIN(I_RTW); float* img = (float*)(ws + WS_RWT);
      for (int i = gt; i < DM * NEXP; i += NGT) img[(i & 15) * 2052 + (i >> 4)] = rtw[i];
      for (int i = gt; i < 16 * 4 + 448; i += NGT) { if (i < 64) img[(i >> 2) * 2052 + 2048 + (i & 3)] = 0.f; else img[16 * 2052 + (i - 64)] = 0.f; } }
    { float* cosT = (float*)(ws + WS_COS); float* sinT = (float*)(ws + WS_SIN);
      for (int i = gt; i < SEQ * 64; i += NGT) { const int pos = i >> 6, j = i & 63;
          const float inv = exp2f(-(float)j * 0.20762050593046014f);
          const float ang = (float)pos * inv;
          const double ad = (double)ang; const double n = rint(ad * 0.15915494309189535); const float r = (float)(ad - n * 6.283185307179586);
          cosT[i] = cosf(r); sinT[i] = sinf(r); } }
    { float* sp8 = (float*)(ws + WS_SP8);
      const float* rlam = AIN(I_RLAM);
      for (int i = gt; i < NLAYER * RW; i += NGT) { const float lam = rlam[i]; sp8[i] = 8.f * log1pf(expf(-lam)); } }
}

__device__ __forceinline__ void conv_unit(const Args& a, int l, int u, LAS unsigned char* lds, int tid, int lane, int wave) {
    unsigned char* ws = opaque_p(a.ws);
    const bf16_t* Z = (const bf16_t*)(ws + WS_Z);
    LAS float* gbuf = (LAS float*)lds;
    LAS float* cbuf = gbuf + 46 * 512;
    const int c = tid, rowbase = u * 16, t0 = rowbase & (SEQ - 1);
    {
        u32x4 r1[6], r2[6];
#pragma unroll
        for (int k = 0; k < 6; ++k) { const int i = tid + 512 * k, j = i >> 6, q = i & 63; const bool ok = (i < 46 * 64) && (t0 - 30 + j >= 0);
            const size_t ro = (size_t)(rowbase - 30 + (ok ? j : 30)) * DIN + ZC_OFF + 8 * q;
            r1[k] = *(const u32x4*)(Z + ro); r2[k] = *(const u32x4*)(Z + ro + CW);
            if (!ok) { r1[k] = (u32x4){0u, 0u, 0u, 0u}; } }
#pragma unroll
        for (int k = 0; k < 6; ++k) { const int i = tid + 512 * k, j = i >> 6, q = i & 63;
            if (i < 46 * 64) { f32x4 g0, g1;
                g0[0] = bflo(r1[k].x) * sigmoidf_(bflo(r2[k].x)); g0[1] = bfhi(r1[k].x) * sigmoidf_(bfhi(r2[k].x));
                g0[2] = bflo(r1[k].y) * sigmoidf_(bflo(r2[k].y)); g0[3] = bfhi(r1[k].y) * sigmoidf_(bfhi(r2[k].y));
                g1[0] = bflo(r1[k].z) * sigmoidf_(bflo(r2[k].z)); g1[1] = bfhi(r1[k].z) * sigmoidf_(bfhi(r2[k].z));
                g1[2] = bflo(r1[k].w) * sigmoidf_(bflo(r2[k].w)); g1[3] = bfhi(r1[k].w) * sigmoidf_(bfhi(r2[k].w));
                *(LAS f32x4*)(gbuf + j * 512 + 8 * q) = g0; *(LAS f32x4*)(gbuf + j * 512 + 8 * q + 4) = g1; } }
    }
    __syncthreads();
    float w[CK]; const float* cdw = AIN(I_CDW);
#pragma unroll
    for (int j = 0; j < CK; ++j) w[j] = cdw[(size_t)l * CK * CW + j * CW + c];
    for (int t = 0; t < 16; ++t) { float acc = 0.f;
#pragma unroll
        for (int j = 0; j < CK; ++j) acc = fmaf(w[j], gbuf[(t + j) * 512 + c], acc);
        cbuf[t * 512 + c] = acc; }
    __syncthreads();
    {
        const float* lg = AIN(I_CLNG) + l * CW + lane * 8; const float* lb = AIN(I_CLNB) + l * CW + lane * 8;
        const f32x4 g0 = *(const f32x4*)lg, g1 = *(const f32x4*)(lg + 4), b0 = *(const f32x4*)lb, b1 = *(const f32x4*)(lb + 4);
        bf16_t* SC = (bf16_t*)(ws + WS_SCONV);
#pragma unroll
        for (int q = 0; q < 2; ++q) { const int tt = wave + 8 * q;
            f32x4 v0 = *(const LAS f32x4*)(cbuf + tt * 512 + lane * 8), v1 = *(const LAS f32x4*)(cbuf + tt * 512 + lane * 8 + 4);
            const float mean = wave_sum((v0[0] + v0[1]) + (v0[2] + v0[3]) + (v1[0] + v1[1]) + (v1[2] + v1[3])) * (1.f / CW);
            v0 = v0 - mean; v1 = v1 - mean;
            const float var = wave_sum((v0[0] * v0[0] + v0[1] * v0[1]) + (v0[2] * v0[2] + v0[3] * v0[3]) + (v1[0] * v1[0] + v1[1] * v1[1]) + (v1[2] * v1[2] + v1[3] * v1[3])) * (1.f / CW);
            const float rstd = __builtin_amdgcn_rsqf(var + LN_EPS);
            v0 = v0 * rstd * g0 + b0; v1 = v1 * rstd * g1 + b1;
            float y[8] = {v0[0], v0[1], v0[2], v0[3], v1[0], v1[1], v1[2], v1[3]};
#pragma unroll
            for (int k = 0; k < 8; ++k) y[k] = y[k] * sigmoidf_(y[k]);
            u32x4 o; o.x = cvt_pk_bf16(y[0], y[1]); o.y = cvt_pk_bf16(y[2], y[3]); o.z = cvt_pk_bf16(y[4], y[5]); o.w = cvt_pk_bf16(y[6], y[7]);
            *(u32x4*)(SC + (size_t)(rowbase + tt) * CW + lane * 8) = o; }
    }
    {
        const float* rcw = AIN(I_RCW) + (size_t)l * 4 * RW + c;
        const float w0 = rcw[0], w1 = rcw[RW], w2 = rcw[2 * RW], w3 = rcw[3 * RW];
        const float bias = AIN(I_RCB)[l * RW + c];
        bf16_t* XC = (bf16_t*)(ws + WS_XC);
        float xs[19];
#pragma unroll
        for (int t = 0; t < 19; ++t) { const bool ok = (t >= 3) || (t0 >= 3); xs[t] = ok ? bf2f(Z[(size_t)(rowbase - 3 + t) * DIN + ZRX_OFF + c]) : 0.f; }
#pragma unroll
        for (int t = 0; t < 16; ++t) { const float xc = fmaf(w0, xs[t], fmaf(w1, xs[t + 1], fmaf(w2, xs[t + 2], w3 * xs[t + 3]))) + bias;
            XC[(size_t)(rowbase + t) * RW + c] = (bf16_t)(cvt_pk_bf16(xc, 0.f) & 0xffffu); }
    }
    __syncthreads();
}

__device__ __forceinline__ void moe_meta(const Args& a, LAS unsigned char* lds, int tid, int l) {
    volatile LAS int* meta = (volatile LAS int*)(lds + META_OFF);
    const unsigned* fill = (const unsigned*)(opaque_p(a.ws) + WS_CTL) + CW_FILL + 64 * l;
    __syncthreads();
    if (tid < 16) meta[tid] = (int)__hip_atomic_load(fill + tid, __ATOMIC_RELAXED, __HIP_MEMORY_SCOPE_AGENT);
    __syncthreads();
    if (tid == 0) { int b = 0; for (int e = 0; e < 16; ++e) { meta[16 + e] = b; b += ((meta[e] + 255) >> 8) << 8; } meta[32] = b >> 8; }
    __syncthreads();
    if (tid < 80) { int e = 0; for (int k = 1; k < 16; ++k) if (tid * 256 >= meta[16 + k]) e = k; meta[48 + tid] = e; }
    __syncthreads();
}

__global__ void __launch_bounds__(NTHREADS, 2) hybrid_fwd(Args a) {
    extern __shared__ __attribute__((aligned(16))) unsigned char lds_raw[];
    LAS unsigned char* const lds0 = (LAS unsigned char*)lds_raw;
    LAS unsigned char* lds = lds0;
    volatile LAS unsigned* MISC = (volatile LAS unsigned*)(lds + MISC_OFF);
    const int wid0 = __builtin_amdgcn_readfirstlane((int)threadIdx.x >> 6);
    const int tid = tidx(wid0), lane = tid & 63, wave = wid0;
    const int G = gridDim.x;
    unsigned char* ws = a.ws;
    unsigned* ctl = (unsigned*)(ws + WS_CTL);
    if (tid < 32) MISC[tid] = 0u;
    if (tid == 0) {
#pragma unroll
        for (int k = 0; k < 28; ++k) ((volatile LAS unsigned long long*)(lds + PTAB_OFF))[k] = (unsigned long long)a.in[k];
    }
    __syncthreads();
    XcdBarrier bar = xcd_barrier_post(ctl + CW_BAR, MISC + 8);
    const int lo = a.ph_lo, hi = a.ph_hi;
#ifndef ONLY_PH
#define ONLY_PH -1
#endif
#define PHEN(p) (ONLY_PH < 0 || ONLY_PH == (p))
#ifndef REPEAT_MASK
#define REPEAT_MASK 0
#endif
#define NREP(p) (((REPEAT_MASK >> (p)) & 1) ? 2 : 1)
#define IN(k) (lo <= (k) && (k) < hi)
#ifndef SEAM_REP
#define SEAM_REP 1
#endif
#define SEAM(k) do { if (IN(k) && IN((k) + 1)) for (int _r = 0; _r < SEAM_REP; ++_r) xcd_barrier(bar, wid0); } while (0)
    const int gw = blockIdx.x * NWAVES + wave, NGW = G * NWAVES;

    if (PHEN(0) && IN(0)) for (int rep = 0; rep < NREP(0); ++rep) { phase_prologue(a, lds, G, tid, lane, wave); __syncthreads(); }
    SEAM(0);

    for (int l = 0; l < NLAYER; ++l) {
        const int pb = 1 + l * NPH;

        if (PHEN(1) && IN(pb + 0)) for (int rep = 0; rep < NREP(1); ++rep) { unsigned char* ws = opaque_p(a.ws); LAS unsigned char* lds = opaque_p(lds0); const int bid = opaque_s((int)blockIdx.x); const int tid = tidx(wid0), lane = tid & 63, wave = __builtin_amdgcn_readfirstlane(tid >> 6), gw = bid * NWAVES + wave; (void)lane; (void)gw;
            pg8::Gemm g{ws, (unsigned)WS_XB, (unsigned)(WS_WIN + (size_t)l * DIN * DM), DM / 2, DM / 2, opaque_s(DM / 2)};
            pg8::GridOrder S; S.init(MTOK, DIN, DM / 2, DM / 2, G, bid);
            EpiZ E{(bf16_t*)(ws + WS_Z), (const float*)(ws + WS_COS), (const float*)(ws + WS_SIN)};
            pg8::gemm_phase<EpiZ, pg8::GridOrder, true, true>(lds, g, S, E, wid0);
            if (l + 1 < NLAYER && G == 256 && bid >= 128)
                f8_convert<true>(a, lds, ws, l + 1, 0, 0, 2, (unsigned*)(ws + WS_CTL) + CW_TICK + 64 * (l + 1), tid, lane, wave);
        }
        SEAM(pb + 0);

        if (PHEN(2) && IN(pb + 1)) for (int rep = 0; rep < NREP(2); ++rep) { unsigned char* ws = opaque_p(a.ws); LAS unsigned char* lds = opaque_p(lds0); const int bid = opaque_s((int)blockIdx.x); const int tid = tidx(wid0), lane = tid & 63, wave = __builtin_amdgcn_readfirstlane(tid >> 6), gw = bid * NWAVES + wave; (void)lane; (void)gw;
#ifndef NO_ATT
            att::attn_phase((char*)lds, (const bf16_t*)(ws + WS_Z), (bf16_t*)(ws + WS_OC), G, bid, wid0);
#endif
            __syncthreads();
#ifndef NO_CONV
            for (int u = bid; u < MTOK / 16; u += G) conv_unit(a, l, u, lds, tid, lane, wave);
#endif
        }
        SEAM(pb + 1);

        if (PHEN(3) && IN(pb + 2)) for (int rep = 0; rep < NREP(3); ++rep) { unsigned char* ws = opaque_p(a.ws); LAS unsigned char* lds = opaque_p(lds0); const int bid = opaque_s((int)blockIdx.x); const int tid = tidx(wid0), lane = tid & 63, wave = __builtin_amdgcn_readfirstlane(tid >> 6), gw = bid * NWAVES + wave; (void)lane; (void)gw;
            pg8::Gemm g{ws, (unsigned)WS_XC, (unsigned)(WS_WRG + (size_t)l * 4 * 256 * 128 * 2), RW, 128, opaque_s(128)};
            RgOrder S{G, bid};
            EpiGate E{(float*)(ws + WS_SA), (float*)(ws + WS_SB), (const bf16_t*)(ws + WS_XC), AIN(I_RBA) + l * RW, AIN(I_RBX) + l * RW, (const float*)(ws + WS_SP8) + l * RW, (float*)(ws + WS_SUMA), (float*)(ws + WS_SUMH)};
            pg8::gemm_phase<EpiGate, RgOrder, true>(lds, g, S, E, wid0);
            if (bid >= 128) {
                pg8::Gemm g2{ws, (unsigned)WS_SCONV, (unsigned)(WS_PW + (size_t)l * CW * CW * 2), CW, CW, CW};
                pg8::GridOrder S2; S2.init(MTOK, CW, CW, CW, G - 128, bid - 128);
                EpiBf16Off E2{ws + WS_CAT, DM, 1024};
                pg8::gemm_phase<EpiBf16Off, pg8::GridOrder, true>(lds, g2, S2, E2, wid0);
                if (l + 1 < NLAYER && G == 256)
                    f8_convert<true>(a, lds, ws, l + 1, 0, 0, bid >= 192 ? 2 : 1, (unsigned*)(ws + WS_CTL) + CW_TICK + 64 * (l + 1), tid, lane, wave);
            }
        }
        SEAM(pb + 2);

        if (PHEN(5) && IN(pb + 4)) for (int rep = 0; rep < NREP(5); ++rep) { unsigned char* ws = opaque_p(a.ws); LAS unsigned char* lds = opaque_p(lds0); const int bid = opaque_s((int)blockIdx.x); const int tid = tidx(wid0), lane = tid & 63, wave = __builtin_amdgcn_readfirstlane(tid >> 6), gw = bid * NWAVES + wave; (void)lane; (void)gw;
            unsigned char* CAT = ws + WS_CAT;
            {
                const float li = 0.8f - 0.6f * expf(-0.3f * (float)l);
                const float* q1 = AIN(I_LQ1) + l * 128 + lane; const float* k1 = AIN(I_LK1) + l * 128 + lane; const float* q2 = AIN(I_LQ2) + l * 128 + lane; const float* k2 = AIN(I_LK2) + l * 128 + lane;
                const float d1 = wave_sum(q1[0] * k1[0] + q1[64] * k1[64]);
                const float d2 = wave_sum(q2[0] * k2[0] + q2[64] * k2[64]);
                const float lam = expf(d1) - expf(d2) + li;
                const f32x4 sg = *(const f32x4*)(AIN(I_SUBLN) + l * 256 + lane * 4) * (1.f - li);
                const bf16_t* O0 = (const bf16_t*)(ws + WS_OC); const bf16_t* O1 = O0 + (size_t)MTOK * 1024;
                for (int row0 = gw; row0 < MTOK; row0 += 2 * NGW) {
                    f32x4 p0[2][4], p1[2][4];
#pragma unroll
                    for (int rr = 0; rr < 2; ++rr)
#pragma unroll
                        for (int h = 0; h < 4; ++h) { const int row = row0 + rr * NGW; const size_t off = (size_t)(row < MTOK ? row : row0) * 1024 + h * 256 + lane * 4;
                            const u32x2 a0 = *(const u32x2*)(O0 + off), a1 = *(const u32x2*)(O1 + off);
                            p0[rr][h] = (f32x4){bflo(a0.x), bfhi(a0.x), bflo(a0.y), bfhi(a0.y)}; p1[rr][h] = (f32x4){bflo(a1.x), bfhi(a1.x), bflo(a1.y), bfhi(a1.y)}; }
#pragma unroll
                    for (int rr = 0; rr < 2; ++rr) { const int row = row0 + rr * NGW;
                        if (row < MTOK) {
#pragma unroll
                            for (int h = 0; h < 4; ++h) {
                                const f32x4 o = p0[rr][h] - p1[rr][h] * lam;
                                const float ss = wave_sum((o[0] * o[0] + o[1] * o[1]) + (o[2] * o[2] + o[3] * o[3]));
                                const float r = __builtin_amdgcn_rsqf(ss * (1.f / 256.f) + LN_EPS);
                                const f32x4 y = o * r * sg;
                                *(unsigned*)(CAT + (size_t)row * DM + h * 256 + lane * 4) = cvt4_fp8(y[0] * CAT_SCALE, y[1] * CAT_SCALE, y[2] * CAT_SCALE, y[3] * CAT_SCALE); } } }
                }
            }
            {
                const float* SA = (const float*)(ws + WS_SA); const float* SB = (const float*)(ws + WS_SB);
                const float* sumA = (const float*)(ws + WS_SUMA); const float* sumH = (const float*)(ws + WS_SUMH);
                const bf16_t* Z = (const bf16_t*)(ws + WS_Z);
                for (int u = bid; u < MTOK / 32; u += G) {
                    const int j = u & 63; float carry = 0.f;
                    for (int jj0 = 0; jj0 < j; jj0 += 16) { float ca[16], ch[16];
#pragma unroll
                        for (int q = 0; q < 16; ++q) { const bool ok = jj0 + q < j; const int idx = (u - j + (ok ? jj0 + q : 0)) * RW + tid; ca[q] = sumA[idx]; ch[q] = sumH[idx]; if (!ok) { ca[q] = 1.f; ch[q] = 0.f; } }
#pragma unroll
                        for (int q = 0; q < 16; ++q) carry = fmaf(ca[q], carry, ch[q]); }
#pragma unroll
                    for (int hb = 0; hb < 2; ++hb) { float pa[16], hl[16], gx[16];
#pragma unroll
                        for (int t = 0; t < 16; ++t) { const size_t row = (size_t)u * 32 + hb * 16 + t; pa[t] = SA[row * RW + tid]; hl[t] = SB[row * RW + tid]; gx[t] = bf2f(Z[row * DIN + ZRG_OFF + tid]); }
#pragma unroll
                        for (int t = 0; t < 16; ++t) { const size_t row = (size_t)u * 32 + hb * 16 + t;
                            const float h = fmaf(pa[t], carry, hl[t]), x = gx[t];
                            const float y = 0.7978845608028654f * (x + 0.044715f * x * x * x);
                            const float th = 1.f - 2.f * __builtin_amdgcn_rcpf(__expf(2.f * y) + 1.f);
                            const float ge = 0.5f * x * (1.f + th);
                            const float cv = h * ge * CAT_SCALE; CAT[row * DM + 1536 + tid] = (unsigned char)(cvt4_fp8(cv, cv, cv, cv) & 0xffu); } }
                }
            }
        }
        SEAM(pb + 4);

        if (PHEN(6) && IN(pb + 5)) for (int rep = 0; rep < NREP(6); ++rep) { unsigned char* ws = opaque_p(a.ws); LAS unsigned char* lds = opaque_p(lds0); const int bid = opaque_s((int)blockIdx.x); const int tid = tidx(wid0), lane = tid & 63, wave = __builtin_amdgcn_readfirstlane(tid >> 6), gw = bid * NWAVES + wave; (void)lane; (void)gw;
            pg8::Gemm g{ws, (unsigned)WS_CAT, (unsigned)(WS_WOUT + (size_t)l * DM * DM), DM / 2, DM / 2, opaque_s(DM / 2)};
            pg8::GridOrder S; S.init(MTOK, DM, DM / 2, DM / 2, G, bid);
            EpiResBf16 E{(bf16_t*)(ws + WS_YBUF), (const bf16_t*)(ws + WS_XA)};
            pg8::gemm_phase<EpiResBf16, pg8::GridOrder, false, true>(lds, g, S, E, wid0);
#ifdef DUP_P6
            { if (opaque_s(1)) pg8::gemm_phase<EpiResBf16, pg8::GridOrder, true, false, 1>(lds, g, S, E, wid0); }
#endif
        }
        SEAM(pb + 5);

        if (PHEN(7) && IN(pb + 6)) for (int rep = 0; rep < NREP(7); ++rep) { unsigned char* ws = opaque_p(a.ws); LAS unsigned char* lds = opaque_p(lds0); const int bid = opaque_s((int)blockIdx.x); const int tid = tidx(wid0), lane = tid & 63, wave = __builtin_amdgcn_readfirstlane(tid >> 6), gw = bid * NWAVES + wave; (void)lane; (void)gw;
            LAS float* rwT = (LAS float*)lds;
            LAS int* hist = (LAS int*)(lds + META_OFF);
            LAS int* ent = (LAS int*)(lds + 131328);
            {
                const unsigned char* img = ws + WS_RWT;
#pragma unroll
                for (int i = 0; i < 16; ++i) __builtin_amdgcn_global_load_lds((const unsigned*)(img + (size_t)(i * 8 + wave) * 1024 + lane * 16), (LAS unsigned*)(lds + (i * 8 + wave) * 1024), 16, 0, 0);
                if (wave == 0) __builtin_amdgcn_global_load_lds((const unsigned*)(img + (size_t)128 * 1024 + lane * 16), (LAS unsigned*)(lds + 128 * 1024), 16, 0, 0);
            }
            float rb[16]; const float* rtb = AIN(I_RTB);
#pragma unroll
            for (int e = 0; e < 16; ++e) rb[e] = rtb[e];
            const bf16_t* YB = (const bf16_t*)(ws + WS_YBUF); bf16_t* X1B = (bf16_t*)(ws + WS_X1B);
            int* tokE = (int*)(ws + WS_TOKE); int* tokP = (int*)(ws + WS_TOKS); int* lst = (int*)(ws + WS_LIST); float* lstW = (float*)(ws + WS_LISTW); unsigned char* X1F = ws + WS_XG;
            unsigned* fill = (unsigned*)(ws + WS_CTL) + CW_FILL + 64 * l;
            const float* lg = AIN(I_LN1G) + l * DM; const float* lb = AIN(I_LN1B) + l * DM;
            for (int v = bid; v < 256; v += G) {
                __syncthreads();
                if (tid < 16) hist[tid] = 0;
                __syncthreads();
                u32x2 raw[4][8];
#pragma unroll
                for (int q = 0; q < 4; ++q)
#pragma unroll
                    for (int j = 0; j < 8; ++j) raw[q][j] = *(const u32x2*)(YB + (size_t)(v * 32 + wave + 8 * q) * DM + j * 256 + lane * 4);
                asm volatile("s_waitcnt vmcnt(0)" ::: "memory"); __syncthreads();
#pragma unroll
                for (int q = 0; q < 4; ++q) {
                    __builtin_amdgcn_sched_barrier(0);
                    const int row = v * 32 + wave + 8 * q;
                    f32x4 y[8]; float s = 0.f;
#pragma unroll
                    for (int j = 0; j < 8; ++j) { const u32x2 p = raw[q][j]; y[j] = (f32x4){bflo(p.x), bfhi(p.x), bflo(p.y), bfhi(p.y)}; s += (y[j][0] + y[j][1]) + (y[j][2] + y[j][3]); }
                    const float mean = wave_sum(s) * (1.f / DM); float s2 = 0.f;
#pragma unroll
                    for (int j = 0; j < 8; ++j) { y[j] = y[j] - mean; s2 += (y[j][0] * y[j][0] + y[j][1] * y[j][1]) + (y[j][2] * y[j][2] + y[j][3] * y[j][3]); }
                    const float rstd = __builtin_amdgcn_rsqf(wave_sum(s2) * (1.f / DM) + LN_EPS);
#pragma unroll
                    for (int j = 0; j < 8; ++j) { const f32x4 gg = *(const f32x4*)(lg + j * 256 + lane * 4), bb = *(const f32x4*)(lb + j * 256 + lane * 4);
                        y[j] = y[j] * rstd * gg + bb;
                        u32x2 w; w.x = cvt_pk_bf16(y[j][0], y[j][1]); w.y = cvt_pk_bf16(y[j][2], y[j][3]);
                        *(u32x2*)(X1B + (size_t)row * DM + j * 256 + lane * 4) = w;
                        *(unsigned*)(X1F + (size_t)row * DM + j * 256 + lane * 4) = cvt4_fp8(y[j][0], y[j][1], y[j][2], y[j][3]); }
                    float acc[16];
#pragma unroll
                    for (int e = 0; e < 16; ++e) acc[e] = 0.f;
#pragma unroll
                    for (int j = 0; j < 8; ++j)
#pragma unroll
                        for (int e = 0; e < 16; ++e) { const f32x4 w = *(const LAS f32x4*)(rwT + e * 2052 + j * 256 + lane * 4);
                            acc[e] += (y[j][0] * w[0] + y[j][1] * w[1]) + (y[j][2] * w[2] + y[j][3] * w[3]); }
                    float sc[16], bi[16];
#pragma unroll
                    for (int e = 0; e < 16; ++e) { acc[e] = wave_sum(acc[e]); sc[e] = sigmoidf_(acc[e]); bi[e] = sc[e] + rb[e]; }
                    float bgs = -__builtin_inff(); int e1 = 0, e2 = 1; float s1 = 0.f, sv2 = 0.f;
#pragma unroll
                    for (int g = 0; g < 4; ++g) {
                        const float b0 = bi[4 * g], b1 = bi[4 * g + 1], b2 = bi[4 * g + 2], b3 = bi[4 * g + 3];
                        const float t0 = sc[4 * g], t1 = sc[4 * g + 1], t2 = sc[4 * g + 2], t3 = sc[4 * g + 3];
                        int i1 = 0; float m1 = b0, c1 = t0;
                        if (b1 > m1) { m1 = b1; i1 = 1; c1 = t1; } if (b2 > m1) { m1 = b2; i1 = 2; c1 = t2; } if (b3 > m1) { m1 = b3; i1 = 3; c1 = t3; }
                        int i2 = 0; float m2 = -__builtin_inff(), c2 = 0.f;
                        if (i1 != 0 && b0 > m2) { m2 = b0; i2 = 0; c2 = t0; } if (i1 != 1 && b1 > m2) { m2 = b1; i2 = 1; c2 = t1; }
                        if (i1 != 2 && b2 > m2) { m2 = b2; i2 = 2; c2 = t2; } if (i1 != 3 && b3 > m2) { m2 = b3; i2 = 3; c2 = t3; }
                        const float gs = m1 + m2;
                        if (gs > bgs) { bgs = gs; e1 = 4 * g + i1; e2 = 4 * g + i2; s1 = c1; sv2 = c2; }
                    }
                    if (lane == 0) { const float inv = 1.f / (s1 + sv2); const int rl = wave + 8 * q;
                        const int r1 = __hip_atomic_fetch_add(hist + e1, 1, __ATOMIC_RELAXED, __HIP_MEMORY_SCOPE_WORKGROUP), r2 = __hip_atomic_fetch_add(hist + e2, 1, __ATOMIC_RELAXED, __HIP_MEMORY_SCOPE_WORKGROUP);
                        ent[rl * 6 + 0] = e1; ent[rl * 6 + 1] = r1; ent[rl * 6 + 2] = __float_as_int(s1 * inv); ent[rl * 6 + 3] = e2; ent[rl * 6 + 4] = r2; ent[rl * 6 + 5] = __float_as_int(sv2 * inv); }
                }
                __syncthreads();
                if (tid < 16) hist[16 + tid] = (int)__hip_atomic_fetch_add(fill + tid, (unsigned)hist[tid], __ATOMIC_RELAXED, __HIP_MEMORY_SCOPE_AGENT);
                __syncthreads();
                if (tid < 64) { const int rl = tid >> 1, k = tid & 1, e = ent[rl * 6 + 3 * k], p = hist[16 + e] + ent[rl * 6 + 3 * k + 1], row = v * 32 + rl;
                    lst[e * MTOK + p] = row; lstW[e * MTOK + p] = __int_as_float(ent[rl * 6 + 3 * k + 2]); tokE[row * 2 + k] = e; tokP[row * 2 + k] = p; }
            }
            __syncthreads();
        }
        SEAM(pb + 6);

        if (PHEN(9) && IN(pb + 8)) for (int rep = 0; rep < NREP(9); ++rep) { unsigned char* ws = opaque_p(a.ws); LAS unsigned char* lds = opaque_p(lds0); const int bid = opaque_s((int)blockIdx.x); const int tid = tidx(wid0), lane = tid & 63, wave = __builtin_amdgcn_readfirstlane(tid >> 6), gw = bid * NWAVES + wave; (void)lane; (void)gw;
            moe_meta(a, lds, tid, l);
            volatile LAS int* meta = (volatile LAS int*)(lds + META_OFF);
            const int tot = meta[32] * 8, F = 2 * G;
            pg8::Gemm g{ws, (unsigned)WS_XG, (unsigned)(WS_W1 + (size_t)l * NEXP * 2048 * DM), DM / 2, DM / 2, opaque_s(DM / 2)};
            MoeOrder<true> S{G, bid, 0, tot < F ? tot : F, DM / 2, DM / 2, meta, (unsigned)(2048 * DM), G == 256 && tot >= 512, (const int*)(ws + WS_LIST)};
            EpiSwiGLU E{ws + WS_HB};
            pg8::gemm_phase<EpiSwiGLU, MoeOrder<true>, true, true>(lds, g, S, E, wid0);
        }
        SEAM(pb + 8);
        if (PHEN(10) && IN(pb + 9)) for (int rep = 0; rep < NREP(10); ++rep) { unsigned char* ws = opaque_p(a.ws); LAS unsigned char* lds = opaque_p(lds0); const int bid = opaque_s((int)blockIdx.x); const int tid = tidx(wid0), lane = tid & 63, wave = __builtin_amdgcn_readfirstlane(tid >> 6), gw = bid * NWAVES + wave; (void)lane; (void)gw;
#if N_LAUNCH_MODE != 1
            moe_meta(a, lds, tid, l);
#endif
            volatile LAS int* meta = (volatile LAS int*)(lds + META_OFF);
            const int tot = meta[32] * 8, F = 2 * G, R = tot > F ? tot - F : 0, done8 = (tot < F ? tot : F) & ~7;
            if (bid < R) {
                pg8::Gemm g{ws, (unsigned)WS_XG, (unsigned)(WS_W1 + (size_t)l * NEXP * 2048 * DM), DM / 2, DM / 2, opaque_s(DM / 2)};
                MoeOrder<true> S{G, bid, F, tot, DM / 2, DM / 2, meta, (unsigned)(2048 * DM), false, (const int*)(ws + WS_LIST)};
                EpiSwiGLU E{ws + WS_HB};
                pg8::gemm_phase<EpiSwiGLU, MoeOrder<true>, true, true, 1>(lds, g, S, E, wid0);
            } else {
                const int Gp = G - R; int hiB = 2 * Gp; if (hiB > done8) hiB = done8; if (hiB < 0) hiB = 0;
                pg8::Gemm g{ws, (unsigned)WS_HB, (unsigned)(WS_W2 + (size_t)l * NEXP * DM * DEXP), DEXP / 2, DEXP / 2, opaque_s(DEXP / 2)};
                MoeOrder<false> S{Gp, bid - R, 0, hiB, DEXP / 2, DEXP / 2, meta, (unsigned)(DM * DEXP), false, nullptr};
                EpiScaleBf16 E{ws + WS_Y2, (const float*)(ws + WS_LISTW)};
                pg8::gemm_phase<EpiScaleBf16, MoeOrder<false>, true, true, 1>(lds, g, S, E, wid0);
            }
        }
        SEAM(pb + 9);
        if (PHEN(11) && IN(pb + 10)) for (int rep = 0; rep < NREP(11); ++rep) { unsigned char* ws = opaque_p(a.ws); LAS unsigned char* lds = opaque_p(lds0); const int bid = opaque_s((int)blockIdx.x); const int tid = tidx(wid0), lane = tid & 63, wave = __builtin_amdgcn_readfirstlane(tid >> 6), gw = bid * NWAVES + wave; (void)lane; (void)gw;
#if N_LAUNCH_MODE != 1
            moe_meta(a, lds, tid, l);
#endif
            volatile LAS int* meta = (volatile LAS int*)(lds + META_OFF);
            const int tot = meta[32] * 8, F = 2 * G, R = tot > F ? tot - F : 0, done8 = (tot < F ? tot : F) & ~7;
            int hiB = 2 * (G - R); if (hiB > done8) hiB = done8; if (hiB < 0) hiB = 0;
            pg8::Gemm g{ws, (unsigned)WS_HB, (unsigned)(WS_W2 + (size_t)l * NEXP * DM * DEXP), DEXP / 2, DEXP / 2, opaque_s(DEXP / 2)};
            MoeOrder<false> S{G, bid, hiB, tot, DEXP / 2, DEXP / 2, meta, (unsigned)(DM * DEXP), false, nullptr};
            EpiScaleBf16 E{ws + WS_Y2, (const float*)(ws + WS_LISTW)};
            pg8::gemm_phase<EpiScaleBf16, MoeOrder<false>, true, true>(lds, g, S, E, wid0);
            if (l + 1 < NLAYER && G == 256 && bid >= tot - hiB)
                f8_convert<true>(a, lds, ws, l + 1, 0, 0, 1, (unsigned*)(ws + WS_CTL) + CW_TICK + 64 * (l + 1), tid, lane, wave);
        }
        SEAM(pb + 10);

        if (PHEN(12) && IN(pb + 11)) for (int rep = 0; rep < NREP(12); ++rep) { unsigned char* ws = opaque_p(a.ws); LAS unsigned char* lds = opaque_p(lds0); const int bid = opaque_s((int)blockIdx.x); const int tid = tidx(wid0), lane = tid & 63, wave = __builtin_amdgcn_readfirstlane(tid >> 6), gw = bid * NWAVES + wave; (void)lane; (void)gw;
            const bool lastl = (l == NLAYER - 1); bf16_t* XA16 = (bf16_t*)(ws + WS_XA);
            const bf16_t* X1B = (const bf16_t*)(ws + WS_X1B); const unsigned char* Y2 = ws + WS_Y2; const int* tokS = (const int*)(ws + WS_TOKS); const int* tokE = (const int*)(ws + WS_TOKE);
#if N_LAUNCH_MODE != 1
            moe_meta(a, lds, tid, l);
#endif
            volatile LAS int* meta = (volatile LAS int*)(lds + META_OFF);
            unsigned char* XB = ws + WS_XB;
            const float* lg = AIN(I_LN2G) + l * DM; const float* lb = AIN(I_LN2B) + l * DM;
            for (int row0 = gw; row0 < MTOK; row0 += 2 * NGW) {
                int sl[2][2];
#pragma unroll
                for (int rr = 0; rr < 2; ++rr) { const int row = row0 + rr * NGW; sl[rr][0] = meta[16 + tokE[row * 2]] + tokS[row * 2]; sl[rr][1] = meta[16 + tokE[row * 2 + 1]] + tokS[row * 2 + 1]; }
                u32x2 xw[2][8]; unsigned pw_[2][8], qw[2][8];
#pragma unroll
                for (int rr = 0; rr < 2; ++rr) { const int row = row0 + rr * NGW;
#pragma unroll
                    for (int j = 0; j < 8; ++j) { xw[rr][j] = *(const u32x2*)(X1B + (size_t)row * DM + j * 256 + lane * 4);
                        pw_[rr][j] = *(const unsigned*)(Y2 + (size_t)sl[rr][0] * DM + j * 256 + lane * 4); qw[rr][j] = *(const unsigned*)(Y2 + (size_t)sl[rr][1] * DM + j * 256 + lane * 4); } }
#pragma unroll
                for (int rr = 0; rr < 2; ++rr) { const int row = row0 + rr * NGW;
                    f32x4 y[8]; float s = 0.f;
#pragma unroll
                    for (int j = 0; j < 8; ++j) { const u32x2 x = xw[rr][j]; const int p = (int)pw_[rr][j], q = (int)qw[rr][j];
                        const f32x2 p0 = __builtin_amdgcn_cvt_pk_f32_fp8(p, false), p1 = __builtin_amdgcn_cvt_pk_f32_fp8(p, true), q0 = __builtin_amdgcn_cvt_pk_f32_fp8(q, false), q1 = __builtin_amdgcn_cvt_pk_f32_fp8(q, true);
                        y[j][0] = bflo(x.x) * ALPHA + (p0.x + q0.x) * (1.f / Y2_SCALE); y[j][1] = bfhi(x.x) * ALPHA + (p0.y + q0.y) * (1.f / Y2_SCALE);
                        y[j][2] = bflo(x.y) * ALPHA + (p1.x + q1.x) * (1.f / Y2_SCALE); y[j][3] = bfhi(x.y) * ALPHA + (p1.y + q1.y) * (1.f / Y2_SCALE);
                        s += (y[j][0] + y[j][1]) + (y[j][2] + y[j][3]); }
                    const float mean = wave_sum(s) * (1.f / DM); float s2 = 0.f;
#pragma unroll
                    for (int j = 0; j < 8; ++j) { y[j] = y[j] - mean; s2 += (y[j][0] * y[j][0] + y[j][1] * y[j][1]) + (y[j][2] * y[j][2] + y[j][3] * y[j][3]); }
                    const float rstd = __builtin_amdgcn_rsqf(wave_sum(s2) * (1.f / DM) + LN_EPS);
#pragma unroll
                    for (int j = 0; j < 8; ++j) { const f32x4 gg = *(const f32x4*)(lg + j * 256 + lane * 4), bb = *(const f32x4*)(lb + j * 256 + lane * 4);
                        y[j] = y[j] * rstd * gg + bb;
                        if (lastl) *(f32x4*)(a.out + (size_t)row * DM + j * 256 + lane * 4) = y[j];
                        else { u32x2 w; w.x = cvt_pk_bf16(y[j][0], y[j][1]); w.y = cvt_pk_bf16(y[j][2], y[j][3]); *(u32x2*)(XA16 + (size_t)row * DM + j * 256 + lane * 4) = w; }
                        *(unsigned*)(XB + (size_t)row * DM + j * 256 + lane * 4) = cvt4_fp8(y[j][0], y[j][1], y[j][2], y[j][3]); }
                }
            }
            if (l + 1 < NLAYER)
                f8_convert<true>(a, lds, ws, l + 1, 0, 0, 1 << 30, (unsigned*)(ws + WS_CTL) + CW_TICK + 64 * (l + 1), tid, lane, wave);
        }
        SEAM(pb + 11);
    }
#undef IN
#undef SEAM
}

extern "C" void kernel_launch(void* const* d_in, const int* in_sizes, int n_in, void* d_out, int out_size, void* d_ws, size_t ws_size, hipStream_t stream) {
    static int grid = 0;
    if (grid == 0) {
        if (n_in != 28 || out_size != MTOK * DM || ws_size < WS_END) { fprintf(stderr, "kernel_launch: unexpected shapes (n_in %d out %d ws %zu)\n", n_in, out_size, ws_size); grid = -1; return; }
        int dev = 0, cus = 0, per_cu = 0;
        if (hipGetDevice(&dev) != hipSuccess || hipDeviceGetAttribute(&cus, hipDeviceAttributeMultiprocessorCount, dev) != hipSuccess) { grid = -1; return; }
        if (hipFuncSetAttribute((const void*)hybrid_fwd, hipFuncAttributeMaxDynamicSharedMemorySize, LDS_BYTES) != hipSuccess) { fprintf(stderr, "kernel_launch: hipFuncSetAttribute failed\n"); grid = -1; return; }
        if (hipOccupancyMaxActiveBlocksPerMultiprocessor(&per_cu, (const void*)hybrid_fwd, NTHREADS, LDS_BYTES) != hipSuccess || per_cu < 1) { fprintf(stderr, "kernel_launch: occupancy query says %d\n", per_cu); (void)hipGetLastError(); grid = -1; return; }
        grid = cus < 256 ? cus : 256;
    }
    if (grid < 0) return;
    (void)hipMemsetAsync((char*)d_ws + WS_CTL, 0, CTL_ZERO_BYTES, stream);
    Args a{};
    for (int i = 0; i < 28; ++i) a.in[i] = (const float*)d_in[i];
    a.out = (float*)d_out; a.ws = (unsigned char*)d_ws;
#if N_LAUNCH_MODE == 1
    a.ph_lo = 0; a.ph_hi = NPHASES;
    hipLaunchKernelGGL(hybrid_fwd, dim3(grid), dim3(NTHREADS), LDS_BYTES, stream, a);
#else
    for (int p = 0; p < NPHASES; ++p) { a.ph_lo = p; a.ph_hi = p + 1; hipLaunchKernelGGL(hybrid_fwd, dim3(grid), dim3(NTHREADS), LDS_BYTES, stream, a); }
#endif
}
```

```cpp
#include <hip/hip_runtime.h>
#include <cstdio>
#include <cstdint>

#ifndef N_LAUNCH_MODE
#define N_LAUNCH_MODE 1
#endif

#define GAS __attribute__((address_space(1)))
#define LAS __attribute__((address_space(3)))
typedef unsigned short bf16_t;
typedef short bf16x8 __attribute__((ext_vector_type(8)));
typedef short s16x4 __attribute__((ext_vector_type(4)));
typedef float f32x2 __attribute__((ext_vector_type(2)));
typedef int int4_t __attribute__((ext_vector_type(4)));
typedef float f32x4 __attribute__((ext_vector_type(4)));
typedef float f32x16 __attribute__((ext_vector_type(16)));
typedef unsigned u32x2 __attribute__((ext_vector_type(2)));
typedef unsigned u32x4 __attribute__((ext_vector_type(4)));
typedef int i32x4 __attribute__((ext_vector_type(4)));
typedef int i32x8 __attribute__((ext_vector_type(8)));

constexpr int DM = 2048, NBATCH = 4, SEQ = 2048, NLAYER = 4, MTOK = NBATCH * SEQ;
constexpr int DIN = 5120, ZK_OFF = 1024, ZV_OFF = 2048, ZC_OFF = 3072, ZRX_OFF = 4096, ZRG_OFF = 4608;
constexpr int CW = 512, RW = 512, NEXP = 16, DEXP = 1024, CK = 31;
constexpr float ALPHA = 1.6817928305074290f;
constexpr float LN_EPS = 1e-5f;
constexpr int NWAVES = 8, NTHREADS = 512;
constexpr int MOE_ROWS = 20480;
constexpr float W1_SCALE = 32.f, W2_SCALE = 64.f, H_SCALE = 4.f, WIN_SCALE = 32.f, WOUT_SCALE = 64.f, CAT_SCALE = 4.f, Y2_SCALE = 16.f;

constexpr size_t MiB = 1u << 20;
constexpr size_t WS_CTL = 0, CTL_ZERO_BYTES = 1 * MiB;
constexpr size_t WS_COS = 1 * MiB;
constexpr size_t WS_SIN = WS_COS + 512 * 1024;
constexpr size_t WS_SP8 = 2 * MiB;
constexpr size_t WS_TOKE = WS_SP8 + 64 * 1024;
constexpr size_t WS_TOKW = WS_TOKE + 64 * 1024;
constexpr size_t WS_TOKS = WS_TOKW + 64 * 1024;
constexpr size_t WS_SLOTW = WS_TOKS + 64 * 1024;
constexpr size_t WS_CNT = WS_SLOTW + 128 * 1024;
constexpr size_t WS_SUMA = 3 * MiB;
constexpr size_t WS_SUMH = WS_SUMA + 512 * 1024;
constexpr size_t WS_WIN = 8 * MiB;
constexpr size_t WS_WOUT = 88 * MiB;
constexpr size_t WS_PW = 120 * MiB;
constexpr size_t WS_WRG = 122 * MiB;
constexpr size_t WS_W1 = 128 * MiB;
constexpr size_t WS_W2 = 640 * MiB;
constexpr size_t WS_XA = 896 * MiB;
constexpr size_t WS_X1 = 960 * MiB;
constexpr size_t WS_XB = 1024 * MiB;
constexpr size_t WS_X1B = 1056 * MiB;
constexpr size_t WS_Z = 1088 * MiB;
constexpr size_t WS_OC = 1168 * MiB;
constexpr size_t WS_SCONV = 1232 * MiB;
constexpr size_t WS_XC = 1240 * MiB;
constexpr size_t WS_SA = 1248 * MiB;
constexpr size_t WS_SB = 1264 * MiB;
constexpr size_t WS_CAT = 1280 * MiB;
constexpr size_t WS_YBUF = 1312 * MiB;
constexpr size_t WS_XG = 1376 * MiB;
constexpr size_t WS_HB = 1456 * MiB;
constexpr size_t WS_Y2 = 1496 * MiB;
constexpr size_t WS_END = 1576 * MiB;
constexpr int CW_TMO = 0, CW_FLAG = 2048, CW_BAR = 4096, CW_FILL = 8192, CW_TICK = 9216; constexpr unsigned CTL_MAGIC = 0x51C0FFEEu;
constexpr int CW_TMO_ = 0;
constexpr size_t WS_LIST = 5 * MiB;
constexpr size_t WS_LISTW = 6 * MiB;
constexpr size_t WS_RWT = 7 * MiB;

constexpr int RING_BYTES = 131072;
constexpr int META_OFF = 132096;
constexpr int MISC_OFF = 132608;
constexpr int LDS_BYTES = 147456;

__device__ __forceinline__ unsigned cvt_pk_bf16(float lo, float hi) { unsigned r; asm volatile("v_cvt_pk_bf16_f32 %0, %1, %2" : "=v"(r) : "v"(lo), "v"(hi)); return r; }
__device__ __forceinline__ unsigned cvt4_fp8(float a, float b, float c, float d) {
    a = __builtin_amdgcn_fmed3f(a, -448.f, 448.f); b = __builtin_amdgcn_fmed3f(b, -448.f, 448.f); c = __builtin_amdgcn_fmed3f(c, -448.f, 448.f); d = __builtin_amdgcn_fmed3f(d, -448.f, 448.f);
    int w = 0; w = __builtin_amdgcn_cvt_pk_fp8_f32(a, b, w, false); w = __builtin_amdgcn_cvt_pk_fp8_f32(c, d, w, true); return (unsigned)w; }
__device__ __forceinline__ float bf2f(unsigned short b) { return __uint_as_float((unsigned)b << 16); }
__device__ __forceinline__ float bflo(unsigned w) { return __uint_as_float(w << 16); }
__device__ __forceinline__ float bfhi(unsigned w) { return __uint_as_float(w & 0xffff0000u); }
__device__ __forceinline__ float wave_sum(float v) {
#define WS_STEP(ctrl) v += __int_as_float(__builtin_amdgcn_update_dpp(0, __float_as_int(v), (ctrl), 0xf, 0xf, true))
    WS_STEP(0xB1); WS_STEP(0x4E); WS_STEP(0x124); WS_STEP(0x128);
#undef WS_STEP
    const auto r16 = __builtin_amdgcn_permlane16_swap(__float_as_uint(v), __float_as_uint(v), false, false);
    v = __uint_as_float(r16[0]) + __uint_as_float(r16[1]);
    const auto rr = __builtin_amdgcn_permlane32_swap(__float_as_uint(v), __float_as_uint(v), false, false);
    return __uint_as_float(rr[0]) + __uint_as_float(rr[1]);
}
__device__ __forceinline__ float sigmoidf_(float x) { return __builtin_amdgcn_rcpf(1.f + __expf(-x)); }
#define LDS_WAIT() asm volatile("s_waitcnt lgkmcnt(0)" ::: "memory")
constexpr int PTAB_OFF = 132736;
__device__ __forceinline__ const float* ldptr(LAS unsigned char* lds, int k) {
    int off = PTAB_OFF + 8 * k; asm volatile("" : "+s"(off));
    const unsigned long long v = *(volatile LAS unsigned long long*)(lds + off);
    const unsigned lo = __builtin_amdgcn_readfirstlane((unsigned)v), hi = __builtin_amdgcn_readfirstlane((unsigned)(v >> 32));
    return (const float*)(const GAS float*)(((unsigned long long)hi << 32) | lo);
}
template <class T> __device__ __forceinline__ T* opaque_p(T* p) { asm volatile("" : "+s"(p)); return p; }
__device__ __forceinline__ int tidx(int wid) { int l; asm volatile("v_mbcnt_lo_u32_b32 %0, -1, 0\n\tv_mbcnt_hi_u32_b32 %0, -1, %0" : "=v"(l)); return (wid << 6) + l; }
__device__ __forceinline__ int opaque_s(int v) { asm volatile("" : "+s"(v)); return v; }

#define XB_TMO      128
#define XB_XCNT(j)  (256  + 64 * (j))
#define XB_XSUB(j)  (1280 + 64 * (j))
#define XB_XGEN(j)  (2304 + 64 * (j))
#define XB_TOP      3328
#define XB_TOPGEN   3392
#define XCD_BAR_WORDS 3456
#define XB_SPIN_CAP (1u << 18)
__device__ __forceinline__ unsigned xb_ld(unsigned* p)              { return __hip_atomic_load(p, __ATOMIC_RELAXED, __HIP_MEMORY_SCOPE_AGENT); }
__device__ __forceinline__ unsigned xb_add(unsigned* p, unsigned v) { return __hip_atomic_fetch_add(p, v, __ATOMIC_RELAXED, __HIP_MEMORY_SCOPE_AGENT); }
__device__ __forceinline__ unsigned xb_xcc_id() { return (unsigned)__builtin_amdgcn_s_getreg((3 << 11) | 20) & 0xFu; }
#define XB_SPIN(cond, bar) do { unsigned _sp = 0; while (cond) { __builtin_amdgcn_s_sleep(1); \
    if ((++_sp & 255u) == 0u) { if (xb_ld(&(bar)[XB_TMO])) break; if (_sp > XB_SPIN_CAP) { atomicAdd(&(bar)[XB_TMO], 1u); break; } } } } while (0)
struct XcdBarrier { unsigned* bar; unsigned x; volatile LAS unsigned* st; };
__device__ __forceinline__ XcdBarrier xcd_barrier_post(unsigned* bar, volatile LAS unsigned* st) {
    XcdBarrier b; b.bar = bar; b.x = xb_xcc_id(); b.st = st;
    if (threadIdx.x == 0) (void)xb_add(&bar[XB_XCNT(b.x)], 1u);
    return b;
}
__device__ __forceinline__ void xcd_barrier_complete(unsigned* bar, unsigned x, unsigned& nloc, unsigned& nx) {
    const unsigned G = gridDim.x * gridDim.y * gridDim.z;
    asm volatile("" : "+s"(x));
    unsigned sum, cnt, mine, sp = 0u;
    for (;;) {
        sum = 0u; cnt = 0u; mine = 0u;
#pragma unroll
        for (unsigned j = 0; j < 16; ++j) { const unsigned c = xb_ld(&bar[XB_XCNT(j)]); sum += c; cnt += (c > 0u) ? 1u : 0u; mine = (j == x) ? c : mine; }
        if (sum == G) break;
        __builtin_amdgcn_s_sleep(1);
        if ((++sp & 255u) == 0u) { if (xb_ld(&bar[XB_TMO])) break; if (sp > XB_SPIN_CAP) { atomicAdd(&bar[XB_TMO], 1u); break; } }
    }
    nloc = mine > 0u ? mine : 1u; nx = cnt > 0u ? cnt : 1u;
}
__device__ __forceinline__ void xcd_barrier(const XcdBarrier& b, int wid0) {
    asm volatile("s_waitcnt vmcnt(0)" ::: "memory");
    __syncthreads();
    if (tidx(wid0) == 0) {
        unsigned* bar = opaque_p(b.bar);
        __builtin_amdgcn_s_waitcnt(0);
        unsigned nloc = b.st[0], nx = b.st[1];
        if (nloc == 0u) { xcd_barrier_complete(bar, b.x, nloc, nx); b.st[0] = nloc; b.st[1] = nx; }
        const unsigned old = xb_add(&bar[XB_XSUB(b.x)], 1u);
        const unsigned gen = old / nloc;
        if (old + 1u == (gen + 1u) * nloc) {
            __builtin_amdgcn_fence(__ATOMIC_RELEASE, "agent");
            asm volatile("s_waitcnt vmcnt(0)" ::: "memory");
            const unsigned og = xb_add(&bar[XB_TOP], 1u);
            const unsigned tg = og / nx;
            if (og + 1u == (tg + 1u) * nx) xb_add(&bar[XB_TOPGEN], 1u);
            else XB_SPIN(xb_ld(&bar[XB_TOPGEN]) == tg, bar);
            __builtin_amdgcn_fence(__ATOMIC_ACQUIRE, "agent");
            xb_add(&bar[XB_XGEN(b.x)], 1u);
            asm volatile("s_waitcnt vmcnt(0)" ::: "memory");
        } else {
            XB_SPIN(xb_ld(&bar[XB_XGEN(b.x)]) == gen, bar);
            __builtin_amdgcn_fence(__ATOMIC_ACQUIRE, "agent");
            asm volatile("s_waitcnt vmcnt(0)" ::: "memory");
        }
    }
    __syncthreads();
}

namespace pg8 {
constexpr int BM = 256, BK = 64, HALF = 128, HTB = HALF * BK * 2, STAGE_BYTES = 8 * HTB, NXCD = 8, WGM = 8;
__host__ __device__ __forceinline__ int lds_byte(int r, int c) { const int st = (r >> 4) * 2 + (c >> 5), rr = r & 15, cc = c & 31, ob = rr * 64 + cc * 2; return st * 1024 + (ob ^ (((ob >> 9) & 1) << 5)); }
__host__ __device__ __forceinline__ void stage_rc(int b, int& R, int& C) { const int st = b / 1024, sb = b % 1024, swz = sb ^ (((sb >> 9) & 1) << 5); R = (st >> 1) * 16 + swz / 64; C = (st & 1) * 32 + (swz % 64) / 2; }
__host__ __device__ __forceinline__ int perm32(int rho) { const int n = rho >> 4, i = rho & 15; return 8 * (i >> 2) + 4 * n + (i & 3); }

struct Unit { int pm, pn; unsigned aoff, boff; int pb, cnt, lb; };
struct Gemm { const unsigned char* base; unsigned A, Bt; int lda, ldb, K; };

struct GridOrder {
    int nM, nN, nwg, G, c; unsigned atile, btile;
    __device__ void init(int M, int N, int lda, int ldb, int G_, int c_) { nM = M / BM; nN = N / BM; nwg = nM * nN; G = G_; c = c_; atile = (unsigned)BM * lda * 2; btile = (unsigned)BM * ldb * 2; }
    __device__ bool next(int i, Unit& u) const {
        const long L = (long)i * G + c; if (L >= nwg) return false;
        int wgid = (int)L; { const int q = nwg / NXCD, r = nwg % NXCD, xcd = wgid % NXCD, off = wgid / NXCD; wgid = (xcd < r ? xcd * (q + 1) : r * (q + 1) + (xcd - r) * q) + off; }
        const int nig = WGM * nN, gid = wgid / nig, fm = gid * WGM, gsz = (nM - fm) < WGM ? (nM - fm) : WGM;
        u.pm = fm + ((wgid % nig) % gsz); u.pn = (wgid % nig) / gsz; u.aoff = (unsigned)u.pm * atile; u.boff = (unsigned)u.pn * btile; return true;
    }
    static constexpr bool GATHER = false;
    __device__ __forceinline__ unsigned arow(const Unit&, int) const { return 0u; }
    __device__ __forceinline__ void a_ready(const Unit&) const {}
    __device__ __forceinline__ void done(const Unit&) const {}
};

template <class Epi, class Sched, bool ALIGN_EPI, bool F8 = false, int COPY = 0>
__device__ __forceinline__ void gemm_phase(LAS unsigned char* lds, const Gemm g, const Sched& S, const Epi& E, int wid0) {
    const int tid = tidx(wid0), wid = __builtin_amdgcn_readfirstlane(tid >> 6), lane = tid & 63, wr = wid >> 2, wc = wid & 3, fr = lane & 15, fq = lane >> 4;
    const int K = g.K, nt = K / BK;
    unsigned vA0[2], vA1[2], nA0[2], nA1[2], voffB[2]; int Rr[2], Cc[2];
    const unsigned hsA_ = (unsigned)HALF * g.lda * 2;
#pragma unroll
    for (int i = 0; i < 2; ++i) { int R, C; stage_rc(tid * 16 + i * 8192, R, C); const int Rb = Epi::PERM ? ((R & ~31) + perm32(R & 31)) : R;
        Rr[i] = R; Cc[i] = C * 2; vA0[i] = (unsigned)(R * g.lda + C) * 2u; vA1[i] = vA0[i] + hsA_; voffB[i] = (unsigned)(Rb * g.ldb + C) * 2u; }
#define PG8_GATHER(d0, d1, U) do { _Pragma("unroll") for (int _i = 0; _i < 2; ++_i) { d0[_i] = S.arow(U, Rr[_i]) * (unsigned)(g.lda * 2) + (unsigned)Cc[_i]; d1[_i] = S.arow(U, Rr[_i] + HALF) * (unsigned)(g.lda * 2) + (unsigned)Cc[_i]; } } while (0)
    const unsigned kstep = (unsigned)(BK * 2);
    const unsigned hsB = (unsigned)HALF * g.ldb * 2;
    const __amdgpu_buffer_rsrc_t rs = __builtin_amdgcn_make_buffer_rsrc((void*)g.base, (short)0, 0x7fffffff, 0x00020000);
    const unsigned ldsw = (unsigned)wid * 1024u;
    const int aoff = lds_byte(wr * 64 + fr, fq * 8), boff = lds_byte(wc * 32 + fr, fq * 8);
#define PG8_SA(b, h) (((b) * 2 + (h)) * HTB)
#define PG8_SB(b, h) ((4 + (b) * 2 + (h)) * HTB)
#define PG8_STAGE(bufoff, soff, voff) do { _Pragma("unroll") for (int _i = 0; _i < 2; ++_i) \
        __builtin_amdgcn_raw_ptr_buffer_load_lds(rs, (LAS void*)(lds + (bufoff) + ldsw + _i * 8192), 16, (int)(voff)[_i], (int)(soff), 0, 0); } while (0)
#define PG8_LDA(dst, b, h) do { _Pragma("unroll") for (int m = 0; m < 4; ++m) { if constexpr (F8) { \
        dst##8[m].lo = *(const LAS i32x4*)(lds + PG8_SA(b, h) + aoff + m * 2048); dst##8[m].hi = *(const LAS i32x4*)(lds + PG8_SA(b, h) + aoff + m * 2048 + 1024); } else { \
        _Pragma("unroll") for (int k = 0; k < 2; ++k) dst[m][k] = *(const LAS bf16x8*)(lds + PG8_SA(b, h) + aoff + m * 2048 + k * 1024); } } } while (0)
#define PG8_LDB(dst, b, h) do { _Pragma("unroll") for (int n = 0; n < 2; ++n) { if constexpr (F8) { \
        dst##8[n].lo = *(const LAS i32x4*)(lds + PG8_SB(b, h) + boff + n * 2048); dst##8[n].hi = *(const LAS i32x4*)(lds + PG8_SB(b, h) + boff + n * 2048 + 1024); } else { \
        _Pragma("unroll") for (int k = 0; k < 2; ++k) dst[n][k] = *(const LAS bf16x8*)(lds + PG8_SB(b, h) + boff + n * 2048 + k * 1024); } } } while (0)
#define PG8_MMA(ai, bj, At, Bt) do { __builtin_amdgcn_s_setprio(1); _Pragma("unroll") for (int m = 0; m < 4; ++m) _Pragma("unroll") for (int n = 0; n < 2; ++n) _Pragma("unroll") for (int k = 0; k < 2; ++k) \
        acc[ai][bj][m][n] = __builtin_amdgcn_mfma_f32_16x16x32_bf16(Bt[n][k], At[m][k], acc[ai][bj][m][n], 0, 0, 0); __builtin_amdgcn_s_setprio(0); } while (0)
#define PG8_MMA8(ai, bj, At, Bt) do { __builtin_amdgcn_s_setprio(1); _Pragma("unroll") for (int m = 0; m < 4; ++m) _Pragma("unroll") for (int n = 0; n < 2; ++n) \
        asm volatile("v_mfma_f32_16x16x128_f8f6f4 %0, %1, %2, %0" : "+v"(acc[ai][bj][m][n]) : "v"(Bt##8[n]), "v"(At##8[m])); __builtin_amdgcn_s_setprio(0); } while (0)
#define PG8_MM(ai, bj, At, Bt) do { if constexpr (F8) PG8_MMA8(ai, bj, At, Bt); else PG8_MMA(ai, bj, At, Bt); } while (0)
#define PG8_WAIT_V(n) asm volatile("s_waitcnt vmcnt(" #n ")" ::: "memory")
#define PG8_WAIT_L(n) asm volatile("s_waitcnt lgkmcnt(" #n ")" ::: "memory")
#define PG8_BAR __builtin_amdgcn_s_barrier()
#define PG8_SCHED __builtin_amdgcn_sched_barrier(0)
    Unit cur, nxt; int ui = 0;
    if (!S.next(0, cur)) return;
    f32x4 acc[2][2][4][2];
#pragma unroll
    for (int a = 0; a < 2; ++a)
#pragma unroll
        for (int b = 0; b < 2; ++b)
#pragma unroll
            for (int m = 0; m < 4; ++m)
#pragma unroll
                for (int n = 0; n < 2; ++n) acc[a][b][m][n] = (f32x4){0.f, 0.f, 0.f, 0.f};
    bf16x8 At[4][2], B0[2][2], B1[2][2]; i32x8 At8[4], B08[2], B18[2];
    unsigned cA = g.A + cur.aoff, cB = g.Bt + cur.boff;
    S.a_ready(cur);
    if constexpr (Sched::GATHER) PG8_GATHER(vA0, vA1, cur);
    PG8_STAGE(PG8_SB(0, 0), cB, voffB); PG8_STAGE(PG8_SB(0, 1), cB + hsB, voffB); PG8_STAGE(PG8_SA(0, 0), cA, vA0); PG8_STAGE(PG8_SA(0, 1), cA, vA1);
    if (wr == 1) PG8_BAR;
    PG8_WAIT_V(2); PG8_BAR;
    PG8_STAGE(PG8_SB(1, 0), cB + kstep, voffB); PG8_STAGE(PG8_SA(1, 0), cA + kstep, vA0); PG8_STAGE(PG8_SB(1, 1), cB + hsB + kstep, voffB);
    PG8_WAIT_V(6); PG8_BAR;
    for (;;) {
        const bool has_next = S.next(ui + 1, nxt);
        const unsigned nA = has_next ? g.A + nxt.aoff : cA, nB = has_next ? g.Bt + nxt.boff : cB;
        if (Sched::GATHER && has_next) PG8_GATHER(nA0, nA1, nxt);
        else {
#pragma unroll
            for (int _i = 0; _i < 2; ++_i) { nA0[_i] = vA0[_i]; nA1[_i] = vA1[_i]; } }
        for (int t = 0; t < nt; t += 2) {
            const bool last = (t == nt - 2);
            const unsigned a1 = cA + (unsigned)(t + 1) * kstep;
            const unsigned a2 = last ? nA : cA + (unsigned)(t + 2) * kstep, b2 = last ? nB : cB + (unsigned)(t + 2) * kstep;
            const unsigned a3 = a2 + kstep, b3 = b2 + kstep;
            if (last && has_next) S.a_ready(nxt);
            const unsigned w0[2] = {last ? nA0[0] : vA0[0], last ? nA0[1] : vA0[1]}, w1[2] = {last ? nA1[0] : vA1[0], last ? nA1[1] : vA1[1]};
            PG8_LDB(B0, 0, 0); PG8_LDB(B1, 0, 1); PG8_SCHED; PG8_LDA(At, 0, 0); PG8_STAGE(PG8_SA(1, 1), a1, vA1);
            PG8_WAIT_V(8); PG8_WAIT_L(0); PG8_BAR; PG8_MM(0, 0, At, B0); PG8_MM(0, 1, At, B1); PG8_BAR; PG8_SCHED;
            PG8_LDA(At, 0, 1); PG8_STAGE(PG8_SB(0, 0), b2, voffB); PG8_STAGE(PG8_SB(0, 1), b2 + hsB, voffB); PG8_STAGE(PG8_SA(0, 0), a2, w0);
            PG8_WAIT_V(8); PG8_WAIT_L(0); PG8_BAR; PG8_MM(1, 0, At, B0); PG8_MM(1, 1, At, B1); PG8_BAR; PG8_SCHED;
            PG8_LDB(B0, 1, 0); PG8_LDB(B1, 1, 1); PG8_SCHED; PG8_LDA(At, 1, 0); PG8_STAGE(PG8_SA(0, 1), a2, w1);
            PG8_WAIT_V(8); PG8_WAIT_L(0); PG8_BAR; PG8_MM(0, 0, At, B0); PG8_MM(0, 1, At, B1); PG8_BAR; PG8_SCHED;
            PG8_LDA(At, 1, 1); PG8_STAGE(PG8_SB(1, 0), b3, voffB); PG8_STAGE(PG8_SB(1, 1), b3 + hsB, voffB); PG8_STAGE(PG8_SA(1, 0), a3, w0);
            PG8_WAIT_V(8); PG8_WAIT_L(0); PG8_BAR; PG8_MM(1, 0, At, B0); PG8_MM(1, 1, At, B1); PG8_BAR; PG8_SCHED;
        }
        if constexpr (ALIGN_EPI) { if (wr == 0) PG8_BAR; }
        if constexpr (F8) asm volatile("s_nop 15\n\ts_nop 15" ::: "memory");
        E(acc, cur, wr, wc, fr, fq); S.done(cur);
        if (!has_next) break;
#pragma unroll
        for (int a = 0; a < 2; ++a)
#pragma unroll
            for (int b = 0; b < 2; ++b)
#pragma unroll
                for (int m = 0; m < 4; ++m)
#pragma unroll
                    for (int n = 0; n < 2; ++n) acc[a][b][m][n] = (f32x4){0.f, 0.f, 0.f, 0.f};
        cur = nxt; cA = nA; cB = nB; ++ui;
#pragma unroll
        for (int _i = 0; _i < 2; ++_i) { vA0[_i] = nA0[_i]; vA1[_i] = nA1[_i]; }
        if constexpr (ALIGN_EPI) { if (wr == 1) PG8_BAR; }
    }
    PG8_WAIT_V(0);
    if constexpr (!ALIGN_EPI) { if (wr == 0) PG8_BAR; }
    PG8_BAR;
#undef PG8_SA
#undef PG8_SB
#undef PG8_STAGE
#undef PG8_GATHER
#undef PG8_LDA
#undef PG8_LDB
#undef PG8_MMA
#undef PG8_MMA8
#undef PG8_MM
#undef PG8_WAIT_V
#undef PG8_WAIT_L
#undef PG8_BAR
#undef PG8_SCHED
}
}

typedef const f32x4 (&AccRef)[2][2][4][2];

struct EpiZ {
    static constexpr bool PERM = true;
    bf16_t* Z; const float* cosT; const float* sinT;
    __device__ __forceinline__ void operator()(AccRef acc, const pg8::Unit& u, int wr, int wc, int fr, int fq) const {
        asm volatile("" : "+v"(fr), "+v"(fq));
        const int row0 = u.pm * 256 + wr * 64 + fr, col0 = u.pn * 256 + wc * 32 + 8 * fq;
        const bool rope = u.pn < 8;
#pragma unroll
        for (int ai = 0; ai < 2; ++ai)
#pragma unroll
            for (int m = 0; m < 4; ++m) {
                const int row = row0 + ai * 128 + m * 16, pos = row & (SEQ - 1);
                f32x4 cs = {1.f, 1.f, 1.f, 1.f}, sn = {0.f, 0.f, 0.f, 0.f};
                if (rope) { cs = *(const f32x4*)(cosT + pos * 64 + 16 * wc + 4 * fq); sn = *(const f32x4*)(sinT + pos * 64 + 16 * wc + 4 * fq); }
                bf16_t* rowp = Z + (size_t)row * DIN + col0;
#pragma unroll
                for (int bj = 0; bj < 2; ++bj) {
                    const f32x4 v0 = acc[ai][bj][m][0] * (1.f / WIN_SCALE), v1 = acc[ai][bj][m][1] * (1.f / WIN_SCALE);
                    u32x4 w;
                    w.x = cvt_pk_bf16(v0[0] * cs[0] - v0[1] * sn[0], v0[1] * cs[0] + v0[0] * sn[0]);
                    w.y = cvt_pk_bf16(v0[2] * cs[1] - v0[3] * sn[1], v0[3] * cs[1] + v0[2] * sn[1]);
                    w.z = cvt_pk_bf16(v1[0] * cs[2] - v1[1] * sn[2], v1[1] * cs[2] + v1[0] * sn[2]);
                    w.w = cvt_pk_bf16(v1[2] * cs[3] - v1[3] * sn[3], v1[3] * cs[3] + v1[2] * sn[3]);
                    *(u32x4*)(rowp + bj * 128) = w;
                }
            }
    }
};
struct EpiBf16Off {
    static constexpr bool PERM = true;
    unsigned char* O; int ldc, coloff;
    __device__ __forceinline__ void operator()(AccRef acc, const pg8::Unit& u, int wr, int wc, int fr, int fq) const {
        const int row0 = u.pm * 256 + wr * 64 + fr, col0 = coloff + u.pn * 256 + wc * 32 + 8 * fq;
#pragma unroll
        for (int ai = 0; ai < 2; ++ai)
#pragma unroll
            for (int m = 0; m < 4; ++m) { unsigned char* rowp = O + (size_t)(row0 + ai * 128 + m * 16) * ldc + col0;
#pragma unroll
                for (int bj = 0; bj < 2; ++bj) { const f32x4 v0 = acc[ai][bj][m][0] * CAT_SCALE, v1 = acc[ai][bj][m][1] * CAT_SCALE;
                    u32x2 w; w.x = cvt4_fp8(v0[0], v0[1], v0[2], v0[3]); w.y = cvt4_fp8(v1[0], v1[1], v1[2], v1[3]);
                    *(u32x2*)(rowp + bj * 128) = w; } }
    }
};
struct EpiResBf16 {
    static constexpr bool PERM = true;
    bf16_t* C; const bf16_t* res;
    __device__ __forceinline__ void operator()(AccRef acc, const pg8::Unit& u, int wr, int wc, int fr, int fq) const {
        const int row0 = u.pm * 256 + wr * 64 + fr, col0 = u.pn * 256 + wc * 32 + 8 * fq;
#pragma unroll
        for (int ai = 0; ai < 2; ++ai)
#pragma unroll
            for (int m = 0; m < 4; ++m) { const size_t ro = (size_t)(row0 + ai * 128 + m * 16) * DM + col0;
#pragma unroll
                for (int bj = 0; bj < 2; ++bj) { const u32x4 r = *(const u32x4*)(res + ro + bj * 128);
                    const f32x4 v0 = acc[ai][bj][m][0] * (1.f / (CAT_SCALE * WOUT_SCALE)), v1 = acc[ai][bj][m][1] * (1.f / (CAT_SCALE * WOUT_SCALE));
                    u32x4 w;
                    w.x = cvt_pk_bf16(v0[0] + ALPHA * bflo(r.x), v0[1] + ALPHA * bfhi(r.x)); w.y = cvt_pk_bf16(v0[2] + ALPHA * bflo(r.y), v0[3] + ALPHA * bfhi(r.y));
                    w.z = cvt_pk_bf16(v1[0] + ALPHA * bflo(r.z), v1[1] + ALPHA * bfhi(r.z)); w.w = cvt_pk_bf16(v1[2] + ALPHA * bflo(r.w), v1[3] + ALPHA * bfhi(r.w));
                    *(u32x4*)(C + ro + bj * 128) = w; } }
    }
};
__device__ __forceinline__ float dpp_shr(float v, float oldv, int d) {
    const int o = __float_as_int(oldv), x = __float_as_int(v);
    return __int_as_float(d == 1 ? __builtin_amdgcn_update_dpp(o, x, 0x111, 0xf, 0xf, false) : d == 2 ? __builtin_amdgcn_update_dpp(o, x, 0x112, 0xf, 0xf, false)
                        : d == 4 ? __builtin_amdgcn_update_dpp(o, x, 0x114, 0xf, 0xf, false) : __builtin_amdgcn_update_dpp(o, x, 0x118, 0xf, 0xf, false));
}
struct EpiGate {
    static constexpr bool PERM = false;
    float* SA; float* SB; const bf16_t* XC; const float* ba; const float* bx; const float* sp8; float* sumA; float* sumH;
    __device__ __forceinline__ void operator()(AccRef acc, const pg8::Unit& u, int wr, int wc, int fr, int fq) const {
        const int row0 = u.pm * 256 + wr * 64 + fr, ch0 = u.pn * 128 + wc * 32 + 4 * fq;
        const int l15 = (fq * 16 + 15) * 4;
#pragma unroll
        for (int n = 0; n < 2; ++n) {
            const int ch = ch0 + 16 * n;
            const f32x4 vba = *(const f32x4*)(ba + ch), vbx = *(const f32x4*)(bx + ch), vsp = *(const f32x4*)(sp8 + ch);
#pragma unroll
            for (int ai = 0; ai < 2; ++ai)
#pragma unroll
                for (int mp = 0; mp < 2; ++mp) {
                    float A[8], B[8];
#pragma unroll
                    for (int sg = 0; sg < 2; ++sg) { const int m = 2 * mp + sg;
                        const size_t ro = (size_t)(row0 + ai * 128 + m * 16) * RW + ch;
                        const u32x2 xw = *(const u32x2*)(XC + ro);
                        const float xc[4] = {bflo(xw.x), bfhi(xw.x), bflo(xw.y), bfhi(xw.y)};
                        const f32x4 ar = acc[ai][0][m][n], ain = acc[ai][1][m][n];
#pragma unroll
                        for (int q = 0; q < 4; ++q) {
                            const float r = sigmoidf_(ar[q] + vba[q]), ig = sigmoidf_(ain[q] + vbx[q]);
                            const float la = -r * vsp[q];
                            const float a = __expf(la);
                            A[sg * 4 + q] = a; B[sg * 4 + q] = __builtin_amdgcn_sqrtf((1.f - a) * (1.f + a)) * (ig * xc[q]);
                        }
                    }
#define GS_F(i, j, D) "v_fmac_f32_dpp %" #j ", %" #j ", %" #i " row_shr:" #D " row_mask:0xf bank_mask:0xf\n\t"
#define GS_M(i, D) "v_mul_f32_dpp %" #i ", %" #i ", %" #i " row_shr:" #D " row_mask:0xf bank_mask:0xf\n\t"
#define GATE_SCAN_STEP(D) asm volatile("s_nop 1\n\t" GS_F(0, 8, D) GS_F(1, 9, D) GS_F(2, 10, D) GS_F(3, 11, D) GS_F(4, 12, D) GS_F(5, 13, D) GS_F(6, 14, D) GS_F(7, 15, D) \
                        GS_M(0, D) GS_M(1, D) GS_M(2, D) GS_M(3, D) GS_M(4, D) GS_M(5, D) GS_M(6, D) GS_M(7, D) \
                        : "+v"(A[0]), "+v"(A[1]), "+v"(A[2]), "+v"(A[3]), "+v"(A[4]), "+v"(A[5]), "+v"(A[6]), "+v"(A[7]), \
                          "+v"(B[0]), "+v"(B[1]), "+v"(B[2]), "+v"(B[3]), "+v"(B[4]), "+v"(B[5]), "+v"(B[6]), "+v"(B[7]))
                    GATE_SCAN_STEP(1); GATE_SCAN_STEP(2); GATE_SCAN_STEP(4); GATE_SCAN_STEP(8);
#undef GATE_SCAN_STEP
#undef GS_M
#undef GS_F
#pragma unroll
                    for (int q = 0; q < 4; ++q) {
                        const float A1 = __int_as_float(__builtin_amdgcn_ds_bpermute(l15, __float_as_int(A[q]))), H1 = __int_as_float(__builtin_amdgcn_ds_bpermute(l15, __float_as_int(B[q])));
                        B[4 + q] = fmaf(A[4 + q], H1, B[4 + q]); A[4 + q] *= A1; }
#pragma unroll
                    for (int sg = 0; sg < 2; ++sg) { const size_t ro = (size_t)(row0 + ai * 128 + (2 * mp + sg) * 16) * RW + ch;
                        *(f32x4*)(SA + ro) = (f32x4){A[sg * 4], A[sg * 4 + 1], A[sg * 4 + 2], A[sg * 4 + 3]}; *(f32x4*)(SB + ro) = (f32x4){B[sg * 4], B[sg * 4 + 1], B[sg * 4 + 2], B[sg * 4 + 3]}; }
                    if (fr == 15) { const size_t so = (size_t)(u.pm * 8 + ai * 4 + wr * 2 + mp) * RW + ch;
                        *(f32x4*)(sumA + so) = (f32x4){A[4], A[5], A[6], A[7]}; *(f32x4*)(sumH + so) = (f32x4){B[4], B[5], B[6], B[7]}; }
                }
        }
    }
};
struct EpiSwiGLU {
    static constexpr bool PERM = true;
    unsigned char* H;
    __device__ __forceinline__ void operator()(AccRef acc, const pg8::Unit& u, int wr, int wc, int fr, int fq) const {
        const int row0 = u.pm * 256 + wr * 64 + fr, j0 = (u.pn * 256 + wc * 32 + 8 * fq) >> 1;
        constexpr float ds = 1.f / W1_SCALE;
#pragma unroll
        for (int ai = 0; ai < 2; ++ai)
#pragma unroll
            for (int m = 0; m < 4; ++m) { unsigned char* rowp = H + (size_t)(row0 + ai * 128 + m * 16) * DEXP + j0;
#pragma unroll
                for (int bj = 0; bj < 2; ++bj) { const f32x4 v0 = acc[ai][bj][m][0] * ds, v1 = acc[ai][bj][m][1] * ds;
                    const float h0 = v0[0] * sigmoidf_(v0[0]) * v0[1], h1 = v0[2] * sigmoidf_(v0[2]) * v0[3];
                    const float h2 = v1[0] * sigmoidf_(v1[0]) * v1[1], h3 = v1[2] * sigmoidf_(v1[2]) * v1[3];
                    *(unsigned*)(rowp + bj * 64) = cvt4_fp8(h0 * H_SCALE, h1 * H_SCALE, h2 * H_SCALE, h3 * H_SCALE); } }
    }
};
struct EpiScaleBf16 {
    static constexpr bool PERM = true;
    unsigned char* O; const float* sw;
    __device__ __forceinline__ void operator()(AccRef acc, const pg8::Unit& u, int wr, int wc, int fr, int fq) const {
        const int row0 = u.pm * 256 + wr * 64 + fr, col0 = u.pn * 256 + wc * 32 + 8 * fq;
#pragma unroll
        for (int ai = 0; ai < 2; ++ai)
#pragma unroll
            for (int m = 0; m < 4; ++m) { const int row = row0 + ai * 128 + m * 16; const float s = sw[u.lb + u.pb - u.pm * 256 + row] * (Y2_SCALE / (H_SCALE * W2_SCALE)); unsigned char* rowp = O + (size_t)row * DM + col0;
#pragma unroll
                for (int bj = 0; bj < 2; ++bj) { const f32x4 v0 = acc[ai][bj][m][0] * s, v1 = acc[ai][bj][m][1] * s;
                    u32x2 w; w.x = cvt4_fp8(v0[0], v0[1], v0[2], v0[3]); w.y = cvt4_fp8(v1[0], v1[1], v1[2], v1[3]);
                    *(u32x2*)(rowp + bj * 128) = w; } }
    }
};
struct RgOrder {
    static constexpr bool GATHER = false;
    __device__ __forceinline__ unsigned arow(const pg8::Unit&, int) const { return 0u; }
    int G, c;
    __device__ bool next(int i, pg8::Unit& u) const {
        const int L = i * G + c; if (L >= 128) return false;
        u.pm = L >> 2; u.pn = L & 3; u.aoff = ((unsigned)u.pm * 256 * RW + (unsigned)u.pn * 128) * 2; u.boff = (unsigned)u.pn * 256 * 128 * 2; return true;
    }
    __device__ __forceinline__ void a_ready(const pg8::Unit&) const {}
    __device__ __forceinline__ void done(const pg8::Unit&) const {}
};
template <bool GATHER_>
struct MoeOrder {
    static constexpr bool GATHER = GATHER_;
    int Gp, c, lo, hi, lda, ldb; const volatile LAS int* meta; unsigned estride; bool xcdmap; const int* list; int xr = 0;
    __device__ bool next(int i, pg8::Unit& u) const {
        int L = lo + i * Gp + c;
        if (xr > 0) { if (i >= xr) return false; const int n = Gp >> 3; L = lo + ((c & 7) * xr + i) * n + (c >> 3); }
        if (c < 0 || L >= hi) return false;
        if (xcdmap) {
            const int x = c & 7, r = c >> 3; L = (((i * 8 + x) * 4 + (r >> 3)) << 3) | (r & 7); }
        u.pm = L >> 3; u.pn = L & 7; const int e = __builtin_amdgcn_readfirstlane(meta[48 + u.pm]);
        u.cnt = __builtin_amdgcn_readfirstlane(meta[e]); u.pb = u.pm * 256 - __builtin_amdgcn_readfirstlane(meta[16 + e]); u.lb = e * MTOK;
        u.aoff = GATHER_ ? 0u : (unsigned)u.pm * 256 * lda * 2; u.boff = (unsigned)e * estride + (unsigned)u.pn * 256 * ldb * 2; return true;
    }
    __device__ __forceinline__ unsigned arow(const pg8::Unit& u, int r) const { const int p = u.pb + r; return (p < u.cnt) ? (unsigned)list[u.lb + p] : 0u; }
    __device__ __forceinline__ void a_ready(const pg8::Unit&) const {}
    __device__ __forceinline__ void done(const pg8::Unit&) const {}
};

namespace att {
constexpr int D = 128, PQ = DIN, PO = 1024;
constexpr float SCALE = 0.08838834764831845f;
constexpr float THR = 8.f;
constexpr int NW = 8, QBLK = 32, KVBLK = 64, QB = NW * QBLK;
constexpr int SHM_V = KVBLK * D * 2, SHM_K = KVBLK * D * 2;
constexpr int LDS_ATT = 2 * SHM_V + 2 * SHM_K + NW * 64 * 4;
#define KSWZ(row, colB) ((row) * 256 + ((colB) ^ (((row) & 7) << 4)))
#define SBAR() __builtin_amdgcn_sched_barrier(0)
__device__ __forceinline__ int v_st(int k, int c) { const int kk = (k & ~0xC) | ((k & 4) << 1) | ((k & 8) >> 1); return ((kk >> 3) * 4 + (c >> 5)) * 512 + ((kk & 7) * 32 + (c & 31)) * 2; }
__device__ __forceinline__ int v_rd_base(int lane) { return ((lane & 3) << 3) | (((lane >> 2) & 3) << 6) | (((lane >> 4) & 1) << 5) | (((lane >> 5) & 1) << 8); }
constexpr int v_rd_off(int d0, int ks, int half) { return d0 * 512 + ks * 4096 + half * 2048; }
__device__ __forceinline__ int crow(int r, int hi) { return (r & 3) + 8 * (r >> 2) + 4 * hi; }
__device__ __forceinline__ unsigned cvtpk(float lo, float hi) { unsigned r; asm volatile("v_cvt_pk_bf16_f32 %0, %1, %2" : "=v"(r) : "v"(lo), "v"(hi)); return r; }
__device__ __forceinline__ bf16x8 load8(const bf16_t* p) { return *reinterpret_cast<const bf16x8*>(p); }
__device__ __forceinline__ void mask_tile(f32x16& p0, f32x16& p1, int dq, unsigned W) {
    const float NEG = -__builtin_inff();
#pragma unroll
    for (int r = 0; r < 16; ++r) {
        const int c = (r & 3) + 8 * (r >> 2);
        if ((unsigned)(dq - c) >= W) p0[r] = NEG;
        if ((unsigned)(dq - c - 32) >= W) p1[r] = NEG;
    }
}
__device__ __forceinline__ void partialSM(f32x16& p0, f32x16& p1, float& m_reg, float& mn, float& alpha) {
    float pmax = p0[0]; for (int r = 1; r < 16; ++r) pmax = fmaxf(pmax, p0[r]); for (int r = 0; r < 16; ++r) pmax = fmaxf(pmax, p1[r]);
    { auto rr = __builtin_amdgcn_permlane32_swap(__float_as_uint(pmax), __float_as_uint(pmax), false, false);
      pmax = fmaxf(__uint_as_float(rr[0]), __uint_as_float(rr[1])); }
    constexpr float C2 = 1.4426950408889634f * SCALE;
    if (__builtin_expect(__all((pmax - m_reg) * SCALE <= THR), 1)) { mn = m_reg; alpha = 1.f; }
    else { mn = fmaxf(m_reg, pmax); alpha = __builtin_amdgcn_exp2f((m_reg - mn) * C2); m_reg = mn; }
    const float mnL = -mn * C2;
    for (int r = 0; r < 16; ++r) p0[r] = fmaf(p0[r], C2, mnL); for (int r = 0; r < 16; ++r) p1[r] = fmaf(p1[r], C2, mnL);
    for (int r = 0; r < 16; ++r) p0[r] = __builtin_amdgcn_exp2f(p0[r]);
}
__device__ __forceinline__ void finishSM(f32x16& p0, f32x16& p1, float alpha, float& l_reg, bf16x8& pa0, bf16x8& pa1, bf16x8& pa2, bf16x8& pa3) {
    for (int r = 0; r < 16; ++r) p1[r] = __builtin_amdgcn_exp2f(p1[r]);
    float ps = 0; for (int r = 0; r < 16; ++r) ps += p0[r]; for (int r = 0; r < 16; ++r) ps += p1[r];
    { auto rr = __builtin_amdgcn_permlane32_swap(__float_as_uint(ps), __float_as_uint(ps), false, false);
      ps = __uint_as_float(rr[0]) + __uint_as_float(rr[1]); }
    l_reg = l_reg * alpha + ps;
#define PK4(P, B_, OUT) do { unsigned a0 = cvtpk(P[B_+0], P[B_+1]), a1 = cvtpk(P[B_+2], P[B_+3]);                          \
        unsigned b0 = cvtpk(P[B_+4], P[B_+5]), b1 = cvtpk(P[B_+6], P[B_+7]);                                             \
        auto r0 = __builtin_amdgcn_permlane32_swap(a0, b0, false, false); auto r1 = __builtin_amdgcn_permlane32_swap(a1, b1, false, false); \
        u32x4 w = {r0[0], r1[0], r0[1], r1[1]}; OUT = *reinterpret_cast<bf16x8*>(&w); } while (0)
    PK4(p0, 0, pa0); PK4(p0, 8, pa1); PK4(p1, 0, pa2); PK4(p1, 8, pa3);
#undef PK4
}
template <int KB>
__device__ __forceinline__ void qkt(f32x16& p0, f32x16& p1, const char* K_lds, int r32, int hi, const bf16x8* qr) {
    p0 = f32x16{}; p1 = f32x16{};
    const char* kb[4];
#pragma unroll
    for (int dd = 0; dd < 4; ++dd) kb[dd] = K_lds + KB * SHM_K + KSWZ(r32, (dd * 16 + hi * 8) * 2);
#pragma unroll
    for (int d0 = 0; d0 < 8; ++d0) { const char* a = kb[d0 & 3] + (d0 >> 2) * 128;
        bf16x8 b0 = *reinterpret_cast<const bf16x8*>(a);
        bf16x8 b1 = *reinterpret_cast<const bf16x8*>(a + 32 * 256);
        p0 = __builtin_amdgcn_mfma_f32_32x32x16_bf16(b0, qr[d0], p0, 0, 0, 0);
        p1 = __builtin_amdgcn_mfma_f32_32x32x16_bf16(b1, qr[d0], p1, 0, 0, 0); }
}
template <int VB>
__device__ __forceinline__ void pv_tile(f32x16* o, int vb0, bf16x8 pa0, bf16x8 pa1, bf16x8 pa2, bf16x8 pa3) {
#define TRRD(dst, off) asm volatile("ds_read_b64_tr_b16 %0, %1 offset:%2" : "=&v"(dst) : "v"(vb0), "i"(off) : "memory")
#define PV_D0(d0) do { s16x4 l0, l1, l2, l3, h0, h1, h2, h3; constexpr int b_ = VB * SHM_V + v_rd_off(d0, 0, 0); \
        TRRD(l0, b_); TRRD(h0, b_ + 2048); TRRD(l1, b_ + 4096); TRRD(h1, b_ + 6144); TRRD(l2, b_ + 8192); TRRD(h2, b_ + 10240); TRRD(l3, b_ + 12288); TRRD(h3, b_ + 14336); \
        asm volatile("s_waitcnt lgkmcnt(0)" ::: "memory"); SBAR();   \
        o[d0] = __builtin_amdgcn_mfma_f32_32x32x16_bf16(pa0, (bf16x8){l0[0], l0[1], l0[2], l0[3], h0[0], h0[1], h0[2], h0[3]}, o[d0], 0, 0, 0);   \
        o[d0] = __builtin_amdgcn_mfma_f32_32x32x16_bf16(pa1, (bf16x8){l1[0], l1[1], l1[2], l1[3], h1[0], h1[1], h1[2], h1[3]}, o[d0], 0, 0, 0);   \
        o[d0] = __builtin_amdgcn_mfma_f32_32x32x16_bf16(pa2, (bf16x8){l2[0], l2[1], l2[2], l2[3], h2[0], h2[1], h2[2], h2[3]}, o[d0], 0, 0, 0);   \
        o[d0] = __builtin_amdgcn_mfma_f32_32x32x16_bf16(pa3, (bf16x8){l3[0], l3[1], l3[2], l3[3], h3[0], h3[1], h3[2], h3[3]}, o[d0], 0, 0, 0); } while (0)
    PV_D0(0); PV_D0(1); PV_D0(2); PV_D0(3);
#undef PV_D0
#undef TRRD
}
struct BlockRef { const bf16_t* Q; const bf16_t* K; const bf16_t* V; bf16_t* O; int P0; };
struct Seam { bf16x8 qr[8]; bf16x8 st_v0, st_v1, st_k0, st_k1; };
#define ROW(p, k0, rr) ((p) + (size_t)((k0) + (rr)) * PQ + sc)
#define VMW() asm volatile("s_waitcnt vmcnt(0)" ::: "memory")
#define VMWN(n) asm volatile("s_waitcnt vmcnt(%0)" :: "i"(n) : "memory")
#define SLOAD_H(Kp, Vp, k0) do { S.st_v0 = load8(ROW(Vp, k0, sr)); S.st_v1 = load8(ROW(Vp, k0, 32 + sr));              \
                         S.st_k0 = load8(ROW(Kp, k0, sr)); S.st_k1 = load8(ROW(Kp, k0, 32 + sr)); } while (0)
#define SWRITE_HK(bf) do { *(bf16x8*)(K_lds + (bf) * SHM_K + kws) = S.st_k0; *(bf16x8*)(K_lds + (bf) * SHM_K + kws + 32 * 256) = S.st_k1; } while (0)
#define SWRITE_HV(bf) do { *(bf16x8*)(V_lds + (bf) * SHM_V + vst0) = S.st_v0; *(bf16x8*)(V_lds + (bf) * SHM_V + vst1) = S.st_v1; } while (0)
#define SWRITE_H(bf) do { SWRITE_HV(bf); SWRITE_HK(bf); } while (0)
__device__ __forceinline__ void causal_prime(const BlockRef& cur, char* lds, Seam& S, int wid0) {
    const int tid = tidx(wid0), wid = __builtin_amdgcn_readfirstlane(tid >> 6), lane = tid & 63, r32 = lane & 31, hi = lane >> 5;
    const int sr = tid >> 4, sc = (tid & 15) * 8, kws = KSWZ(sr, sc * 2); char* K_lds = lds + 2 * SHM_V;
    const int kb0 = 0;
    for (int d0 = 0; d0 < 8; ++d0) S.qr[d0] = load8(cur.Q + (size_t)(wid * QBLK + r32) * PQ + d0 * 16 + hi * 8);
    SLOAD_H(cur.K, cur.V, kb0); VMW(); SWRITE_HK(0);
    __syncthreads();
}
__device__ __forceinline__ void causal_block(const BlockRef& cur, const BlockRef& nxt, char* lds, Seam& S, int wid0) {
    const int tid = tidx(wid0), wid = __builtin_amdgcn_readfirstlane(tid >> 6), lane = tid & 63, r32 = lane & 31, hi = lane >> 5;
    const int W = 1 << 30;
    const int j_lo = 0;
    const int j_hi = (cur.P0 + QB - 1) / KVBLK + 1;
    const int NT = j_hi - j_lo;
    const int kbn = 0;
    const int qlo = cur.P0 + wid * QBLK, qm = qlo + r32 - 4 * hi;
    char* V_lds = lds; char* K_lds = lds + 2 * SHM_V;
    float* ws = (float*)(lds + 2 * SHM_V + 2 * SHM_K) + wid * 64; float* li_l = ws, * al_l = ws + 32;
    float m_reg = -1e30f, l_reg = 0; f32x16 o[4] = {};
    const int sr = tid >> 4, sc = (tid & 15) * 8, vst0 = v_st(sr, sc), vst1 = v_st(32 + sr, sc), kws = KSWZ(sr, sc * 2);
    const int vb0 = (int)(uintptr_t)V_lds + v_rd_base(lane);
    const bf16_t* Kh = cur.K; const bf16_t* Vh = cur.V;
#define RESC(a) do { if (__any((a) < 1.f)) { if (hi == 0) al_l[r32] = (a); asm volatile("s_waitcnt lgkmcnt(0)" ::: "memory");              \
                     for (int d_ = 0; d_ < 4; ++d_) for (int r = 0; r < 16; ++r) o[d_][r] *= al_l[crow(r, hi)]; } } while (0)
#define KBASE(t) ((j_lo + (t)) * KVBLK)
#define MASKT(P0_, P1_, t) do { const int kb_ = KBASE(t); if (kb_ + KVBLK - 1 > qlo) mask_tile(P0_, P1_, qm - kb_, (unsigned)W); } while (0)
    constexpr int NQL = 8;
#define SEAM_K0() do { VMWN(NQL); SWRITE_HK(0); SBAR(); } while (0)
    f32x16 pA0, pA1, pB0, pB1; float mnA, mnB, alA, alB; bf16x8 pa0, pa1, pa2, pa3;
    SWRITE_HV(0); SBAR();
    if (NT > 1) { SLOAD_H(Kh, Vh, KBASE(1)); }
    SBAR(); qkt<0>(pA0, pA1, K_lds, r32, hi, S.qr);
    MASKT(pA0, pA1, 0); partialSM(pA0, pA1, m_reg, mnA, alA);
    if (NT > 1) { VMW(); SWRITE_H(1); }
    __syncthreads();
#define HALF_STEP(PX0, PX1, mnX, alX, PY0, PY1, alY, t, KB, VB, SB) do {                                                      \
        SBAR(); qkt<KB>(PX0, PX1, K_lds, r32, hi, S.qr);                                                         \
        finishSM(PY0, PY1, alY, l_reg, pa0, pa1, pa2, pa3); SBAR();                                                           \
        if ((t) + 1 < NT) { SLOAD_H(Kh, Vh, KBASE((t) + 1)); SBAR(); }                                                        \
        pv_tile<VB>(o, vb0, pa0, pa1, pa2, pa3); MASKT(PX0, PX1, (t)); partialSM(PX0, PX1, m_reg, mnX, alX);                  \
        __syncthreads();                                                                                                      \
        if ((t) + 1 < NT) { VMW(); SWRITE_H(SB); }                                                                            \
        RESC(alX); __syncthreads(); } while (0)
    for (int t = 1; t + 1 < NT; t += 2) {
        HALF_STEP(pB0, pB1, mnB, alB, pA0, pA1, alA, t, 1, 0, 0);
        HALF_STEP(pA0, pA1, mnA, alA, pB0, pB1, alB, t + 1, 0, 1, 1);
    }
    const bool even = (NT & 1) == 0;
    if (even) { SBAR(); qkt<1>(pB0, pB1, K_lds, r32, hi, S.qr); SBAR(); }
    SLOAD_H(nxt.K, nxt.V, kbn); SBAR();
#pragma unroll
    for (int d0 = 0; d0 < 8; ++d0) S.qr[d0] = load8(nxt.Q + (size_t)(wid * QBLK + r32) * PQ + d0 * 16 + hi * 8);
    SBAR();
    finishSM(pA0, pA1, alA, l_reg, pa0, pa1, pa2, pa3); SBAR();
    pv_tile<0>(o, vb0, pa0, pa1, pa2, pa3);
    if (even) { MASKT(pB0, pB1, NT - 1); partialSM(pB0, pB1, m_reg, mnB, alB); __syncthreads(); RESC(alB);
        finishSM(pB0, pB1, alB, l_reg, pa0, pa1, pa2, pa3); SBAR(); pv_tile<1>(o, vb0, pa0, pa1, pa2, pa3); }
    SBAR(); SEAM_K0();
    if (hi == 0) li_l[r32] = l_reg; asm volatile("s_waitcnt lgkmcnt(0)" ::: "memory");
    float rli[16];
#pragma unroll
    for (int r = 0; r < 16; ++r) rli[r] = __builtin_amdgcn_rcpf(li_l[crow(r, hi)]);
    bf16_t* Ow = cur.O + (size_t)(wid * QBLK) * PO;
#pragma unroll
    for (int r = 0; r < 16; ++r) { const int orow = crow(r, hi);
#pragma unroll
        for (int d0 = 0; d0 < 4; ++d0) { const float v = o[d0][r] * rli[r];
            const float vn = __int_as_float(__builtin_amdgcn_mov_dpp(__float_as_int(v), 0xB1, 0xf, 0xf, true));
            if ((r32 & 1) == 0) *(unsigned*)(Ow + (size_t)orow * PO + d0 * 32 + r32) = cvtpk(v, vn); } }
    __syncthreads();
#undef RESC
#undef KBASE
#undef MASKT
#undef SEAM_K0
#undef HALF_STEP
}
#undef ROW
#undef VMW
#undef VMWN
#undef SLOAD_H
#undef SWRITE_HK
#undef SWRITE_HV
#undef SWRITE_H
__device__ __forceinline__ BlockRef make_ref(int L, int pass, const bf16_t* Z, bf16_t* OC) {
    const int bh = L >> 2, x = L & 3, b = bh >> 4, vh = bh & 15, h = vh >> 2, c = (vh >> 1) & 1, vhalf = vh & 1;
    const int qb = pass ? 7 - x : x;
    const size_t row0 = (size_t)b * SEQ;
    BlockRef r;
    r.Q = Z + (row0 + (size_t)qb * QB) * PQ + h * 256 + c * 128;
    r.K = Z + row0 * PQ + ZK_OFF + h * 256 + c * 128;
    r.V = Z + row0 * PQ + ZV_OFF + h * 256 + vhalf * 128;
    r.O = OC + (size_t)c * MTOK * PO + (row0 + (size_t)qb * QB) * PO + h * 256 + vhalf * 128;
    r.P0 = qb * QB;
    return r;
}
__device__ __forceinline__ void attn_phase(char* lds, const bf16_t* Z, bf16_t* OC, int G, int c0, int wid0) {
    constexpr int total = 256;
    int L = c0; if (L >= total) return;
    int pass = 0;
    BlockRef cur = make_ref(L, 0, Z, OC);
    Seam S;
    causal_prime(cur, lds, S, wid0);
    for (;;) {
        const bool more_pass = pass == 0, more_item = L + G < total, last = !more_pass && !more_item;
        int passn = pass + 1, Ln = L;
        if (!more_pass) { passn = 0; Ln = more_item ? L + G : L; }
        const BlockRef nxt = last ? cur : make_ref(Ln, passn, Z, OC);
        causal_block(cur, nxt, lds, S, wid0);
        if (last) break;
        cur = nxt; pass = passn; L = Ln;
    }
}
}

#define AIN(k) ldptr(lds, (k))
struct Args { const float* in[28]; float* out; unsigned char* ws; int ph_lo, ph_hi; };
enum { I_X = 0, I_WIN, I_LQ1, I_LK1, I_LQ2, I_LK2, I_SUBLN, I_CDW, I_CLNG, I_CLNB, I_CPW, I_RCW, I_RCB, I_RWA, I_RBA, I_RWX, I_RBX, I_RLAM, I_WOUT,
       I_LN1G, I_LN1B, I_RTW, I_RTB, I_EWG, I_EWU, I_EWD, I_LN2G, I_LN2B };
constexpr int NPH = 12;
constexpr int NPHASES = 1 + NLAYER * NPH;

template <bool F8>
__device__ __forceinline__ void cvt_tile(const float* src, int ld, unsigned char* dst, int dpitch, float scale, LAS unsigned char* scr, int lane) {
    constexpr int NB = F8 ? 4 : 2;
    float va[32], vb[32];
#define CT_LOAD(v, b) do { _Pragma("unroll") for (int r = 0; r < 32; ++r) v[r] = src[(size_t)((b) * 32 + r) * ld]; } while (0)
#define CT_CONV(v, b) do { if constexpr (F8) { _Pragma("unroll") for (int i = 0; i < 4; ++i) { u32x2 w; \
            w.x = cvt4_fp8(v[8 * i + 0] * scale, v[8 * i + 1] * scale, v[8 * i + 2] * scale, v[8 * i + 3] * scale); \
            w.y = cvt4_fp8(v[8 * i + 4] * scale, v[8 * i + 5] * scale, v[8 * i + 6] * scale, v[8 * i + 7] * scale); \
            *(LAS u32x2*)(scr + lane * 136 + (b) * 32 + i * 8) = w; } } \
        else { _Pragma("unroll") for (int i = 0; i < 8; ++i) { u32x2 w; w.x = cvt_pk_bf16(v[4 * i + 0], v[4 * i + 1]); w.y = cvt_pk_bf16(v[4 * i + 2], v[4 * i + 3]); \
            *(LAS u32x2*)(scr + lane * 136 + (b) * 64 + i * 8) = w; } } } while (0)
    CT_LOAD(va, 0);
#pragma unroll
    for (int b = 0; b < NB; b += 2) {
        CT_LOAD(vb, b + 1);
        __builtin_amdgcn_sched_barrier(0);
        CT_CONV(va, b);
        if (b + 2 < NB) CT_LOAD(va, b + 2);
        __builtin_amdgcn_sched_barrier(0);
        CT_CONV(vb, b + 1);
    }
#undef CT_LOAD
#undef CT_CONV
    LDS_WAIT();
#pragma unroll
    for (int it = 0; it < 8; ++it) { const int id = it * 64 + lane, n = id >> 3, c = id & 7;
        const u32x2 a = *(const LAS u32x2*)(scr + n * 136 + c * 16), b = *(const LAS u32x2*)(scr + n * 136 + c * 16 + 8);
        u32x4 o; o.x = a.x; o.y = a.y; o.z = b.x; o.w = b.y;
        *(u32x4*)(dst + (size_t)n * dpitch + c * 16) = o; }
    LDS_WAIT();
}

struct F8Tile { const float* src; unsigned char* dst; int ld, dpitch, drow, dstep; float scale; };
__device__ __forceinline__ F8Tile f8_tile(const Args& a, LAS unsigned char* lds, unsigned char* ws, int t, int lane, int wave) {
    F8Tile T;
    if (t < 640) {
        const int l = t / 160, r = t % 160, kt = r / 20, nt = r % 20, sc = 4 * lane;
        T.src = AIN(I_WIN) + (size_t)l * DM * DIN + (size_t)(kt * 256 + 32 * wave) * DIN + nt * 256 + sc; T.ld = DIN; T.scale = WIN_SCALE;
        T.dst = ws + WS_WIN + (size_t)l * DIN * DM + (size_t)(nt * 256) * DM + kt * 256; T.dpitch = DM;
        if (nt < 8) { const int d = sc & 127; T.drow = (sc & 128) + 2 * (d & 63) + (d >> 6); T.dstep = 2; } else { T.drow = sc; T.dstep = 1; }
    } else if (t < 640 + 4096) {
        t -= 640; const int le = t / 64, r = t % 64, kt = r / 8, nt = r % 8, half = lane >> 5, lc = lane & 31;
        T.src = (half ? AIN(I_EWU) : AIN(I_EWG)) + (size_t)le * DM * DEXP + (size_t)(kt * 256 + 32 * wave) * DEXP + nt * 128 + 4 * lc; T.ld = DEXP; T.scale = W1_SCALE;
        T.dst = ws + WS_W1 + (size_t)le * 2048 * DM + (size_t)(nt * 256) * DM + kt * 256; T.dpitch = DM;
        T.drow = 8 * lc + half; T.dstep = 2;
    } else if (t >= 640 + 4096 + 2048) {
        t -= 640 + 4096 + 2048; const int l = t / 64, r = t % 64, kt = r / 8, nt = r % 8;
        T.src = AIN(I_WOUT) + (size_t)l * DM * DM + (size_t)(kt * 256 + 32 * wave) * DM + nt * 256 + 4 * lane; T.ld = DM; T.scale = WOUT_SCALE;
        T.dst = ws + WS_WOUT + (size_t)l * DM * DM + (size_t)(nt * 256) * DM + kt * 256; T.dpitch = DM;
        T.drow = 4 * lane; T.dstep = 1;
    } else {
        t -= 640 + 4096; const int le = t / 32, r = t % 32, kt = r / 8, nt = r % 8;
        T.src = AIN(I_EWD) + (size_t)le * DEXP * DM + (size_t)(kt * 256 + 32 * wave) * DM + nt * 256 + 4 * lane; T.ld = DM; T.scale = W2_SCALE;
        T.dst = ws + WS_W2 + (size_t)le * DM * DEXP + (size_t)(nt * 256) * DEXP + kt * 256; T.dpitch = DEXP;
        T.drow = 4 * lane; T.dstep = 1;
    }
    return T;
}
__device__ __forceinline__ int f8_tile_of(int l, int k) { return k < 160 ? l * 160 + k : (k < 1184 ? 640 + l * 1024 + (k - 160) : (k < 1696 ? 640 + 4096 + l * 512 + (k - 1184) : 640 + 4096 + 2048 + l * 64 + (k - 1696))); }
constexpr int F8_TILES_PER_LAYER = 1760;
template <bool STEAL>
__device__ __forceinline__ void f8_convert(const Args& a, LAS unsigned char* lds, unsigned char* ws, int l, int first, int stride, int quota, unsigned* ticket, int tid, int lane, int wave) {
    volatile LAS int* word = (volatile LAS int*)(lds + MISC_OFF) + 16;
    f32x4 v[32];
    int k, n = 0;
    if constexpr (STEAL) {
        __syncthreads();
        if (tid == 0) word[0] = (quota > 0) ? (int)__hip_atomic_fetch_add(ticket, 1u, __ATOMIC_RELAXED, __HIP_MEMORY_SCOPE_AGENT) : F8_TILES_PER_LAYER;
        __syncthreads();
        k = word[0];
    } else k = first;
    F8Tile T = f8_tile(a, lds, ws, f8_tile_of(l, k < F8_TILES_PER_LAYER ? k : 0), lane, wave);
#define F8_LOADS() do { _Pragma("unroll") for (int q = 0; q < 32; ++q) v[q] = __builtin_nontemporal_load((const f32x4*)(T.src + (size_t)q * T.ld)); } while (0)
    if (k < F8_TILES_PER_LAYER) F8_LOADS();
    while (k < F8_TILES_PER_LAYER) {
        LAS unsigned char* buf = lds + (n & 1) * 65536;
        if constexpr (STEAL) { if (tid == 0) word[(n + 1) & 1] = (n + 1 < quota) ? (int)__hip_atomic_fetch_add(ticket, 1u, __ATOMIC_RELAXED, __HIP_MEMORY_SCOPE_AGENT) : F8_TILES_PER_LAYER; }
        const float sc = T.scale;
#pragma unroll
        for (int c = 0; c < 4; ++c) {
            const int R = T.drow + c * T.dstep, sw = (R >> 2) & 15;
            u32x4 lo, hi;
            lo.x = cvt4_fp8(v[0][c] * sc, v[1][c] * sc, v[2][c] * sc, v[3][c] * sc);     lo.y = cvt4_fp8(v[4][c] * sc, v[5][c] * sc, v[6][c] * sc, v[7][c] * sc);
            lo.z = cvt4_fp8(v[8][c] * sc, v[9][c] * sc, v[10][c] * sc, v[11][c] * sc);   lo.w = cvt4_fp8(v[12][c] * sc, v[13][c] * sc, v[14][c] * sc, v[15][c] * sc);
            hi.x = cvt4_fp8(v[16][c] * sc, v[17][c] * sc, v[18][c] * sc, v[19][c] * sc); hi.y = cvt4_fp8(v[20][c] * sc, v[21][c] * sc, v[22][c] * sc, v[23][c] * sc);
            hi.z = cvt4_fp8(v[24][c] * sc, v[25][c] * sc, v[26][c] * sc, v[27][c] * sc); hi.w = cvt4_fp8(v[28][c] * sc, v[29][c] * sc, v[30][c] * sc, v[31][c] * sc);
            *(LAS u32x4*)(buf + R * 256 + (((2 * wave) ^ sw) << 4)) = lo;
            *(LAS u32x4*)(buf + R * 256 + (((2 * wave + 1) ^ sw) << 4)) = hi;
        }
        __syncthreads();
        unsigned char* const dst = T.dst; const int dpitch = T.dpitch;
        int kn; if constexpr (STEAL) kn = word[(n + 1) & 1]; else kn = k + stride;
        if (kn < F8_TILES_PER_LAYER) { T = f8_tile(a, lds, ws, f8_tile_of(l, kn), lane, wave); F8_LOADS(); }
        __builtin_amdgcn_sched_barrier(0);
#pragma unroll
        for (int it = 0; it < 8; ++it) { const int id = it * NTHREADS + tid, R = id >> 4, cl = id & 15;
            const u32x4 o = *(const LAS u32x4*)(buf + R * 256 + ((cl ^ ((R >> 2) & 15)) << 4));
            __builtin_nontemporal_store(o, (u32x4*)(dst + (size_t)R * dpitch + cl * 16)); }
        k = kn; ++n;
    }
#undef F8_LOADS
    __syncthreads();
}
__device__ __forceinline__ void phase_prologue(const Args& a, LAS unsigned char* lds, int G, int tid, int lane, int wave) {
    unsigned char* ws = a.ws;
    f8_convert<false>(a, lds, ws, 0, (int)blockIdx.x, G, 0, nullptr, tid, lane, wave);
    LAS unsigned char* scr = lds + wave * 8704;
    const int gw = blockIdx.x * NWAVES + wave, NGW = G * NWAVES;
    constexpr int nB = 4 * 32 * 32, nE = 4 * 8 * 8, nF = 16 * 2 * 4;
    constexpr int NITEMS = nB + nE + nF;
    for (int it0 = gw; it0 < NITEMS; it0 += NGW) {
        int it = it0; const float* src; unsigned char* dst; int ld, dpitch;
        if (it < nB) { continue;
            const int l = it / 1024, r = it % 1024, kt = r / 32, nt = r % 32;
            src = AIN(I_WOUT) + (size_t)l * DM * DM + (size_t)(kt * 64) * DM + nt * 64 + lane; ld = DM;
            dst = ws + WS_WOUT + ((size_t)l * DM * DM + (size_t)(nt * 64) * DM + kt * 64) * 2; dpitch = DM * 2; }
        else if ((it -= nB) < nE) { const int l = it / 64, r = it % 64, kt = r / 8, nt = r % 8;
            src = AIN(I_CPW) + (size_t)l * CW * CW + (size_t)(kt * 64) * CW + nt * 64 + lane; ld = CW;
            dst = ws + WS_PW + ((size_t)l * CW * CW + (size_t)(nt * 64) * CW + kt * 64) * 2; dpitch = CW * 2; }
        else { it -= nE; const int lb = it / 8, r = it % 8, kt = r / 4, nt = r % 4, np = nt * 64 + lane;
            src = ((np < 128) ? AIN(I_RWA) : AIN(I_RWX)) + (size_t)lb * 128 * 128 + (size_t)(kt * 64) * 128 + (np & 127); ld = 128;
            dst = ws + WS_WRG + ((size_t)lb * 256 * 128 + (size_t)(nt * 64) * 128 + kt * 64) * 2; dpitch = 128 * 2; }
        cvt_tile<false>(src, ld, dst, dpitch, 1.f, scr, lane);
    }
    const int gt = blockIdx.x * NTHREADS + tid, NGT = G * NTHREADS;
    { const float* x = AIN(I_X); unsigned char* xb = ws + WS_XB;
      for (int i = gt; i < MTOK * DM / 8; i += NGT) { const f32x4 v0 = *(const f32x4*)(x + (size_t)i * 8), v1 = *(const f32x4*)(x + (size_t)i * 8 + 4);
          u32x2 w; w.x = cvt4_fp8(v0[0], v0[1], v0[2], v0[3]); w.y = cvt4_fp8(v1[0], v1[1], v1[2], v1[3]);
          *(u32x2*)(xb + (size_t)i * 8) = w;
          u32x4 h; h.x = cvt_pk_bf16(v0[0], v0[1]); h.y = cvt_pk_bf16(v0[2], v0[3]); h.z = cvt_pk_bf16(v1[0], v1[1]); h.w = cvt_pk_bf16(v1[2], v1[3]);
          *(u32x4*)((bf16_t*)(ws + WS_XA) + (size_t)i * 8) = h; } }
    { const float* rtw = AIN(I_RTW); float* img = (float*)(ws + WS_RWT);
      for (int i = gt; i < DM * NEXP; i += NGT) img[(i & 15) * 2052 + (i >> 4)] = rtw[i];
      for (int i = gt; i < 16 * 4 + 448; i += NGT) { if (i < 64) img[(i >> 2) * 2052 + 2048 + (i & 3)] = 0.f; else img[16 * 2052 + (i - 64)] = 0.f; } }
    { float* cosT = (float*)(ws + WS_COS); float* sinT = (float*)(ws + WS_SIN);
      for (int i = gt; i < SEQ * 64; i += NGT) { const int pos = i >> 6, j = i & 63;
          const float inv = exp2f(-(float)j * 0.20762050593046014f);
          const float ang = (float)pos * inv;
          const double ad = (double)ang; const double n = rint(ad * 0.15915494309189535); const float r = (float)(ad - n * 6.283185307179586);
          cosT[i] = cosf(r); sinT[i] = sinf(r); } }
    { float* sp8 = (float*)(ws + WS_SP8);
      const float* rlam = AIN(I_RLAM);
      for (int i = gt; i < NLAYER * RW; i += NGT) { const float lam = rlam[i]; sp8[i] = 8.f * log1pf(expf(-lam)); } }
}

__device__ __forceinline__ void conv_unit(const Args& a, int l, int u, LAS unsigned char* lds, int tid, int lane, int wave) {
    unsigned char* ws = opaque_p(a.ws);
    const bf16_t* Z = (const bf16_t*)(ws + WS_Z);
    LAS float* gbuf = (LAS float*)lds;
    LAS float* cbuf = gbuf + 46 * 512;
    const int c = tid, rowbase = u * 16, t0 = rowbase & (SEQ - 1);
    {
        u32x4 r1[6], r2[6];
#pragma unroll
        for (int k = 0; k < 6; ++k) { const int i = tid + 512 * k, j = i >> 6, q = i & 63; const bool ok = (i < 46 * 64) && (t0 - 30 + j >= 0);
            const size_t ro = (size_t)(rowbase - 30 + (ok ? j : 30)) * DIN + ZC_OFF + 8 * q;
            r1[k] = *(const u32x4*)(Z + ro); r2[k] = *(const u32x4*)(Z + ro + CW);
            if (!ok) { r1[k] = (u32x4){0u, 0u, 0u, 0u}; } }
#pragma unroll
        for (int k = 0; k < 6; ++k) { const int i = tid + 512 * k, j = i >> 6, q = i & 63;
            if (i < 46 * 64) { f32x4 g0, g1;
                g0[0] = bflo(r1[k].x) * sigmoidf_(bflo(r2[k].x)); g0[1] = bfhi(r1[k].x) * sigmoidf_(bfhi(r2[k].x));
                g0[2] = bflo(r1[k].y) * sigmoidf_(bflo(r2[k].y)); g0[3] = bfhi(r1[k].y) * sigmoidf_(bfhi(r2[k].y));
                g1[0] = bflo(r1[k].z) * sigmoidf_(bflo(r2[k].z)); g1[1] = bfhi(r1[k].z) * sigmoidf_(bfhi(r2[k].z));
                g1[2] = bflo(r1[k].w) * sigmoidf_(bflo(r2[k].w)); g1[3] = bfhi(r1[k].w) * sigmoidf_(bfhi(r2[k].w));
                *(LAS f32x4*)(gbuf + j * 512 + 8 * q) = g0; *(LAS f32x4*)(gbuf + j * 512 + 8 * q + 4) = g1; } }
    }
    __syncthreads();
    float w[CK]; const float* cdw = AIN(I_CDW);
#pragma unroll
    for (int j = 0; j < CK; ++j) w[j] = cdw[(size_t)l * CK * CW + j * CW + c];
    for (int t = 0; t < 16; ++t) { float acc = 0.f;
#pragma unroll
        for (int j = 0; j < CK; ++j) acc = fmaf(w[j], gbuf[(t + j) * 512 + c], acc);
        cbuf[t * 512 + c] = acc; }
    __syncthreads();
    {
        const float* lg = AIN(I_CLNG) + l * CW + lane * 8; const float* lb = AIN(I_CLNB) + l * CW + lane * 8;
        const f32x4 g0 = *(const f32x4*)lg, g1 = *(const f32x4*)(lg + 4), b0 = *(const f32x4*)lb, b1 = *(const f32x4*)(lb + 4);
        bf16_t* SC = (bf16_t*)(ws + WS_SCONV);
#pragma unroll
        for (int q = 0; q < 2; ++q) { const int tt = wave + 8 * q;
            f32x4 v0 = *(const LAS f32x4*)(cbuf + tt * 512 + lane * 8), v1 = *(const LAS f32x4*)(cbuf + tt * 512 + lane * 8 + 4);
            const float mean = wave_sum((v0[0] + v0[1]) + (v0[2] + v0[3]) + (v1[0] + v1[1]) + (v1[2] + v1[3])) * (1.f / CW);
            v0 = v0 - mean; v1 = v1 - mean;
            const float var = wave_sum((v0[0] * v0[0] + v0[1] * v0[1]) + (v0[2] * v0[2] + v0[3] * v0[3]) + (v1[0] * v1[0] + v1[1] * v1[1]) + (v1[2] * v1[2] + v1[3] * v1[3])) * (1.f / CW);
            const float rstd = __builtin_amdgcn_rsqf(var + LN_EPS);
            v0 = v0 * rstd * g0 + b0; v1 = v1 * rstd * g1 + b1;
            float y[8] = {v0[0], v0[1], v0[2], v0[3], v1[0], v1[1], v1[2], v1[3]};
#pragma unroll
            for (int k = 0; k < 8; ++k) y[k] = y[k] * sigmoidf_(y[k]);
            u32x4 o; o.x = cvt_pk_bf16(y[0], y[1]); o.y = cvt_pk_bf16(y[2], y[3]); o.z = cvt_pk_bf16(y[4], y[5]); o.w = cvt_pk_bf16(y[6], y[7]);
            *(u32x4*)(SC + (size_t)(rowbase + tt) * CW + lane * 8) = o; }
    }
    {
        const float* rcw = AIN(I_RCW) + (size_t)l * 4 * RW + c;
        const float w0 = rcw[0], w1 = rcw[RW], w2 = rcw[2 * RW], w3 = rcw[3 * RW];
        const float bias = AIN(I_RCB)[l * RW + c];
        bf16_t* XC = (bf16_t*)(ws + WS_XC);
        float xs[19];
#pragma unroll
        for (int t = 0; t < 19; ++t) { const bool ok = (t >= 3) || (t0 >= 3); xs[t] = ok ? bf2f(Z[(size_t)(rowbase - 3 + t) * DIN + ZRX_OFF + c]) : 0.f; }
#pragma unroll
        for (int t = 0; t < 16; ++t) { const float xc = fmaf(w0, xs[t], fmaf(w1, xs[t + 1], fmaf(w2, xs[t + 2], w3 * xs[t + 3]))) + bias;
            XC[(size_t)(rowbase + t) * RW + c] = (bf16_t)(cvt_pk_bf16(xc, 0.f) & 0xffffu); }
    }
    __syncthreads();
}

__device__ __forceinline__ void moe_meta(const Args& a, LAS unsigned char* lds, int tid, int l) {
    volatile LAS int* meta = (volatile LAS int*)(lds + META_OFF);
    const unsigned* fill = (const unsigned*)(opaque_p(a.ws) + WS_CTL) + CW_FILL + 64 * l;
    __syncthreads();
    if (tid < 64) {
        const int c = (tid < 16) ? (int)__hip_atomic_load(fill + (tid & 15), __ATOMIC_RELAXED, __HIP_MEMORY_SCOPE_AGENT) : 0;
        const int p = ((c + 255) >> 8) << 8;
        int sc = p;
        sc += __builtin_amdgcn_update_dpp(0, sc, 0x111, 0xf, 0xf, true); sc += __builtin_amdgcn_update_dpp(0, sc, 0x112, 0xf, 0xf, true);
        sc += __builtin_amdgcn_update_dpp(0, sc, 0x114, 0xf, 0xf, true); sc += __builtin_amdgcn_update_dpp(0, sc, 0x118, 0xf, 0xf, true);
        if (tid < 16) { meta[tid] = c; meta[16 + tid] = sc - p; }
        if (tid == 15) meta[32] = sc >> 8;
    }
    __syncthreads();
    if (tid < 80) {
        const LAS int4_t* bp = (const LAS int4_t*)(lds + META_OFF + 64);
        const int4_t b0 = bp[0], b1 = bp[1], b2 = bp[2], b3 = bp[3]; const int r = tid * 256;
        const int e = (r >= b0.y) + (r >= b0.z) + (r >= b0.w) + (r >= b1.x) + (r >= b1.y) + (r >= b1.z) + (r >= b1.w) + (r >= b2.x) + (r >= b2.y) + (r >= b2.z) + (r >= b2.w)
                    + (r >= b3.x) + (r >= b3.y) + (r >= b3.z) + (r >= b3.w);
        meta[48 + tid] = e; }
    __syncthreads();
}

__global__ void __launch_bounds__(NTHREADS, 2) hybrid_fwd(Args a) {
    extern __shared__ __attribute__((aligned(16))) unsigned char lds_raw[];
    LAS unsigned char* const lds0 = (LAS unsigned char*)lds_raw;
    LAS unsigned char* lds = lds0;
    volatile LAS unsigned* MISC = (volatile LAS unsigned*)(lds + MISC_OFF);
    const int wid0 = __builtin_amdgcn_readfirstlane((int)threadIdx.x >> 6);
    const int tid = tidx(wid0), lane = tid & 63, wave = wid0;
    const int G = gridDim.x;
    unsigned char* ws = a.ws;
    unsigned* ctl = (unsigned*)(ws + WS_CTL);
    if (tid < 32) MISC[tid] = 0u;
    if (tid == 0) {
#pragma unroll
        for (int k = 0; k < 28; ++k) ((volatile LAS unsigned long long*)(lds + PTAB_OFF))[k] = (unsigned long long)a.in[k];
    }
    __syncthreads();
#if N_LAUNCH_MODE == 1
    if (blockIdx.x == 0) {
        u32x4* z = (u32x4*)ctl;
        for (int i = tid; i < 4096; i += NTHREADS) if (i != CW_FLAG / 4) z[i] = (u32x4){0u, 0u, 0u, 0u};
        asm volatile("s_waitcnt vmcnt(0)" ::: "memory");
        __syncthreads();
        if (tid == 0) { __builtin_amdgcn_fence(__ATOMIC_RELEASE, "agent"); __hip_atomic_store(ctl + CW_FLAG, CTL_MAGIC, __ATOMIC_RELAXED, __HIP_MEMORY_SCOPE_AGENT); }
    }
#endif
    const int lo = a.ph_lo, hi = a.ph_hi;
#ifndef ONLY_PH
#define ONLY_PH -1
#endif
#define PHEN(p) (ONLY_PH < 0 || ONLY_PH == (p))
#ifndef REPEAT_MASK
#define REPEAT_MASK 0
#endif
#define NREP(p) (((REPEAT_MASK >> (p)) & 1) ? 2 : 1)
#define IN(k) (lo <= (k) && (k) < hi)
#ifndef SEAM_REP
#define SEAM_REP 1
#endif
#define SEAM(k) do { if (IN(k) && IN((k) + 1)) for (int _r = 0; _r < SEAM_REP; ++_r) xcd_barrier(bar, wid0); } while (0)
    const int gw = blockIdx.x * NWAVES + wave, NGW = G * NWAVES;

    if (PHEN(0) && IN(0)) for (int rep = 0; rep < NREP(0); ++rep) { phase_prologue(a, lds, G, tid, lane, wave); __syncthreads(); }
#if N_LAUNCH_MODE == 1
    if (tid == 0 && blockIdx.x != 0) { unsigned sp = 0u;
        while (__hip_atomic_load(ctl + CW_FLAG, __ATOMIC_RELAXED, __HIP_MEMORY_SCOPE_AGENT) != CTL_MAGIC) { __builtin_amdgcn_s_sleep(2); if (++sp > (1u << 22)) break; }
        __builtin_amdgcn_fence(__ATOMIC_ACQUIRE, "agent"); asm volatile("s_waitcnt vmcnt(0)" ::: "memory"); }
    __syncthreads();
#endif
    XcdBarrier bar = xcd_barrier_post(ctl + CW_BAR, MISC + 8);
    SEAM(0);
#if N_LAUNCH_MODE == 1
    if (blockIdx.x == 0 && tid == 0) __hip_atomic_store(ctl + CW_FLAG, 0u, __ATOMIC_RELAXED, __HIP_MEMORY_SCOPE_AGENT);
#endif

    for (int l = 0; l < NLAYER; ++l) {
        const int pb = 1 + l * NPH;

        if (PHEN(1) && IN(pb + 0)) for (int rep = 0; rep < NREP(1); ++rep) { unsigned char* ws = opaque_p(a.ws); LAS unsigned char* lds = opaque_p(lds0); const int bid = opaque_s((int)blockIdx.x); const int tid = tidx(wid0), lane = tid & 63, wave = __builtin_amdgcn_readfirstlane(tid >> 6), gw = bid * NWAVES + wave; (void)lane; (void)gw;
            pg8::Gemm g{ws, (unsigned)WS_XB, (unsigned)(WS_WIN + (size_t)l * DIN * DM), DM / 2, DM / 2, opaque_s(DM / 2)};
            pg8::GridOrder S; S.init(MTOK, DIN, DM / 2, DM / 2, G, bid);
            EpiZ E{(bf16_t*)(ws + WS_Z), (const float*)(ws + WS_COS), (const float*)(ws + WS_SIN)};
            pg8::gemm_phase<EpiZ, pg8::GridOrder, true, true>(lds, g, S, E, wid0);
            if (l + 1 < NLAYER && G == 256 && bid >= 128)
                f8_convert<true>(a, lds, ws, l + 1, 0, 0, 2, (unsigned*)(ws + WS_CTL) + CW_TICK + 64 * (l + 1), tid, lane, wave);
        }
        SEAM(pb + 0);

        if (PHEN(2) && IN(pb + 1)) for (int rep = 0; rep < NREP(2); ++rep) { unsigned char* ws = opaque_p(a.ws); LAS unsigned char* lds = opaque_p(lds0); const int bid = opaque_s((int)blockIdx.x); const int tid = tidx(wid0), lane = tid & 63, wave = __builtin_amdgcn_readfirstlane(tid >> 6), gw = bid * NWAVES + wave; (void)lane; (void)gw;
#ifndef NO_ATT
            att::attn_phase((char*)lds, (const bf16_t*)(ws + WS_Z), (bf16_t*)(ws + WS_OC), G, (G == 256) ? ((bid & 7) * 32 + (bid >> 3)) : bid, wid0);
#endif
            __syncthreads();
#ifndef NO_CONV
            for (int u0 = bid; u0 < MTOK / 16; u0 += G) {
                const int u = (G == 256) ? ((bid & 7) * 64 + (bid >> 3) * 2 + (u0 >> 8)) : u0;
                conv_unit(a, l, u, lds, tid, lane, wave); }
#endif
        }
        SEAM(pb + 1);

        if (PHEN(3) && IN(pb + 2)) for (int rep = 0; rep < NREP(3); ++rep) { unsigned char* ws = opaque_p(a.ws); LAS unsigned char* lds = opaque_p(lds0); const int bid = opaque_s((int)blockIdx.x); const int tid = tidx(wid0), lane = tid & 63, wave = __builtin_amdgcn_readfirstlane(tid >> 6), gw = bid * NWAVES + wave; (void)lane; (void)gw;
            pg8::Gemm g{ws, (unsigned)WS_XC, (unsigned)(WS_WRG + (size_t)l * 4 * 256 * 128 * 2), RW, 128, opaque_s(128)};
            RgOrder S{G, bid};
            EpiGate E{(float*)(ws + WS_SA), (float*)(ws + WS_SB), (const bf16_t*)(ws + WS_XC), AIN(I_RBA) + l * RW, AIN(I_RBX) + l * RW, (const float*)(ws + WS_SP8) + l * RW, (float*)(ws + WS_SUMA), (float*)(ws + WS_SUMH)};
            pg8::gemm_phase<EpiGate, RgOrder, true>(lds, g, S, E, wid0);
            if (bid >= 128) {
                pg8::Gemm g2{ws, (unsigned)WS_SCONV, (unsigned)(WS_PW + (size_t)l * CW * CW * 2), CW, CW, CW};
                pg8::GridOrder S2; S2.init(MTOK, CW, CW, CW, G - 128, bid - 128);
                EpiBf16Off E2{ws + WS_CAT, DM, 1024};
                pg8::gemm_phase<EpiBf16Off, pg8::GridOrder, true>(lds, g2, S2, E2, wid0);
                if (l + 1 < NLAYER && G == 256)
                    f8_convert<true>(a, lds, ws, l + 1, 0, 0, bid >= 192 ? 2 : 1, (unsigned*)(ws + WS_CTL) + CW_TICK + 64 * (l + 1), tid, lane, wave);
            }
        }
        SEAM(pb + 2);

        if (PHEN(5) && IN(pb + 4)) for (int rep = 0; rep < NREP(5); ++rep) { unsigned char* ws = opaque_p(a.ws); LAS unsigned char* lds = opaque_p(lds0); const int bid = opaque_s((int)blockIdx.x); const int tid = tidx(wid0), lane = tid & 63, wave = __builtin_amdgcn_readfirstlane(tid >> 6), gw = bid * NWAVES + wave; (void)lane; (void)gw;
            unsigned char* CAT = ws + WS_CAT;
            {
                const float li = 0.8f - 0.6f * expf(-0.3f * (float)l);
                const float* q1 = AIN(I_LQ1) + l * 128 + lane; const float* k1 = AIN(I_LK1) + l * 128 + lane; const float* q2 = AIN(I_LQ2) + l * 128 + lane; const float* k2 = AIN(I_LK2) + l * 128 + lane;
                const float d1 = wave_sum(q1[0] * k1[0] + q1[64] * k1[64]);
                const float d2 = wave_sum(q2[0] * k2[0] + q2[64] * k2[64]);
                const float lam = expf(d1) - expf(d2) + li;
                const f32x4 sg = *(const f32x4*)(AIN(I_SUBLN) + l * 256 + lane * 4) * (1.f - li);
                const bf16_t* O0 = (const bf16_t*)(ws + WS_OC); const bf16_t* O1 = O0 + (size_t)MTOK * 1024;
                for (int row0 = gw; row0 < MTOK; row0 += 2 * NGW) {
                    f32x4 p0[2][4], p1[2][4];
#pragma unroll
                    for (int rr = 0; rr < 2; ++rr)
#pragma unroll
                        for (int h = 0; h < 4; ++h) { const int row = row0 + rr * NGW; const size_t off = (size_t)(row < MTOK ? row : row0) * 1024 + h * 256 + lane * 4;
                            const u32x2 a0 = *(const u32x2*)(O0 + off), a1 = *(const u32x2*)(O1 + off);
                            p0[rr][h] = (f32x4){bflo(a0.x), bfhi(a0.x), bflo(a0.y), bfhi(a0.y)}; p1[rr][h] = (f32x4){bflo(a1.x), bfhi(a1.x), bflo(a1.y), bfhi(a1.y)}; }
#pragma unroll
                    for (int rr = 0; rr < 2; ++rr) { const int row = row0 + rr * NGW;
                        if (row < MTOK) {
#pragma unroll
                            for (int h = 0; h < 4; ++h) {
                                const f32x4 o = p0[rr][h] - p1[rr][h] * lam;
                                const float ss = wave_sum((o[0] * o[0] + o[1] * o[1]) + (o[2] * o[2] + o[3] * o[3]));
                                const float r = __builtin_amdgcn_rsqf(ss * (1.f / 256.f) + LN_EPS);
                                const f32x4 y = o * r * sg;
                                __builtin_nontemporal_store(cvt4_fp8(y[0] * CAT_SCALE, y[1] * CAT_SCALE, y[2] * CAT_SCALE, y[3] * CAT_SCALE), (unsigned*)(CAT + (size_t)row * DM + h * 256 + lane * 4)); } } }
                }
            }
            {
                const float* SA = (const float*)(ws + WS_SA); const float* SB = (const float*)(ws + WS_SB);
                const float* sumA = (const float*)(ws + WS_SUMA); const float* sumH = (const float*)(ws + WS_SUMH);
                const bf16_t* Z = (const bf16_t*)(ws + WS_Z);
                for (int u = bid; u < MTOK / 32; u += G) {
                    const int j = u & 63; float carry = 0.f;
                    for (int jj0 = 0; jj0 < j; jj0 += 32) { float ca[32], ch[32];
#pragma unroll
                        for (int q = 0; q < 32; ++q) { const bool ok = jj0 + q < j; const int idx = (u - j + (ok ? jj0 + q : 0)) * RW + tid; ca[q] = sumA[idx]; ch[q] = sumH[idx]; if (!ok) { ca[q] = 1.f; ch[q] = 0.f; } }
#pragma unroll
                        for (int q = 0; q < 32; ++q) carry = fmaf(ca[q], carry, ch[q]); }
#pragma unroll
                    for (int hb = 0; hb < 2; ++hb) { float pa[16], hl[16], gx[16];
#pragma unroll
                        for (int t = 0; t < 16; ++t) { const size_t row = (size_t)u * 32 + hb * 16 + t; pa[t] = SA[row * RW + tid]; hl[t] = SB[row * RW + tid]; gx[t] = bf2f(Z[row * DIN + ZRG_OFF + tid]); }
#pragma unroll
                        for (int t = 0; t < 16; ++t) { const size_t row = (size_t)u * 32 + hb * 16 + t;
                            const float h = fmaf(pa[t], carry, hl[t]), x = gx[t];
                            const float y = 0.7978845608028654f * (x + 0.044715f * x * x * x);
                            const float th = 1.f - 2.f * __builtin_amdgcn_rcpf(__expf(2.f * y) + 1.f);
                            const float ge = 0.5f * x * (1.f + th);
                            const float cv = h * ge * CAT_SCALE; __builtin_nontemporal_store((unsigned char)(cvt4_fp8(cv, cv, cv, cv) & 0xffu), CAT + row * DM + 1536 + tid); } }
                }
            }
        }
        SEAM(pb + 4);

        if (PHEN(6) && IN(pb + 5)) for (int rep = 0; rep < NREP(6); ++rep) { unsigned char* ws = opaque_p(a.ws); LAS unsigned char* lds = opaque_p(lds0); const int bid = opaque_s((int)blockIdx.x); const int tid = tidx(wid0), lane = tid & 63, wave = __builtin_amdgcn_readfirstlane(tid >> 6), gw = bid * NWAVES + wave; (void)lane; (void)gw;
            pg8::Gemm g{ws, (unsigned)WS_CAT, (unsigned)(WS_WOUT + (size_t)l * DM * DM), DM / 2, DM / 2, opaque_s(DM / 2)};
            pg8::GridOrder S; S.init(MTOK, DM, DM / 2, DM / 2, G, bid);
            EpiResBf16 E{(bf16_t*)(ws + WS_YBUF), (const bf16_t*)(ws + WS_XA)};
            pg8::gemm_phase<EpiResBf16, pg8::GridOrder, true, true>(lds, g, S, E, wid0);
#ifdef DUP_P6
            { if (opaque_s(1)) pg8::gemm_phase<EpiResBf16, pg8::GridOrder, true, false, 1>(lds, g, S, E, wid0); }
#endif
        }
        SEAM(pb + 5);

        if (PHEN(7) && IN(pb + 6)) for (int rep = 0; rep < NREP(7); ++rep) { unsigned char* ws = opaque_p(a.ws); LAS unsigned char* lds = opaque_p(lds0); const int bid = opaque_s((int)blockIdx.x); const int tid = tidx(wid0), lane = tid & 63, wave = __builtin_amdgcn_readfirstlane(tid >> 6), gw = bid * NWAVES + wave; (void)lane; (void)gw;
            LAS float* rwT = (LAS float*)lds;
            LAS int* hist = (LAS int*)(lds + META_OFF);
            LAS int* ent = (LAS int*)(lds + 131328);
            {
                const unsigned char* img = ws + WS_RWT;
#pragma unroll
                for (int i = 0; i < 16; ++i) __builtin_amdgcn_global_load_lds((const unsigned*)(img + (size_t)(i * 8 + wave) * 1024 + lane * 16), (LAS unsigned*)(lds + (i * 8 + wave) * 1024), 16, 0, 0);
                if (wave == 0) __builtin_amdgcn_global_load_lds((const unsigned*)(img + (size_t)128 * 1024 + lane * 16), (LAS unsigned*)(lds + 128 * 1024), 16, 0, 0);
            }
            float rb[16]; const float* rtb = AIN(I_RTB);
#pragma unroll
            for (int e = 0; e < 16; ++e) rb[e] = rtb[e];
            const bf16_t* YB = (const bf16_t*)(ws + WS_YBUF); bf16_t* X1B = (bf16_t*)(ws + WS_X1B);
            int* tokE = (int*)(ws + WS_TOKE); int* tokP = (int*)(ws + WS_TOKS); int* lst = (int*)(ws + WS_LIST); float* lstW = (float*)(ws + WS_LISTW); unsigned char* X1F = ws + WS_XG;
            unsigned* fill = (unsigned*)(ws + WS_CTL) + CW_FILL + 64 * l;
            const float* lg = AIN(I_LN1G) + l * DM; const float* lb = AIN(I_LN1B) + l * DM;
            for (int v = bid; v < 256; v += G) {
                __syncthreads();
                if (tid < 16) hist[tid] = 0;
                __syncthreads();
                u32x2 raw[2][8];
#pragma unroll
                for (int q = 0; q < 2; ++q)
#pragma unroll
                    for (int j = 0; j < 8; ++j) raw[q][j] = __builtin_nontemporal_load((const u32x2*)(YB + (size_t)(v * 32 + wave + 8 * q) * DM + j * 256 + lane * 4));
                asm volatile("s_waitcnt vmcnt(0)" ::: "memory"); __syncthreads();
#define P7_LN(q_, ri_, YV_) do { const int row = v * 32 + wave + 8 * (q_); float s = 0.f;                                                                       \
                    _Pragma("unroll") for (int j = 0; j < 8; ++j) { const u32x2 p = raw[ri_][j]; YV_[j] = (f32x4){bflo(p.x), bfhi(p.x), bflo(p.y), bfhi(p.y)}; s += (YV_[j][0] + YV_[j][1]) + (YV_[j][2] + YV_[j][3]); } \
                    const float mean = wave_sum(s) * (1.f / DM); float s2 = 0.f;                                                                                 \
                    _Pragma("unroll") for (int j = 0; j < 8; ++j) { YV_[j] = YV_[j] - mean; s2 += (YV_[j][0] * YV_[j][0] + YV_[j][1] * YV_[j][1]) + (YV_[j][2] * YV_[j][2] + YV_[j][3] * YV_[j][3]); } \
                    const float rstd = __builtin_amdgcn_rsqf(wave_sum(s2) * (1.f / DM) + LN_EPS);                                                                \
                    const float* lgq = opaque_p(lg); const float* lbq = opaque_p(lb);     \
                    _Pragma("unroll") for (int j = 0; j < 8; ++j) { const f32x4 gg = *(const f32x4*)(lgq + j * 256 + lane * 4), bb = *(const f32x4*)(lbq + j * 256 + lane * 4); \
                        YV_[j] = YV_[j] * rstd * gg + bb;                                                                                                            \
                        u32x2 w; w.x = cvt_pk_bf16(YV_[j][0], YV_[j][1]); w.y = cvt_pk_bf16(YV_[j][2], YV_[j][3]);                                                       \
                        __builtin_nontemporal_store(w, (u32x2*)(X1B + (size_t)row * DM + j * 256 + lane * 4));                                                                            \
                        __builtin_nontemporal_store(cvt4_fp8(YV_[j][0], YV_[j][1], YV_[j][2], YV_[j][3]), (unsigned*)(X1F + (size_t)row * DM + j * 256 + lane * 4)); } } while (0)
#define P7_PICK(q_, AC_) do { float sc[16], bi[16];                                                                                                             \
                    _Pragma("unroll") for (int e = 0; e < 16; ++e) { AC_[e] = wave_sum(AC_[e]); sc[e] = sigmoidf_(AC_[e]); bi[e] = sc[e] + rb[e]; }              \
                    float bgs = -__builtin_inff(); int e1 = 0, e2 = 1; float s1 = 0.f, sv2 = 0.f;                                                                \
                    _Pragma("unroll") for (int g = 0; g < 4; ++g) {                                                                                              \
                        const float b0 = bi[4 * g], b1 = bi[4 * g + 1], b2 = bi[4 * g + 2], b3 = bi[4 * g + 3];                                                  \
                        const float t0 = sc[4 * g], t1 = sc[4 * g + 1], t2 = sc[4 * g + 2], t3 = sc[4 * g + 3];                                                  \
                        int i1 = 0; float m1 = b0, c1 = t0;                                                                                                      \
                        if (b1 > m1) { m1 = b1; i1 = 1; c1 = t1; } if (b2 > m1) { m1 = b2; i1 = 2; c1 = t2; } if (b3 > m1) { m1 = b3; i1 = 3; c1 = t3; }          \
                        int i2 = 0; float m2 = -__builtin_inff(), c2 = 0.f;                                                                                      \
                        if (i1 != 0 && b0 > m2) { m2 = b0; i2 = 0; c2 = t0; } if (i1 != 1 && b1 > m2) { m2 = b1; i2 = 1; c2 = t1; }                              \
                        if (i1 != 2 && b2 > m2) { m2 = b2; i2 = 2; c2 = t2; } if (i1 != 3 && b3 > m2) { m2 = b3; i2 = 3; c2 = t3; }                              \
                        const float gs = m1 + m2;                                                                                                                \
                        if (gs > bgs) { bgs = gs; e1 = 4 * g + i1; e2 = 4 * g + i2; s1 = c1; sv2 = c2; }                                                         \
                    }                                                                                                                                            \
                    if (lane == 0) { const float inv = 1.f / (s1 + sv2); const int rl = wave + 8 * (q_);                                                         \
                        const int r1 = __hip_atomic_fetch_add(hist + e1, 1, __ATOMIC_RELAXED, __HIP_MEMORY_SCOPE_WORKGROUP), r2 = __hip_atomic_fetch_add(hist + e2, 1, __ATOMIC_RELAXED, __HIP_MEMORY_SCOPE_WORKGROUP); \
                        ent[rl * 6 + 0] = e1; ent[rl * 6 + 1] = r1; ent[rl * 6 + 2] = __float_as_int(s1 * inv); ent[rl * 6 + 3] = e2; ent[rl * 6 + 4] = r2; ent[rl * 6 + 5] = __float_as_int(sv2 * inv); } } while (0)
#pragma unroll
                for (int qp = 0; qp < 2; ++qp) {
                    __builtin_amdgcn_sched_barrier(0);
                    f32x4 ya[8], yb[8];
                    P7_LN(2 * qp, 0, ya);
                    __builtin_amdgcn_sched_barrier(0);
                    P7_LN(2 * qp + 1, 1, yb);
                    __builtin_amdgcn_sched_barrier(0);
                    if (qp == 0) {
#pragma unroll
                        for (int q = 0; q < 2; ++q)
#pragma unroll
                            for (int j = 0; j < 8; ++j) raw[q][j] = __builtin_nontemporal_load((const u32x2*)(YB + (size_t)(v * 32 + wave + 8 * (2 + q)) * DM + j * 256 + lane * 4));
                        __builtin_amdgcn_sched_barrier(0);
                    }
                    f32x2 y2[8][4];
#pragma unroll
                    for (int j = 0; j < 8; ++j)
#pragma unroll
                        for (int c = 0; c < 4; ++c) y2[j][c] = (f32x2){ya[j][c], yb[j][c]};
                    f32x2 acc2[16];
#pragma unroll
                    for (int e = 0; e < 16; ++e) acc2[e] = (f32x2){0.f, 0.f};
#pragma unroll
                    for (int j = 0; j < 8; ++j) {
#pragma unroll
                        for (int e = 0; e < 16; ++e) { const f32x4 w = *(const LAS f32x4*)(rwT + e * 2052 + j * 256 + lane * 4);
                            acc2[e] += y2[j][0] * (f32x2){w[0], w[0]}; acc2[e] += y2[j][1] * (f32x2){w[1], w[1]};
                            acc2[e] += y2[j][2] * (f32x2){w[2], w[2]}; acc2[e] += y2[j][3] * (f32x2){w[3], w[3]}; }
                        __builtin_amdgcn_sched_barrier(0);
                    }
                    float acca[16], accb[16];
#pragma unroll
                    for (int e = 0; e < 16; ++e) { acca[e] = acc2[e][0]; accb[e] = acc2[e][1]; }
                    P7_PICK(2 * qp, acca);
                    __builtin_amdgcn_sched_barrier(0);
                    P7_PICK(2 * qp + 1, accb);
                }
#undef P7_LN
#undef P7_PICK
                __syncthreads();
                if (tid < 16) hist[16 + tid] = (int)__hip_atomic_fetch_add(fill + tid, (unsigned)hist[tid], __ATOMIC_RELAXED, __HIP_MEMORY_SCOPE_AGENT);
                __syncthreads();
                if (tid < 64) { const int rl = tid >> 1, k = tid & 1, e = ent[rl * 6 + 3 * k], p = hist[16 + e] + ent[rl * 6 + 3 * k + 1], row = v * 32 + rl;
                    lst[e * MTOK + p] = row; lstW[e * MTOK + p] = __int_as_float(ent[rl * 6 + 3 * k + 2]); tokE[row * 2 + k] = e; tokP[row * 2 + k] = p; }
            }
            __syncthreads();
        }
        SEAM(pb + 6);

        if (PHEN(9) && IN(pb + 8)) for (int rep = 0; rep < NREP(9); ++rep) { unsigned char* ws = opaque_p(a.ws); LAS unsigned char* lds = opaque_p(lds0); const int bid = opaque_s((int)blockIdx.x); const int tid = tidx(wid0), lane = tid & 63, wave = __builtin_amdgcn_readfirstlane(tid >> 6), gw = bid * NWAVES + wave; (void)lane; (void)gw;
            moe_meta(a, lds, tid, l);
            volatile LAS int* meta = (volatile LAS int*)(lds + META_OFF);
            const int tot = meta[32] * 8, F = 2 * G;
            pg8::Gemm g{ws, (unsigned)WS_XG, (unsigned)(WS_W1 + (size_t)l * NEXP * 2048 * DM), DM / 2, DM / 2, opaque_s(DM / 2)};
            MoeOrder<true> S{G, bid, 0, tot < F ? tot : F, DM / 2, DM / 2, meta, (unsigned)(2048 * DM), G == 256 && tot >= 512, (const int*)(ws + WS_LIST)};
            EpiSwiGLU E{ws + WS_HB};
            pg8::gemm_phase<EpiSwiGLU, MoeOrder<true>, true, true>(lds, g, S, E, wid0);
        }
        SEAM(pb + 8);
        if (PHEN(10) && IN(pb + 9)) for (int rep = 0; rep < NREP(10); ++rep) { unsigned char* ws = opaque_p(a.ws); LAS unsigned char* lds = opaque_p(lds0); const int bid = opaque_s((int)blockIdx.x); const int tid = tidx(wid0), lane = tid & 63, wave = __builtin_amdgcn_readfirstlane(tid >> 6), gw = bid * NWAVES + wave; (void)lane; (void)gw;
#if N_LAUNCH_MODE != 1
            moe_meta(a, lds, tid, l);
#endif
            volatile LAS int* meta = (volatile LAS int*)(lds + META_OFF);
            const int tot = meta[32] * 8, F = 2 * G, R = tot > F ? tot - F : 0, done8 = (tot < F ? tot : F) & ~7;
            if (bid < R) {
                pg8::Gemm g{ws, (unsigned)WS_XG, (unsigned)(WS_W1 + (size_t)l * NEXP * 2048 * DM), DM / 2, DM / 2, opaque_s(DM / 2)};
                MoeOrder<true> S{G, bid, F, tot, DM / 2, DM / 2, meta, (unsigned)(2048 * DM), false, (const int*)(ws + WS_LIST)};
                EpiSwiGLU E{ws + WS_HB};
                pg8::gemm_phase<EpiSwiGLU, MoeOrder<true>, true, true, 1>(lds, g, S, E, wid0);
            } else {
                const int Gp = G - R; int hiB = 2 * Gp; if (hiB > done8) hiB = done8; if (hiB < 0) hiB = 0;
                pg8::Gemm g{ws, (unsigned)WS_HB, (unsigned)(WS_W2 + (size_t)l * NEXP * DM * DEXP), DEXP / 2, DEXP / 2, opaque_s(DEXP / 2)};
                MoeOrder<false> S{Gp, bid - R, 0, hiB, DEXP / 2, DEXP / 2, meta, (unsigned)(DM * DEXP), false, nullptr, ((Gp & 7) == 0 && (R & 7) == 0) ? 2 : 0};
                EpiScaleBf16 E{ws + WS_Y2, (const float*)(ws + WS_LISTW)};
                pg8::gemm_phase<EpiScaleBf16, MoeOrder<false>, true, true, 1>(lds, g, S, E, wid0);
            }
        }
        SEAM(pb + 9);
        if (PHEN(11) && IN(pb + 10)) for (int rep = 0; rep < NREP(11); ++rep) { unsigned char* ws = opaque_p(a.ws); LAS unsigned char* lds = opaque_p(lds0); const int bid = opaque_s((int)blockIdx.x); const int tid = tidx(wid0), lane = tid & 63, wave = __builtin_amdgcn_readfirstlane(tid >> 6), gw = bid * NWAVES + wave; (void)lane; (void)gw;
#if N_LAUNCH_MODE != 1
            moe_meta(a, lds, tid, l);
#endif
            volatile LAS int* meta = (volatile LAS int*)(lds + META_OFF);
            const int tot = meta[32] * 8, F = 2 * G, R = tot > F ? tot - F : 0, done8 = (tot < F ? tot : F) & ~7;
            int hiB = 2 * (G - R); if (hiB > done8) hiB = done8; if (hiB < 0) hiB = 0;
            pg8::Gemm g{ws, (unsigned)WS_HB, (unsigned)(WS_W2 + (size_t)l * NEXP * DM * DEXP), DEXP / 2, DEXP / 2, opaque_s(DEXP / 2)};
            const bool xm = (G & 7) == 0 && tot - hiB <= G;
            MoeOrder<false> S{G, bid, hiB, tot, DEXP / 2, DEXP / 2, meta, (unsigned)(DM * DEXP), false, nullptr, xm ? 1 : 0};
            EpiScaleBf16 E{ws + WS_Y2, (const float*)(ws + WS_LISTW)};
            pg8::gemm_phase<EpiScaleBf16, MoeOrder<false>, true, true>(lds, g, S, E, wid0);
            if (l + 1 < NLAYER && G == 256 && (xm ? ((bid & 7) * (G >> 3) + (bid >> 3)) : bid) >= tot - hiB)
                f8_convert<true>(a, lds, ws, l + 1, 0, 0, 1, (unsigned*)(ws + WS_CTL) + CW_TICK + 64 * (l + 1), tid, lane, wave);
        }
        SEAM(pb + 10);

        if (PHEN(12) && IN(pb + 11)) for (int rep = 0; rep < NREP(12); ++rep) { unsigned char* ws = opaque_p(a.ws); LAS unsigned char* lds = opaque_p(lds0); const int bid = opaque_s((int)blockIdx.x); const int tid = tidx(wid0), lane = tid & 63, wave = __builtin_amdgcn_readfirstlane(tid >> 6), gw = bid * NWAVES + wave; (void)lane; (void)gw;
            const bool lastl = (l == NLAYER - 1); bf16_t* XA16 = (bf16_t*)(ws + WS_XA);
            const bf16_t* X1B = (const bf16_t*)(ws + WS_X1B); const unsigned char* Y2 = ws + WS_Y2; const int* tokS = (const int*)(ws + WS_TOKS); const int* tokE = (const int*)(ws + WS_TOKE);
#if N_LAUNCH_MODE != 1
            moe_meta(a, lds, tid, l);
#endif
            volatile LAS int* meta = (volatile LAS int*)(lds + META_OFF);
            unsigned char* XB = ws + WS_XB;
            const float* lg = AIN(I_LN2G) + l * DM; const float* lb = AIN(I_LN2B) + l * DM;
            for (int row0 = gw; row0 < MTOK; row0 += 2 * NGW) {
                int sl[2][2];
#pragma unroll
                for (int rr = 0; rr < 2; ++rr) { const int row = row0 + rr * NGW; sl[rr][0] = meta[16 + tokE[row * 2]] + tokS[row * 2]; sl[rr][1] = meta[16 + tokE[row * 2 + 1]] + tokS[row * 2 + 1]; }
                u32x2 xw[2][8]; unsigned pw_[2][8], qw[2][8];
#pragma unroll
                for (int rr = 0; rr < 2; ++rr) { const int row = row0 + rr * NGW;
#pragma unroll
                    for (int j = 0; j < 8; ++j) { xw[rr][j] = __builtin_nontemporal_load((const u32x2*)(X1B + (size_t)row * DM + j * 256 + lane * 4));
                        pw_[rr][j] = __builtin_nontemporal_load((const unsigned*)(Y2 + (size_t)sl[rr][0] * DM + j * 256 + lane * 4)); qw[rr][j] = __builtin_nontemporal_load((const unsigned*)(Y2 + (size_t)sl[rr][1] * DM + j * 256 + lane * 4)); } }
#pragma unroll
                for (int rr = 0; rr < 2; ++rr) { const int row = row0 + rr * NGW;
                    f32x4 y[8]; float s = 0.f;
#pragma unroll
                    for (int j = 0; j < 8; ++j) { const u32x2 x = xw[rr][j]; const int p = (int)pw_[rr][j], q = (int)qw[rr][j];
                        const f32x2 p0 = __builtin_amdgcn_cvt_pk_f32_fp8(p, false), p1 = __builtin_amdgcn_cvt_pk_f32_fp8(p, true), q0 = __builtin_amdgcn_cvt_pk_f32_fp8(q, false), q1 = __builtin_amdgcn_cvt_pk_f32_fp8(q, true);
                        y[j][0] = bflo(x.x) * ALPHA + (p0.x + q0.x) * (1.f / Y2_SCALE); y[j][1] = bfhi(x.x) * ALPHA + (p0.y + q0.y) * (1.f / Y2_SCALE);
                        y[j][2] = bflo(x.y) * ALPHA + (p1.x + q1.x) * (1.f / Y2_SCALE); y[j][3] = bfhi(x.y) * ALPHA + (p1.y + q1.y) * (1.f / Y2_SCALE);
                        s += (y[j][0] + y[j][1]) + (y[j][2] + y[j][3]); }
                    const float mean = wave_sum(s) * (1.f / DM); float s2 = 0.f;
#pragma unroll
                    for (int j = 0; j < 8; ++j) { y[j] = y[j] - mean; s2 += (y[j][0] * y[j][0] + y[j][1] * y[j][1]) + (y[j][2] * y[j][2] + y[j][3] * y[j][3]); }
                    const float rstd = __builtin_amdgcn_rsqf(wave_sum(s2) * (1.f / DM) + LN_EPS);
#pragma unroll
                    for (int j = 0; j < 8; ++j) { const f32x4 gg = *(const f32x4*)(lg + j * 256 + lane * 4), bb = *(const f32x4*)(lb + j * 256 + lane * 4);
                        y[j] = y[j] * rstd * gg + bb;
                        if (lastl) __builtin_nontemporal_store(y[j], (f32x4*)(a.out + (size_t)row * DM + j * 256 + lane * 4));
                        else { u32x2 w; w.x = cvt_pk_bf16(y[j][0], y[j][1]); w.y = cvt_pk_bf16(y[j][2], y[j][3]); __builtin_nontemporal_store(w, (u32x2*)(XA16 + (size_t)row * DM + j * 256 + lane * 4)); }
                        if (!lastl) __builtin_nontemporal_store(cvt4_fp8(y[j][0], y[j][1], y[j][2], y[j][3]), (unsigned*)(XB + (size_t)row * DM + j * 256 + lane * 4)); }
                }
            }
            if (l + 1 < NLAYER)
                f8_convert<true>(a, lds, ws, l + 1, 0, 0, 1 << 30, (unsigned*)(ws + WS_CTL) + CW_TICK + 64 * (l + 1), tid, lane, wave);
        }
        SEAM(pb + 11);
    }
#undef IN
#undef SEAM
}

extern "C" void kernel_launch(void* const* d_in, const int* in_sizes, int n_in, void* d_out, int out_size, void* d_ws, size_t ws_size, hipStream_t stream) {
    static int grid = 0;
    if (grid == 0) {
        if (n_in != 28 || out_size != MTOK * DM || ws_size < WS_END) { fprintf(stderr, "kernel_launch: unexpected shapes (n_in %d out %d ws %zu)\n", n_in, out_size, ws_size); grid = -1; return; }
        int dev = 0, cus = 0, per_cu = 0;
        if (hipGetDevice(&dev) != hipSuccess || hipDeviceGetAttribute(&cus, hipDeviceAttributeMultiprocessorCount, dev) != hipSuccess) { grid = -1; return; }
        if (hipFuncSetAttribute((const void*)hybrid_fwd, hipFuncAttributeMaxDynamicSharedMemorySize, LDS_BYTES) != hipSuccess) { fprintf(stderr, "kernel_launch: hipFuncSetAttribute failed\n"); grid = -1; return; }
        if (hipOccupancyMaxActiveBlocksPerMultiprocessor(&per_cu, (const void*)hybrid_fwd, NTHREADS, LDS_BYTES) != hipSuccess || per_cu < 1) { fprintf(stderr, "kernel_launch: occupancy query says %d\n", per_cu); (void)hipGetLastError(); grid = -1; return; }
        grid = cus < 256 ? cus : 256;
    }
    if (grid < 0) return;
#if N_LAUNCH_MODE != 1
    (void)hipMemsetAsync((char*)d_ws + WS_CTL, 0, CTL_ZERO_BYTES, stream);
#endif
    Args a{};
    for (int i = 0; i < 28; ++i) a.in[i] = (const float*)d_in[i];
    a.out = (float*)d_out; a.ws = (unsigned char*)d_ws;
#if N_LAUNCH_MODE == 1
    a.ph_lo = 0; a.ph_hi = NPHASES;
    hipLaunchKernelGGL(hybrid_fwd, dim3(grid), dim3(NTHREADS), LDS_BYTES, stream, a);
#else
    for (int p = 0; p < NPHASES; ++p) { a.ph_lo = p; a.ph_hi = p + 1; hipLaunchKernelGGL(hybrid_fwd, dim3(grid), dim3(NTHREADS), LDS_BYTES, stream, a); }
#endif
}
```

```cpp
#include <hip/hip_runtime.h>
#include <cstdio>
#include <cstdint>

#ifndef N_LAUNCH_MODE
#define N_LAUNCH_MODE 1
#endif

#define GAS __attribute__((address_space(1)))
#define LAS __attribute__((address_space(3)))
typedef unsigned short bf16_t;
typedef short bf16x8 __attribute__((ext_vector_type(8)));
typedef short s16x4 __attribute__((ext_vector_type(4)));
typedef float f32x2 __attribute__((ext_vector_type(2)));
typedef int int4_t __attribute__((ext_vector_type(4)));
typedef float f32x4 __attribute__((ext_vector_type(4)));
typedef float f32x16 __attribute__((ext_vector_type(16)));
typedef unsigned u32x2 __attribute__((ext_vector_type(2)));
typedef unsigned u32x4 __attribute__((ext_vector_type(4)));
typedef int i32x4 __attribute__((ext_vector_type(4)));
typedef int i32x8 __attribute__((ext_vector_type(8)));

constexpr int DM = 2048, NBATCH = 4, SEQ = 2048, NLAYER = 4, MTOK = NBATCH * SEQ;
constexpr int DIN = 5120, ZK_OFF = 1024, ZV_OFF = 2048, ZC_OFF = 3072, ZRX_OFF = 4096, ZRG_OFF = 4608;
constexpr int CW = 512, RW = 512, NEXP = 16, DEXP = 1024, CK = 31;
constexpr float ALPHA = 1.6817928305074290f;
constexpr float LN_EPS = 1e-5f;
constexpr int NWAVES = 8, NTHREADS = 512;
constexpr int MOE_ROWS = 20480;
constexpr float W1_SCALE = 32.f, W2_SCALE = 64.f, H_SCALE = 4.f, WIN_SCALE = 32.f, WOUT_SCALE = 64.f, CAT_SCALE = 4.f, Y2_SCALE = 16.f;

constexpr size_t MiB = 1u << 20;
constexpr size_t WS_CTL = 0, CTL_ZERO_BYTES = 1 * MiB;
constexpr size_t WS_COS = 1 * MiB;
constexpr size_t WS_SIN = WS_COS + 512 * 1024;
constexpr size_t WS_SP8 = 2 * MiB;
constexpr size_t WS_TOKE = WS_SP8 + 64 * 1024;
constexpr size_t WS_TOKW = WS_TOKE + 64 * 1024;
constexpr size_t WS_TOKS = WS_TOKW + 64 * 1024;
constexpr size_t WS_SLOTW = WS_TOKS + 64 * 1024;
constexpr size_t WS_CNT = WS_SLOTW + 128 * 1024;
constexpr size_t WS_SUMA = 3 * MiB;
constexpr size_t WS_SUMH = WS_SUMA + 512 * 1024;
constexpr size_t WS_WIN = 8 * MiB;
constexpr size_t WS_WOUT = 88 * MiB;
constexpr size_t WS_PW = 120 * MiB;
constexpr size_t WS_WRG = 122 * MiB;
constexpr size_t WS_W1 = 128 * MiB;
constexpr size_t WS_W2 = 640 * MiB;
constexpr size_t WS_XA = 896 * MiB;
constexpr size_t WS_X1 = 960 * MiB;
constexpr size_t WS_XB = 1024 * MiB;
constexpr size_t WS_X1B = 1056 * MiB;
constexpr size_t WS_Z = 1088 * MiB;
constexpr size_t WS_OC = 1168 * MiB;
constexpr size_t WS_SCONV = 1232 * MiB;
constexpr size_t WS_XC = 1240 * MiB;
constexpr size_t WS_SA = 1248 * MiB;
constexpr size_t WS_SB = 1264 * MiB;
constexpr size_t WS_CAT = 1280 * MiB;
constexpr size_t WS_YBUF = 1312 * MiB;
constexpr size_t WS_XG = 1376 * MiB;
constexpr size_t WS_HB = 1456 * MiB;
constexpr size_t WS_Y2 = 1496 * MiB;
constexpr size_t WS_END = 1576 * MiB;
constexpr int CW_TMO = 0, CW_FLAG = 2048, CW_BAR = 4096, CW_FILL = 8192, CW_TICK = 9216; constexpr unsigned CTL_MAGIC = 0x51C0FFEEu;
constexpr int CW_TMO_ = 0;
constexpr size_t WS_LIST = 5 * MiB;
constexpr size_t WS_LISTW = 6 * MiB;
constexpr size_t WS_RWT = 7 * MiB;

constexpr int RING_BYTES = 131072;
constexpr int META_OFF = 132096;
constexpr int MISC_OFF = 132608;
constexpr int LDS_BYTES = 147456;

__device__ __forceinline__ unsigned cvt_pk_bf16(float lo, float hi) { unsigned r; asm volatile("v_cvt_pk_bf16_f32 %0, %1, %2" : "=v"(r) : "v"(lo), "v"(hi)); return r; }
__device__ __forceinline__ unsigned cvt4_fp8(float a, float b, float c, float d) {
    a = __builtin_amdgcn_fmed3f(a, -448.f, 448.f); b = __builtin_amdgcn_fmed3f(b, -448.f, 448.f); c = __builtin_amdgcn_fmed3f(c, -448.f, 448.f); d = __builtin_amdgcn_fmed3f(d, -448.f, 448.f);
    int w = 0; w = __builtin_amdgcn_cvt_pk_fp8_f32(a, b, w, false); w = __builtin_amdgcn_cvt_pk_fp8_f32(c, d, w, true); return (unsigned)w; }
__device__ __forceinline__ float bf2f(unsigned short b) { return __uint_as_float((unsigned)b << 16); }
__device__ __forceinline__ float bflo(unsigned w) { return __uint_as_float(w << 16); }
__device__ __forceinline__ float bfhi(unsigned w) { return __uint_as_float(w & 0xffff0000u); }
__device__ __forceinline__ float wave_sum(float v) {
#define WS_STEP(ctrl) v += __int_as_float(__builtin_amdgcn_update_dpp(0, __float_as_int(v), (ctrl), 0xf, 0xf, true))
    WS_STEP(0xB1); WS_STEP(0x4E); WS_STEP(0x124); WS_STEP(0x128);
#undef WS_STEP
    const auto r16 = __builtin_amdgcn_permlane16_swap(__float_as_uint(v), __float_as_uint(v), false, false);
    v = __uint_as_float(r16[0]) + __uint_as_float(r16[1]);
    const auto rr = __builtin_amdgcn_permlane32_swap(__float_as_uint(v), __float_as_uint(v), false, false);
    return __uint_as_float(rr[0]) + __uint_as_float(rr[1]);
}
__device__ __forceinline__ float sigmoidf_(float x) { return __builtin_amdgcn_rcpf(1.f + __expf(-x)); }
#define LDS_WAIT() asm volatile("s_waitcnt lgkmcnt(0)" ::: "memory")
constexpr int PTAB_OFF = 132736;
__device__ __forceinline__ const float* ldptr(LAS unsigned char* lds, int k) {
    int off = PTAB_OFF + 8 * k; asm volatile("" : "+s"(off));
    const unsigned long long v = *(volatile LAS unsigned long long*)(lds + off);
    const unsigned lo = __builtin_amdgcn_readfirstlane((unsigned)v), hi = __builtin_amdgcn_readfirstlane((unsigned)(v >> 32));
    return (const float*)(const GAS float*)(((unsigned long long)hi << 32) | lo);
}
template <class T> __device__ __forceinline__ T* opaque_p(T* p) { asm volatile("" : "+s"(p)); return p; }
__device__ __forceinline__ int tidx(int wid) { int l; asm volatile("v_mbcnt_lo_u32_b32 %0, -1, 0\n\tv_mbcnt_hi_u32_b32 %0, -1, %0" : "=v"(l)); return (wid << 6) + l; }
__device__ __forceinline__ int opaque_s(int v) { asm volatile("" : "+s"(v)); return v; }

#define XB_TMO      128
#define XB_XCNT(j)  (256  + 64 * (j))
#define XB_XSUB(j)  (1280 + 64 * (j))
#define XB_XGEN(j)  (2304 + 64 * (j))
#define XB_TOP      3328
#define XB_TOPGEN   3392
#define XCD_BAR_WORDS 3456
#define XB_SPIN_CAP (1u << 18)
__device__ __forceinline__ unsigned xb_ld(unsigned* p)              { return __hip_atomic_load(p, __ATOMIC_RELAXED, __HIP_MEMORY_SCOPE_AGENT); }
__device__ __forceinline__ unsigned xb_add(unsigned* p, unsigned v) { return __hip_atomic_fetch_add(p, v, __ATOMIC_RELAXED, __HIP_MEMORY_SCOPE_AGENT); }
__device__ __forceinline__ unsigned xb_xcc_id() { return (unsigned)__builtin_amdgcn_s_getreg((3 << 11) | 20) & 0xFu; }
#define XB_SPIN(cond, bar) do { unsigned _sp = 0; while (cond) { __builtin_amdgcn_s_sleep(1); \
    if ((++_sp & 255u) == 0u) { if (xb_ld(&(bar)[XB_TMO])) break; if (_sp > XB_SPIN_CAP) { atomicAdd(&(bar)[XB_TMO], 1u); break; } } } } while (0)
struct XcdBarrier { unsigned* bar; unsigned x; volatile LAS unsigned* st; };
__device__ __forceinline__ XcdBarrier xcd_barrier_post(unsigned* bar, volatile LAS unsigned* st) {
    XcdBarrier b; b.bar = bar; b.x = xb_xcc_id(); b.st = st;
    if (threadIdx.x == 0) (void)xb_add(&bar[XB_XCNT(b.x)], 1u);
    return b;
}
__device__ __forceinline__ void xcd_barrier_complete(unsigned* bar, unsigned x, unsigned& nloc, unsigned& nx) {
    const unsigned G = gridDim.x * gridDim.y * gridDim.z;
    asm volatile("" : "+s"(x));
    unsigned sum, cnt, mine, sp = 0u;
    for (;;) {
        sum = 0u; cnt = 0u; mine = 0u;
#pragma unroll
        for (unsigned j = 0; j < 16; ++j) { const unsigned c = xb_ld(&bar[XB_XCNT(j)]); sum += c; cnt += (c > 0u) ? 1u : 0u; mine = (j == x) ? c : mine; }
        if (sum == G) break;
        __builtin_amdgcn_s_sleep(1);
        if ((++sp & 255u) == 0u) { if (xb_ld(&bar[XB_TMO])) break; if (sp > XB_SPIN_CAP) { atomicAdd(&bar[XB_TMO], 1u); break; } }
    }
    nloc = mine > 0u ? mine : 1u; nx = cnt > 0u ? cnt : 1u;
}
__device__ __forceinline__ void xcd_barrier(const XcdBarrier& b, int wid0) {
    asm volatile("s_waitcnt vmcnt(0)" ::: "memory");
    __syncthreads();
    if (tidx(wid0) == 0) {
        unsigned* bar = opaque_p(b.bar);
        __builtin_amdgcn_s_waitcnt(0);
        unsigned nloc = b.st[0], nx = b.st[1];
        if (nloc == 0u) { xcd_barrier_complete(bar, b.x, nloc, nx); b.st[0] = nloc; b.st[1] = nx; }
        const unsigned old = xb_add(&bar[XB_XSUB(b.x)], 1u);
        const unsigned gen = old / nloc;
        if (old + 1u == (gen + 1u) * nloc) {
            __builtin_amdgcn_fence(__ATOMIC_RELEASE, "agent");
            asm volatile("s_waitcnt vmcnt(0)" ::: "memory");
            const unsigned og = xb_add(&bar[XB_TOP], 1u);
            const unsigned tg = og / nx;
            if (og + 1u == (tg + 1u) * nx) xb_add(&bar[XB_TOPGEN], 1u);
            else XB_SPIN(xb_ld(&bar[XB_TOPGEN]) == tg, bar);
            __builtin_amdgcn_fence(__ATOMIC_ACQUIRE, "agent");
            xb_add(&bar[XB_XGEN(b.x)], 1u);
            asm volatile("s_waitcnt vmcnt(0)" ::: "memory");
        } else {
            XB_SPIN(xb_ld(&bar[XB_XGEN(b.x)]) == gen, bar);
            __builtin_amdgcn_fence(__ATOMIC_ACQUIRE, "agent");
            asm volatile("s_waitcnt vmcnt(0)" ::: "memory");
        }
    }
    __syncthreads();
}

namespace pg8 {
constexpr int BM = 256, BK = 64, HALF = 128, HTB = HALF * BK * 2, STAGE_BYTES = 8 * HTB, NXCD = 8, WGM = 8;
__host__ __device__ __forceinline__ int lds_byte(int r, int c) { const int st = (r >> 4) * 2 + (c >> 5), rr = r & 15, cc = c & 31, ob = rr * 64 + cc * 2; return st * 1024 + (ob ^ (((ob >> 9) & 1) << 5)); }
__host__ __device__ __forceinline__ void stage_rc(int b, int& R, int& C) { const int st = b / 1024, sb = b % 1024, swz = sb ^ (((sb >> 9) & 1) << 5); R = (st >> 1) * 16 + swz / 64; C = (st & 1) * 32 + (swz % 64) / 2; }
__host__ __device__ __forceinline__ int perm32(int rho) { const int n = rho >> 4, i = rho & 15; return 8 * (i >> 2) + 4 * n + (i & 3); }

struct Unit { int pm, pn; unsigned aoff, boff; int pb, cnt, lb; };
struct Gemm { const unsigned char* base; unsigned A, Bt; int lda, ldb, K; };

struct GridOrder {
    int nM, nN, nwg, G, c; unsigned atile, btile;
    __device__ void init(int M, int N, int lda, int ldb, int G_, int c_) { nM = M / BM; nN = N / BM; nwg = nM * nN; G = G_; c = c_; atile = (unsigned)BM * lda * 2; btile = (unsigned)BM * ldb * 2; }
    __device__ bool next(int i, Unit& u) const {
        const long L = (long)i * G + c; if (L >= nwg) return false;
        int wgid = (int)L; { const int q = nwg / NXCD, r = nwg % NXCD, xcd = wgid % NXCD, off = wgid / NXCD; wgid = (xcd < r ? xcd * (q + 1) : r * (q + 1) + (xcd - r) * q) + off; }
        const int nig = WGM * nN, gid = wgid / nig, fm = gid * WGM, gsz = (nM - fm) < WGM ? (nM - fm) : WGM;
        u.pm = fm + ((wgid % nig) % gsz); u.pn = (wgid % nig) / gsz; u.aoff = (unsigned)u.pm * atile; u.boff = (unsigned)u.pn * btile; return true;
    }
    static constexpr bool GATHER = false;
    __device__ __forceinline__ unsigned arow(const Unit&, int) const { return 0u; }
    __device__ __forceinline__ void a_ready(const Unit&) const {}
    __device__ __forceinline__ void done(const Unit&) const {}
};

template <class Epi, class Sched, bool ALIGN_EPI, bool F8 = false, int COPY = 0>
__device__ __forceinline__ void gemm_phase(LAS unsigned char* lds, const Gemm g, const Sched& S, const Epi& E, int wid0) {
    const int tid = tidx(wid0), wid = __builtin_amdgcn_readfirstlane(tid >> 6), lane = tid & 63, wr = wid >> 2, wc = wid & 3, fr = lane & 15, fq = lane >> 4;
    const int K = g.K, nt = K / BK;
    unsigned vA0[2], vA1[2], nA0[2], nA1[2], voffB[2]; int Rr[2], Cc[2];
    const unsigned hsA_ = (unsigned)HALF * g.lda * 2;
#pragma unroll
    for (int i = 0; i < 2; ++i) { int R, C; stage_rc(tid * 16 + i * 8192, R, C); const int Rb = Epi::PERM ? ((R & ~31) + perm32(R & 31)) : R;
        Rr[i] = R; Cc[i] = C * 2; vA0[i] = (unsigned)(R * g.lda + C) * 2u; vA1[i] = vA0[i] + hsA_; voffB[i] = (unsigned)(Rb * g.ldb + C) * 2u; }
#define PG8_GATHER(d0, d1, U) do { _Pragma("unroll") for (int _i = 0; _i < 2; ++_i) { d0[_i] = S.arow(U, Rr[_i]) * (unsigned)(g.lda * 2) + (unsigned)Cc[_i]; d1[_i] = S.arow(U, Rr[_i] + HALF) * (unsigned)(g.lda * 2) + (unsigned)Cc[_i]; } } while (0)
    const unsigned kstep = (unsigned)(BK * 2);
    const unsigned hsB = (unsigned)HALF * g.ldb * 2;
    const __amdgpu_buffer_rsrc_t rs = __builtin_amdgcn_make_buffer_rsrc((void*)g.base, (short)0, 0x7fffffff, 0x00020000);
    const unsigned ldsw = (unsigned)wid * 1024u;
    const int aoff = lds_byte(wr * 64 + fr, fq * 8), boff = lds_byte(wc * 32 + fr, fq * 8);
#define PG8_SA(b, h) (((b) * 2 + (h)) * HTB)
#define PG8_SB(b, h) ((4 + (b) * 2 + (h)) * HTB)
#define PG8_STAGE(bufoff, soff, voff) do { _Pragma("unroll") for (int _i = 0; _i < 2; ++_i) \
        __builtin_amdgcn_raw_ptr_buffer_load_lds(rs, (LAS void*)(lds + (bufoff) + ldsw + _i * 8192), 16, (int)(voff)[_i], (int)(soff), 0, 0); } while (0)
#define PG8_LDA(dst, b, h) do { _Pragma("unroll") for (int m = 0; m < 4; ++m) { if constexpr (F8) { \
        dst##8[m].lo = *(const LAS i32x4*)(lds + PG8_SA(b, h) + aoff + m * 2048); dst##8[m].hi = *(const LAS i32x4*)(lds + PG8_SA(b, h) + aoff + m * 2048 + 1024); } else { \
        _Pragma("unroll") for (int k = 0; k < 2; ++k) dst[m][k] = *(const LAS bf16x8*)(lds + PG8_SA(b, h) + aoff + m * 2048 + k * 1024); } } } while (0)
#define PG8_LDB(dst, b, h) do { _Pragma("unroll") for (int n = 0; n < 2; ++n) { if constexpr (F8) { \
        dst##8[n].lo = *(const LAS i32x4*)(lds + PG8_SB(b, h) + boff + n * 2048); dst##8[n].hi = *(const LAS i32x4*)(lds + PG8_SB(b, h) + boff + n * 2048 + 1024); } else { \
        _Pragma("unroll") for (int k = 0; k < 2; ++k) dst[n][k] = *(const LAS bf16x8*)(lds + PG8_SB(b, h) + boff + n * 2048 + k * 1024); } } } while (0)
#define PG8_MMA(ai, bj, At, Bt) do { __builtin_amdgcn_s_setprio(1); _Pragma("unroll") for (int m = 0; m < 4; ++m) _Pragma("unroll") for (int n = 0; n < 2; ++n) _Pragma("unroll") for (int k = 0; k < 2; ++k) \
        acc[ai][bj][m][n] = __builtin_amdgcn_mfma_f32_16x16x32_bf16(Bt[n][k], At[m][k], acc[ai][bj][m][n], 0, 0, 0); __builtin_amdgcn_s_setprio(0); } while (0)
#define PG8_MMA8(ai, bj, At, Bt) do { __builtin_amdgcn_s_setprio(1); _Pragma("unroll") for (int m = 0; m < 4; ++m) _Pragma("unroll") for (int n = 0; n < 2; ++n) \
        asm volatile("v_mfma_f32_16x16x128_f8f6f4 %0, %1, %2, %0" : "+v"(acc[ai][bj][m][n]) : "v"(Bt##8[n]), "v"(At##8[m])); __builtin_amdgcn_s_setprio(0); } while (0)
#define PG8_MM(ai, bj, At, Bt) do { if constexpr (F8) PG8_MMA8(ai, bj, At, Bt); else PG8_MMA(ai, bj, At, Bt); } while (0)
#define PG8_WAIT_V(n) asm volatile("s_waitcnt vmcnt(" #n ")" ::: "memory")
#define PG8_WAIT_L(n) asm volatile("s_waitcnt lgkmcnt(" #n ")" ::: "memory")
#define PG8_BAR __builtin_amdgcn_s_barrier()
#define PG8_SCHED __builtin_amdgcn_sched_barrier(0)
    Unit cur, nxt; int ui = 0;
    if (!S.next(0, cur)) return;
    f32x4 acc[2][2][4][2];
#pragma unroll
    for (int a = 0; a < 2; ++a)
#pragma unroll
        for (int b = 0; b < 2; ++b)
#pragma unroll
            for (int m = 0; m < 4; ++m)
#pragma unroll
                for (int n = 0; n < 2; ++n) acc[a][b][m][n] = (f32x4){0.f, 0.f, 0.f, 0.f};
    bf16x8 At[4][2], B0[2][2], B1[2][2]; i32x8 At8[4], B08[2], B18[2];
    unsigned cA = g.A + cur.aoff, cB = g.Bt + cur.boff;
    S.a_ready(cur);
    if constexpr (Sched::GATHER) PG8_GATHER(vA0, vA1, cur);
    PG8_STAGE(PG8_SB(0, 0), cB, voffB); PG8_STAGE(PG8_SB(0, 1), cB + hsB, voffB); PG8_STAGE(PG8_SA(0, 0), cA, vA0); PG8_STAGE(PG8_SA(0, 1), cA, vA1);
    if (wr == 1) PG8_BAR;
    PG8_WAIT_V(2); PG8_BAR;
    PG8_STAGE(PG8_SB(1, 0), cB + kstep, voffB); PG8_STAGE(PG8_SA(1, 0), cA + kstep, vA0); PG8_STAGE(PG8_SB(1, 1), cB + hsB + kstep, voffB);
    PG8_WAIT_V(6); PG8_BAR;
    for (;;) {
        const bool has_next = S.next(ui + 1, nxt);
        const unsigned nA = has_next ? g.A + nxt.aoff : cA, nB = has_next ? g.Bt + nxt.boff : cB;
        if (Sched::GATHER && has_next) PG8_GATHER(nA0, nA1, nxt);
        else {
#pragma unroll
            for (int _i = 0; _i < 2; ++_i) { nA0[_i] = vA0[_i]; nA1[_i] = vA1[_i]; } }
        for (int t = 0; t < nt; t += 2) {
            const bool last = (t == nt - 2);
            const unsigned a1 = cA + (unsigned)(t + 1) * kstep;
            const unsigned a2 = last ? nA : cA + (unsigned)(t + 2) * kstep, b2 = last ? nB : cB + (unsigned)(t + 2) * kstep;
            const unsigned a3 = a2 + kstep, b3 = b2 + kstep;
            if (last && has_next) S.a_ready(nxt);
            const unsigned w0[2] = {last ? nA0[0] : vA0[0], last ? nA0[1] : vA0[1]}, w1[2] = {last ? nA1[0] : vA1[0], last ? nA1[1] : vA1[1]};
            PG8_LDB(B0, 0, 0); PG8_LDB(B1, 0, 1); PG8_SCHED; PG8_LDA(At, 0, 0); PG8_STAGE(PG8_SA(1, 1), a1, vA1);
            PG8_WAIT_V(8); PG8_WAIT_L(0); PG8_BAR; PG8_MM(0, 0, At, B0); PG8_MM(0, 1, At, B1); PG8_BAR; PG8_SCHED;
            PG8_LDA(At, 0, 1); PG8_STAGE(PG8_SB(0, 0), b2, voffB); PG8_STAGE(PG8_SB(0, 1), b2 + hsB, voffB); PG8_STAGE(PG8_SA(0, 0), a2, w0);
            PG8_WAIT_V(8); PG8_WAIT_L(0); PG8_BAR; PG8_MM(1, 0, At, B0); PG8_MM(1, 1, At, B1); PG8_BAR; PG8_SCHED;
            PG8_LDB(B0, 1, 0); PG8_LDB(B1, 1, 1); PG8_SCHED; PG8_LDA(At, 1, 0); PG8_STAGE(PG8_SA(0, 1), a2, w1);
            PG8_WAIT_V(8); PG8_WAIT_L(0); PG8_BAR; PG8_MM(0, 0, At, B0); PG8_MM(0, 1, At, B1); PG8_BAR; PG8_SCHED;
            PG8_LDA(At, 1, 1); PG8_STAGE(PG8_SB(1, 0), b3, voffB); PG8_STAGE(PG8_SB(1, 1), b3 + hsB, voffB); PG8_STAGE(PG8_SA(1, 0), a3, w0);
            PG8_WAIT_V(8); PG8_WAIT_L(0); PG8_BAR; PG8_MM(1, 0, At, B0); PG8_MM(1, 1, At, B1); PG8_BAR; PG8_SCHED;
        }
        if constexpr (ALIGN_EPI) { if (wr == 0) PG8_BAR; }
        if constexpr (F8) asm volatile("s_nop 15\n\ts_nop 15" ::: "memory");
        E(acc, cur, wr, wc, fr, fq); S.done(cur);
        if (!has_next) break;
#pragma unroll
        for (int a = 0; a < 2; ++a)
#pragma unroll
            for (int b = 0; b < 2; ++b)
#pragma unroll
                for (int m = 0; m < 4; ++m)
#pragma unroll
                    for (int n = 0; n < 2; ++n) acc[a][b][m][n] = (f32x4){0.f, 0.f, 0.f, 0.f};
        cur = nxt; cA = nA; cB = nB; ++ui;
#pragma unroll
        for (int _i = 0; _i < 2; ++_i) { vA0[_i] = nA0[_i]; vA1[_i] = nA1[_i]; }
        if constexpr (ALIGN_EPI) { if (wr == 1) PG8_BAR; }
    }
    PG8_WAIT_V(0);
    if constexpr (!ALIGN_EPI) { if (wr == 0) PG8_BAR; }
    PG8_BAR;
#undef PG8_SA
#undef PG8_SB
#undef PG8_STAGE
#undef PG8_GATHER
#undef PG8_LDA
#undef PG8_LDB
#undef PG8_MMA
#undef PG8_MMA8
#undef PG8_MM
#undef PG8_WAIT_V
#undef PG8_WAIT_L
#undef PG8_BAR
#undef PG8_SCHED
}
}

typedef const f32x4 (&AccRef)[2][2][4][2];

struct EpiZ {
    static constexpr bool PERM = true;
    bf16_t* Z; const float* cosT; const float* sinT;
    __device__ __forceinline__ void operator()(AccRef acc, const pg8::Unit& u, int wr, int wc, int fr, int fq) const {
        asm volatile("" : "+v"(fr), "+v"(fq));
        const int row0 = u.pm * 256 + wr * 64 + fr, col0 = u.pn * 256 + wc * 32 + 8 * fq;
        const bool rope = u.pn < 8;
#pragma unroll
        for (int ai = 0; ai < 2; ++ai)
#pragma unroll
            for (int m = 0; m < 4; ++m) {
                const int row = row0 + ai * 128 + m * 16, pos = row & (SEQ - 1);
                f32x4 cs = {1.f, 1.f, 1.f, 1.f}, sn = {0.f, 0.f, 0.f, 0.f};
                if (rope) { cs = *(const f32x4*)(cosT + pos * 64 + 16 * wc + 4 * fq); sn = *(const f32x4*)(sinT + pos * 64 + 16 * wc + 4 * fq); }
                bf16_t* rowp = Z + (size_t)row * DIN + col0;
#pragma unroll
                for (int bj = 0; bj < 2; ++bj) {
                    const f32x4 v0 = acc[ai][bj][m][0] * (1.f / WIN_SCALE), v1 = acc[ai][bj][m][1] * (1.f / WIN_SCALE);
                    u32x4 w;
                    w.x = cvt_pk_bf16(v0[0] * cs[0] - v0[1] * sn[0], v0[1] * cs[0] + v0[0] * sn[0]);
                    w.y = cvt_pk_bf16(v0[2] * cs[1] - v0[3] * sn[1], v0[3] * cs[1] + v0[2] * sn[1]);
                    w.z = cvt_pk_bf16(v1[0] * cs[2] - v1[1] * sn[2], v1[1] * cs[2] + v1[0] * sn[2]);
                    w.w = cvt_pk_bf16(v1[2] * cs[3] - v1[3] * sn[3], v1[3] * cs[3] + v1[2] * sn[3]);
                    *(u32x4*)(rowp + bj * 128) = w;
                }
            }
    }
};
struct EpiBf16Off {
    static constexpr bool PERM = true;
    unsigned char* O; int ldc, coloff;
    __device__ __forceinline__ void operator()(AccRef acc, const pg8::Unit& u, int wr, int wc, int fr, int fq) const {
        const int row0 = u.pm * 256 + wr * 64 + fr, col0 = coloff + u.pn * 256 + wc * 32 + 8 * fq;
#pragma unroll
        for (int ai = 0; ai < 2; ++ai)
#pragma unroll
            for (int m = 0; m < 4; ++m) { unsigned char* rowp = O + (size_t)(row0 + ai * 128 + m * 16) * ldc + col0;
#pragma unroll
                for (int bj = 0; bj < 2; ++bj) { const f32x4 v0 = acc[ai][bj][m][0] * CAT_SCALE, v1 = acc[ai][bj][m][1] * CAT_SCALE;
                    u32x2 w; w.x = cvt4_fp8(v0[0], v0[1], v0[2], v0[3]); w.y = cvt4_fp8(v1[0], v1[1], v1[2], v1[3]);
                    *(u32x2*)(rowp + bj * 128) = w; } }
    }
};
struct EpiResBf16 {
    static constexpr bool PERM = true;
    bf16_t* C; const bf16_t* res;
    __device__ __forceinline__ void operator()(AccRef acc, const pg8::Unit& u, int wr, int wc, int fr, int fq) const {
        const int row0 = u.pm * 256 + wr * 64 + fr, col0 = u.pn * 256 + wc * 32 + 8 * fq;
#pragma unroll
        for (int ai = 0; ai < 2; ++ai)
#pragma unroll
            for (int m = 0; m < 4; ++m) { const size_t ro = (size_t)(row0 + ai * 128 + m * 16) * DM + col0;
#pragma unroll
                for (int bj = 0; bj < 2; ++bj) { const u32x4 r = *(const u32x4*)(res + ro + bj * 128);
                    const f32x4 v0 = acc[ai][bj][m][0] * (1.f / (CAT_SCALE * WOUT_SCALE)), v1 = acc[ai][bj][m][1] * (1.f / (CAT_SCALE * WOUT_SCALE));
                    u32x4 w;
                    w.x = cvt_pk_bf16(v0[0] + ALPHA * bflo(r.x), v0[1] + ALPHA * bfhi(r.x)); w.y = cvt_pk_bf16(v0[2] + ALPHA * bflo(r.y), v0[3] + ALPHA * bfhi(r.y));
                    w.z = cvt_pk_bf16(v1[0] + ALPHA * bflo(r.z), v1[1] + ALPHA * bfhi(r.z)); w.w = cvt_pk_bf16(v1[2] + ALPHA * bflo(r.w), v1[3] + ALPHA * bfhi(r.w));
                    *(u32x4*)(C + ro + bj * 128) = w; } }
    }
};
__device__ __forceinline__ float dpp_shr(float v, float oldv, int d) {
    const int o = __float_as_int(oldv), x = __float_as_int(v);
    return __int_as_float(d == 1 ? __builtin_amdgcn_update_dpp(o, x, 0x111, 0xf, 0xf, false) : d == 2 ? __builtin_amdgcn_update_dpp(o, x, 0x112, 0xf, 0xf, false)
                        : d == 4 ? __builtin_amdgcn_update_dpp(o, x, 0x114, 0xf, 0xf, false) : __builtin_amdgcn_update_dpp(o, x, 0x118, 0xf, 0xf, false));
}
struct EpiGate {
    static constexpr bool PERM = false;
    float* SA; float* SB; const bf16_t* XC; const float* ba; const float* bx; const float* sp8; float* sumA; float* sumH;
    __device__ __forceinline__ void operator()(AccRef acc, const pg8::Unit& u, int wr, int wc, int fr, int fq) const {
        const int row0 = u.pm * 256 + wr * 64 + fr, ch0 = u.pn * 128 + wc * 32 + 4 * fq;
        const int l15 = (fq * 16 + 15) * 4;
#pragma unroll
        for (int n = 0; n < 2; ++n) {
            const int ch = ch0 + 16 * n;
            const f32x4 vba = *(const f32x4*)(ba + ch), vbx = *(const f32x4*)(bx + ch), vsp = *(const f32x4*)(sp8 + ch);
#pragma unroll
            for (int ai = 0; ai < 2; ++ai)
#pragma unroll
                for (int mp = 0; mp < 2; ++mp) {
                    float A[8], B[8];
#pragma unroll
                    for (int sg = 0; sg < 2; ++sg) { const int m = 2 * mp + sg;
                        const size_t ro = (size_t)(row0 + ai * 128 + m * 16) * RW + ch;
                        const u32x2 xw = *(const u32x2*)(XC + ro);
                        const float xc[4] = {bflo(xw.x), bfhi(xw.x), bflo(xw.y), bfhi(xw.y)};
                        const f32x4 ar = acc[ai][0][m][n], ain = acc[ai][1][m][n];
#pragma unroll
                        for (int q = 0; q < 4; ++q) {
                            const float r = sigmoidf_(ar[q] + vba[q]), ig = sigmoidf_(ain[q] + vbx[q]);
                            const float la = -r * vsp[q];
                            const float a = __expf(la);
                            A[sg * 4 + q] = a; B[sg * 4 + q] = __builtin_amdgcn_sqrtf((1.f - a) * (1.f + a)) * (ig * xc[q]);
                        }
                    }
#define GS_F(i, j, D) "v_fmac_f32_dpp %" #j ", %" #j ", %" #i " row_shr:" #D " row_mask:0xf bank_mask:0xf\n\t"
#define GS_M(i, D) "v_mul_f32_dpp %" #i ", %" #i ", %" #i " row_shr:" #D " row_mask:0xf bank_mask:0xf\n\t"
#define GATE_SCAN_STEP(D) asm volatile("s_nop 1\n\t" GS_F(0, 8, D) GS_F(1, 9, D) GS_F(2, 10, D) GS_F(3, 11, D) GS_F(4, 12, D) GS_F(5, 13, D) GS_F(6, 14, D) GS_F(7, 15, D) \
                        GS_M(0, D) GS_M(1, D) GS_M(2, D) GS_M(3, D) GS_M(4, D) GS_M(5, D) GS_M(6, D) GS_M(7, D) \
                        : "+v"(A[0]), "+v"(A[1]), "+v"(A[2]), "+v"(A[3]), "+v"(A[4]), "+v"(A[5]), "+v"(A[6]), "+v"(A[7]), \
                          "+v"(B[0]), "+v"(B[1]), "+v"(B[2]), "+v"(B[3]), "+v"(B[4]), "+v"(B[5]), "+v"(B[6]), "+v"(B[7]))
                    GATE_SCAN_STEP(1); GATE_SCAN_STEP(2); GATE_SCAN_STEP(4); GATE_SCAN_STEP(8);
#undef GATE_SCAN_STEP
#undef GS_M
#undef GS_F
#pragma unroll
                    for (int q = 0; q < 4; ++q) {
                        const float A1 = __int_as_float(__builtin_amdgcn_ds_bpermute(l15, __float_as_int(A[q]))), H1 = __int_as_float(__builtin_amdgcn_ds_bpermute(l15, __float_as_int(B[q])));
                        B[4 + q] = fmaf(A[4 + q], H1, B[4 + q]); A[4 + q] *= A1; }
#pragma unroll
                    for (int sg = 0; sg < 2; ++sg) { const size_t ro = (size_t)(row0 + ai * 128 + (2 * mp + sg) * 16) * RW + ch;
                        *(f32x4*)(SA + ro) = (f32x4){A[sg * 4], A[sg * 4 + 1], A[sg * 4 + 2], A[sg * 4 + 3]}; *(f32x4*)(SB + ro) = (f32x4){B[sg * 4], B[sg * 4 + 1], B[sg * 4 + 2], B[sg * 4 + 3]}; }
                    if (fr == 15) { const size_t so = (size_t)(u.pm * 8 + ai * 4 + wr * 2 + mp) * RW + ch;
                        *(f32x4*)(sumA + so) = (f32x4){A[4], A[5], A[6], A[7]}; *(f32x4*)(sumH + so) = (f32x4){B[4], B[5], B[6], B[7]}; }
                    asm volatile("" ::: "memory");
                }
        }
    }
};
struct EpiSwiGLU {
    static constexpr bool PERM = true;
    unsigned char* H;
    __device__ __forceinline__ void operator()(AccRef acc, const pg8::Unit& u, int wr, int wc, int fr, int fq) const {
        const int row0 = u.pm * 256 + wr * 64 + fr, j0 = (u.pn * 256 + wc * 32 + 8 * fq) >> 1;
        constexpr float ds = 1.f / W1_SCALE;
#pragma unroll
        for (int ai = 0; ai < 2; ++ai)
#pragma unroll
            for (int m = 0; m < 4; ++m) { unsigned char* rowp = H + (size_t)(row0 + ai * 128 + m * 16) * DEXP + j0;
#pragma unroll
                for (int bj = 0; bj < 2; ++bj) { const f32x4 v0 = acc[ai][bj][m][0] * ds, v1 = acc[ai][bj][m][1] * ds;
                    const float h0 = v0[0] * sigmoidf_(v0[0]) * v0[1], h1 = v0[2] * sigmoidf_(v0[2]) * v0[3];
                    const float h2 = v1[0] * sigmoidf_(v1[0]) * v1[1], h3 = v1[2] * sigmoidf_(v1[2]) * v1[3];
                    *(unsigned*)(rowp + bj * 64) = cvt4_fp8(h0 * H_SCALE, h1 * H_SCALE, h2 * H_SCALE, h3 * H_SCALE); } }
    }
};
struct EpiScaleBf16 {
    static constexpr bool PERM = true;
    unsigned char* O; const float* sw;
    __device__ __forceinline__ void operator()(AccRef acc, const pg8::Unit& u, int wr, int wc, int fr, int fq) const {
        const int row0 = u.pm * 256 + wr * 64 + fr, col0 = u.pn * 256 + wc * 32 + 8 * fq;
#pragma unroll
        for (int ai = 0; ai < 2; ++ai)
#pragma unroll
            for (int m = 0; m < 4; ++m) { const int row = row0 + ai * 128 + m * 16; const float s = sw[u.lb + u.pb - u.pm * 256 + row] * (Y2_SCALE / (H_SCALE * W2_SCALE)); unsigned char* rowp = O + (size_t)row * DM + col0;
#pragma unroll
                for (int bj = 0; bj < 2; ++bj) { const f32x4 v0 = acc[ai][bj][m][0] * s, v1 = acc[ai][bj][m][1] * s;
                    u32x2 w; w.x = cvt4_fp8(v0[0], v0[1], v0[2], v0[3]); w.y = cvt4_fp8(v1[0], v1[1], v1[2], v1[3]);
                    *(u32x2*)(rowp + bj * 128) = w; } }
    }
};
struct RgOrder {
    static constexpr bool GATHER = false;
    __device__ __forceinline__ unsigned arow(const pg8::Unit&, int) const { return 0u; }
    int G, c;
    __device__ bool next(int i, pg8::Unit& u) const {
        const int L = i * G + c; if (L >= 128) return false;
        u.pm = L >> 2; u.pn = L & 3; u.aoff = ((unsigned)u.pm * 256 * RW + (unsigned)u.pn * 128) * 2; u.boff = (unsigned)u.pn * 256 * 128 * 2; return true;
    }
    __device__ __forceinline__ void a_ready(const pg8::Unit&) const {}
    __device__ __forceinline__ void done(const pg8::Unit&) const {}
};
template <bool GATHER_>
struct MoeOrder {
    static constexpr bool GATHER = GATHER_;
    int Gp, c, lo, hi, lda, ldb; const volatile LAS int* meta; unsigned estride; bool xcdmap; const int* list; int xr = 0;
    __device__ bool next(int i, pg8::Unit& u) const {
        int L = lo + i * Gp + c;
        if (xr > 0) { if (i >= xr) return false; const int n = Gp >> 3; L = lo + ((c & 7) * xr + i) * n + (c >> 3); }
        if (c < 0 || L >= hi) return false;
        if (xcdmap) {
            const int x = c & 7, r = c >> 3; L = (((i * 8 + x) * 4 + (r >> 3)) << 3) | (r & 7); }
        u.pm = L >> 3; u.pn = L & 7; const int e = __builtin_amdgcn_readfirstlane(meta[48 + u.pm]);
        u.cnt = __builtin_amdgcn_readfirstlane(meta[e]); u.pb = u.pm * 256 - __builtin_amdgcn_readfirstlane(meta[16 + e]); u.lb = e * MTOK;
        u.aoff = GATHER_ ? 0u : (unsigned)u.pm * 256 * lda * 2; u.boff = (unsigned)e * estride + (unsigned)u.pn * 256 * ldb * 2; return true;
    }
    __device__ __forceinline__ unsigned arow(const pg8::Unit& u, int r) const { const int p = u.pb + r; return (p < u.cnt) ? (unsigned)list[u.lb + p] : 0u; }
    __device__ __forceinline__ void a_ready(const pg8::Unit&) const {}
    __device__ __forceinline__ void done(const pg8::Unit&) const {}
};

namespace att {
constexpr int D = 128, PQ = DIN, PO = 1024;
constexpr float SCALE = 0.08838834764831845f;
constexpr float THR = 8.f;
constexpr int NW = 8, QBLK = 32, KVBLK = 64, QB = NW * QBLK;
constexpr int SHM_V = KVBLK * D * 2, SHM_K = KVBLK * D * 2;
constexpr int LDS_ATT = 2 * SHM_V + 2 * SHM_K + NW * 64 * 4;
#define KSWZ(row, colB) ((row) * 256 + ((colB) ^ (((row) & 7) << 4)))
#define SBAR() __builtin_amdgcn_sched_barrier(0)
__device__ __forceinline__ int v_st(int k, int c) { const int kk = (k & ~0xC) | ((k & 4) << 1) | ((k & 8) >> 1); return ((kk >> 3) * 4 + (c >> 5)) * 512 + ((kk & 7) * 32 + (c & 31)) * 2; }
__device__ __forceinline__ int v_rd_base(int lane) { return ((lane & 3) << 3) | (((lane >> 2) & 3) << 6) | (((lane >> 4) & 1) << 5) | (((lane >> 5) & 1) << 8); }
constexpr int v_rd_off(int d0, int ks, int half) { return d0 * 512 + ks * 4096 + half * 2048; }
__device__ __forceinline__ int crow(int r, int hi) { return (r & 3) + 8 * (r >> 2) + 4 * hi; }
__device__ __forceinline__ unsigned cvtpk(float lo, float hi) { unsigned r; asm volatile("v_cvt_pk_bf16_f32 %0, %1, %2" : "=v"(r) : "v"(lo), "v"(hi)); return r; }
__device__ __forceinline__ bf16x8 load8(const bf16_t* p) { return *reinterpret_cast<const bf16x8*>(p); }
__device__ __forceinline__ void mask_tile(f32x16& p0, f32x16& p1, int dq, unsigned W) {
    const float NEG = -__builtin_inff();
#pragma unroll
    for (int r = 0; r < 16; ++r) {
        const int c = (r & 3) + 8 * (r >> 2);
        if ((unsigned)(dq - c) >= W) p0[r] = NEG;
        if ((unsigned)(dq - c - 32) >= W) p1[r] = NEG;
    }
}
__device__ __forceinline__ void partialSM(f32x16& p0, f32x16& p1, float& m_reg, float& mn, float& alpha) {
    float pmax = p0[0]; for (int r = 1; r < 16; ++r) pmax = fmaxf(pmax, p0[r]); for (int r = 0; r < 16; ++r) pmax = fmaxf(pmax, p1[r]);
    { auto rr = __builtin_amdgcn_permlane32_swap(__float_as_uint(pmax), __float_as_uint(pmax), false, false);
      pmax = fmaxf(__uint_as_float(rr[0]), __uint_as_float(rr[1])); }
    constexpr float C2 = 1.4426950408889634f * SCALE;
    if (__builtin_expect(__all((pmax - m_reg) * SCALE <= THR), 1)) { mn = m_reg; alpha = 1.f; }
    else { mn = fmaxf(m_reg, pmax); alpha = __builtin_amdgcn_exp2f((m_reg - mn) * C2); m_reg = mn; }
    const float mnL = -mn * C2;
    for (int r = 0; r < 16; ++r) p0[r] = fmaf(p0[r], C2, mnL); for (int r = 0; r < 16; ++r) p1[r] = fmaf(p1[r], C2, mnL);
    for (int r = 0; r < 16; ++r) p0[r] = __builtin_amdgcn_exp2f(p0[r]);
}
__device__ __forceinline__ void finishSM(f32x16& p0, f32x16& p1, float alpha, float& l_reg, bf16x8& pa0, bf16x8& pa1, bf16x8& pa2, bf16x8& pa3) {
    for (int r = 0; r < 16; ++r) p1[r] = __builtin_amdgcn_exp2f(p1[r]);
    float ps = 0; for (int r = 0; r < 16; ++r) ps += p0[r]; for (int r = 0; r < 16; ++r) ps += p1[r];
    { auto rr = __builtin_amdgcn_permlane32_swap(__float_as_uint(ps), __float_as_uint(ps), false, false);
      ps = __uint_as_float(rr[0]) + __uint_as_float(rr[1]); }
    l_reg = l_reg * alpha + ps;
#define PK4(P, B_, OUT) do { unsigned a0 = cvtpk(P[B_+0], P[B_+1]), a1 = cvtpk(P[B_+2], P[B_+3]);                          \
        unsigned b0 = cvtpk(P[B_+4], P[B_+5]), b1 = cvtpk(P[B_+6], P[B_+7]);                                             \
        auto r0 = __builtin_amdgcn_permlane32_swap(a0, b0, false, false); auto r1 = __builtin_amdgcn_permlane32_swap(a1, b1, false, false); \
        u32x4 w = {r0[0], r1[0], r0[1], r1[1]}; OUT = *reinterpret_cast<bf16x8*>(&w); } while (0)
    PK4(p0, 0, pa0); PK4(p0, 8, pa1); PK4(p1, 0, pa2); PK4(p1, 8, pa3);
#undef PK4
}
template <int KB>
__device__ __forceinline__ void qkt(f32x16& p0, f32x16& p1, const char* K_lds, int r32, int hi, const bf16x8* qr) {
    p0 = f32x16{}; p1 = f32x16{};
    const char* kb[4];
#pragma unroll
    for (int dd = 0; dd < 4; ++dd) kb[dd] = K_lds + KB * SHM_K + KSWZ(r32, (dd * 16 + hi * 8) * 2);
#pragma unroll
    for (int d0 = 0; d0 < 8; ++d0) { const char* a = kb[d0 & 3] + (d0 >> 2) * 128;
        bf16x8 b0 = *reinterpret_cast<const bf16x8*>(a);
        bf16x8 b1 = *reinterpret_cast<const bf16x8*>(a + 32 * 256);
        p0 = __builtin_amdgcn_mfma_f32_32x32x16_bf16(b0, qr[d0], p0, 0, 0, 0);
        p1 = __builtin_amdgcn_mfma_f32_32x32x16_bf16(b1, qr[d0], p1, 0, 0, 0); }
}
template <int VB>
__device__ __forceinline__ void pv_tile(f32x16* o, int vb0, bf16x8 pa0, bf16x8 pa1, bf16x8 pa2, bf16x8 pa3) {
#define TRRD(dst, off) asm volatile("ds_read_b64_tr_b16 %0, %1 offset:%2" : "=&v"(dst) : "v"(vb0), "i"(off) : "memory")
#define PV_D0(d0) do { s16x4 l0, l1, l2, l3, h0, h1, h2, h3; constexpr int b_ = VB * SHM_V + v_rd_off(d0, 0, 0); \
        TRRD(l0, b_); TRRD(h0, b_ + 2048); TRRD(l1, b_ + 4096); TRRD(h1, b_ + 6144); TRRD(l2, b_ + 8192); TRRD(h2, b_ + 10240); TRRD(l3, b_ + 12288); TRRD(h3, b_ + 14336); \
        asm volatile("s_waitcnt lgkmcnt(0)" ::: "memory"); SBAR();   \
        o[d0] = __builtin_amdgcn_mfma_f32_32x32x16_bf16(pa0, (bf16x8){l0[0], l0[1], l0[2], l0[3], h0[0], h0[1], h0[2], h0[3]}, o[d0], 0, 0, 0);   \
        o[d0] = __builtin_amdgcn_mfma_f32_32x32x16_bf16(pa1, (bf16x8){l1[0], l1[1], l1[2], l1[3], h1[0], h1[1], h1[2], h1[3]}, o[d0], 0, 0, 0);   \
        o[d0] = __builtin_amdgcn_mfma_f32_32x32x16_bf16(pa2, (bf16x8){l2[0], l2[1], l2[2], l2[3], h2[0], h2[1], h2[2], h2[3]}, o[d0], 0, 0, 0);   \
        o[d0] = __builtin_amdgcn_mfma_f32_32x32x16_bf16(pa3, (bf16x8){l3[0], l3[1], l3[2], l3[3], h3[0], h3[1], h3[2], h3[3]}, o[d0], 0, 0, 0); } while (0)
    PV_D0(0); PV_D0(1); PV_D0(2); PV_D0(3);
#undef PV_D0
#undef TRRD
}
struct BlockRef { const bf16_t* Q; const bf16_t* K; const bf16_t* V; bf16_t* O; int P0; };
struct Seam { bf16x8 qr[8]; bf16x8 st_v0, st_v1, st_k0, st_k1; };
#define ROW(p, k0, rr) ((p) + (size_t)((k0) + (rr)) * PQ + sc)
#define VMW() asm volatile("s_waitcnt vmcnt(0)" ::: "memory")
#define VMWN(n) asm volatile("s_waitcnt vmcnt(%0)" :: "i"(n) : "memory")
#define SLOAD_H(Kp, Vp, k0) do { S.st_v0 = load8(ROW(Vp, k0, sr)); S.st_v1 = load8(ROW(Vp, k0, 32 + sr));              \
                         S.st_k0 = load8(ROW(Kp, k0, sr)); S.st_k1 = load8(ROW(Kp, k0, 32 + sr)); } while (0)
#define SWRITE_HK(bf) do { *(bf16x8*)(K_lds + (bf) * SHM_K + kws) = S.st_k0; *(bf16x8*)(K_lds + (bf) * SHM_K + kws + 32 * 256) = S.st_k1; } while (0)
#define SWRITE_HV(bf) do { *(bf16x8*)(V_lds + (bf) * SHM_V + vst0) = S.st_v0; *(bf16x8*)(V_lds + (bf) * SHM_V + vst1) = S.st_v1; } while (0)
#define SWRITE_H(bf) do { SWRITE_HV(bf); SWRITE_HK(bf); } while (0)
__device__ __forceinline__ void causal_prime(const BlockRef& cur, char* lds, Seam& S, int wid0) {
    const int tid = tidx(wid0), wid = __builtin_amdgcn_readfirstlane(tid >> 6), lane = tid & 63, r32 = lane & 31, hi = lane >> 5;
    const int sr = tid >> 4, sc = (tid & 15) * 8, kws = KSWZ(sr, sc * 2); char* K_lds = lds + 2 * SHM_V;
    const int kb0 = 0;
    for (int d0 = 0; d0 < 8; ++d0) S.qr[d0] = load8(cur.Q + (size_t)(wid * QBLK + r32) * PQ + d0 * 16 + hi * 8);
    SLOAD_H(cur.K, cur.V, kb0); VMW(); SWRITE_HK(0);
    __syncthreads();
}
__device__ __forceinline__ void causal_block(const BlockRef& cur, const BlockRef& nxt, char* lds, Seam& S, int wid0) {
    const int tid = tidx(wid0), wid = __builtin_amdgcn_readfirstlane(tid >> 6), lane = tid & 63, r32 = lane & 31, hi = lane >> 5;
    const int W = 1 << 30;
    const int j_lo = 0;
    const int j_hi = (cur.P0 + QB - 1) / KVBLK + 1;
    const int NT = j_hi - j_lo;
    const int kbn = 0;
    const int qlo = cur.P0 + wid * QBLK, qm = qlo + r32 - 4 * hi;
    char* V_lds = lds; char* K_lds = lds + 2 * SHM_V;
    float* ws = (float*)(lds + 2 * SHM_V + 2 * SHM_K) + wid * 64; float* li_l = ws, * al_l = ws + 32;
    float m_reg = -1e30f, l_reg = 0; f32x16 o[4] = {};
    const int sr = tid >> 4, sc = (tid & 15) * 8, vst0 = v_st(sr, sc), vst1 = v_st(32 + sr, sc), kws = KSWZ(sr, sc * 2);
    const int vb0 = (int)(uintptr_t)V_lds + v_rd_base(lane);
    const bf16_t* Kh = cur.K; const bf16_t* Vh = cur.V;
#define RESC(a) do { if (__any((a) < 1.f)) { if (hi == 0) al_l[r32] = (a); asm volatile("s_waitcnt lgkmcnt(0)" ::: "memory");              \
                     for (int d_ = 0; d_ < 4; ++d_) for (int r = 0; r < 16; ++r) o[d_][r] *= al_l[crow(r, hi)]; } } while (0)
#define KBASE(t) ((j_lo + (t)) * KVBLK)
#define MASKT(P0_, P1_, t) do { const int kb_ = KBASE(t); if (kb_ + KVBLK - 1 > qlo) mask_tile(P0_, P1_, qm - kb_, (unsigned)W); } while (0)
    constexpr int NQL = 8;
#define SEAM_K0() do { VMWN(NQL); SWRITE_HK(0); SBAR(); } while (0)
    f32x16 pA0, pA1, pB0, pB1; float mnA, mnB, alA, alB; bf16x8 pa0, pa1, pa2, pa3;
    SWRITE_HV(0); SBAR();
    if (NT > 1) { SLOAD_H(Kh, Vh, KBASE(1)); }
    SBAR(); qkt<0>(pA0, pA1, K_lds, r32, hi, S.qr);
    MASKT(pA0, pA1, 0); partialSM(pA0, pA1, m_reg, mnA, alA);
    if (NT > 1) { VMW(); SWRITE_H(1); }
    __syncthreads();
#define HALF_STEP(PX0, PX1, mnX, alX, PY0, PY1, alY, t, KB, VB, SB) do {                                                      \
        SBAR(); qkt<KB>(PX0, PX1, K_lds, r32, hi, S.qr);                                                         \
        finishSM(PY0, PY1, alY, l_reg, pa0, pa1, pa2, pa3); SBAR();                                                           \
        if ((t) + 1 < NT) { SLOAD_H(Kh, Vh, KBASE((t) + 1)); SBAR(); }                                                        \
        pv_tile<VB>(o, vb0, pa0, pa1, pa2, pa3); MASKT(PX0, PX1, (t)); partialSM(PX0, PX1, m_reg, mnX, alX);                  \
        __syncthreads();                                                                                                      \
        if ((t) + 1 < NT) { VMW(); SWRITE_H(SB); }                                                                            \
        RESC(alX); __syncthreads(); } while (0)
    for (int t = 1; t + 1 < NT; t += 2) {
        HALF_STEP(pB0, pB1, mnB, alB, pA0, pA1, alA, t, 1, 0, 0);
        HALF_STEP(pA0, pA1, mnA, alA, pB0, pB1, alB, t + 1, 0, 1, 1);
    }
    const bool even = (NT & 1) == 0;
    if (even) { SBAR(); qkt<1>(pB0, pB1, K_lds, r32, hi, S.qr); SBAR(); }
    SLOAD_H(nxt.K, nxt.V, kbn); SBAR();
#pragma unroll
    for (int d0 = 0; d0 < 8; ++d0) S.qr[d0] = load8(nxt.Q + (size_t)(wid * QBLK + r32) * PQ + d0 * 16 + hi * 8);
    SBAR();
    finishSM(pA0, pA1, alA, l_reg, pa0, pa1, pa2, pa3); SBAR();
    pv_tile<0>(o, vb0, pa0, pa1, pa2, pa3);
    if (even) { MASKT(pB0, pB1, NT - 1); partialSM(pB0, pB1, m_reg, mnB, alB); __syncthreads(); RESC(alB);
        finishSM(pB0, pB1, alB, l_reg, pa0, pa1, pa2, pa3); SBAR(); pv_tile<1>(o, vb0, pa0, pa1, pa2, pa3); }
    SBAR(); SEAM_K0();
    if (hi == 0) li_l[r32] = l_reg; asm volatile("s_waitcnt lgkmcnt(0)" ::: "memory");
    float rli[16];
#pragma unroll
    for (int r = 0; r < 16; ++r) rli[r] = __builtin_amdgcn_rcpf(li_l[crow(r, hi)]);
    bf16_t* Ow = cur.O + (size_t)(wid * QBLK) * PO;
#pragma unroll
    for (int r = 0; r < 16; ++r) { const int orow = crow(r, hi);
#pragma unroll
        for (int d0 = 0; d0 < 4; ++d0) { const float v = o[d0][r] * rli[r];
            const float vn = __int_as_float(__builtin_amdgcn_mov_dpp(__float_as_int(v), 0xB1, 0xf, 0xf, true));
            if ((r32 & 1) == 0) *(unsigned*)(Ow + (size_t)orow * PO + d0 * 32 + r32) = cvtpk(v, vn); } }
    __syncthreads();
#undef RESC
#undef KBASE
#undef MASKT
#undef SEAM_K0
#undef HALF_STEP
}
#undef ROW
#undef VMW
#undef VMWN
#undef SLOAD_H
#undef SWRITE_HK
#undef SWRITE_HV
#undef SWRITE_H
__device__ __forceinline__ BlockRef make_ref(int L, int pass, const bf16_t* Z, bf16_t* OC) {
    const int bh = L >> 2, x = L & 3, b = bh >> 4, vh = bh & 15, h = vh >> 2, c = (vh >> 1) & 1, vhalf = vh & 1;
    const int qb = pass ? 7 - x : x;
    const size_t row0 = (size_t)b * SEQ;
    BlockRef r;
    r.Q = Z + (row0 + (size_t)qb * QB) * PQ + h * 256 + c * 128;
    r.K = Z + row0 * PQ + ZK_OFF + h * 256 + c * 128;
    r.V = Z + row0 * PQ + ZV_OFF + h * 256 + vhalf * 128;
    r.O = OC + (size_t)c * MTOK * PO + (row0 + (size_t)qb * QB) * PO + h * 256 + vhalf * 128;
    r.P0 = qb * QB;
    return r;
}
__device__ __forceinline__ void attn_phase(char* lds, const bf16_t* Z, bf16_t* OC, int G, int c0, int wid0) {
    constexpr int total = 256;
    int L = c0; if (L >= total) return;
    int pass = 0;
    BlockRef cur = make_ref(L, 0, Z, OC);
    Seam S;
    causal_prime(cur, lds, S, wid0);
    for (;;) {
        const bool more_pass = pass == 0, more_item = L + G < total, last = !more_pass && !more_item;
        int passn = pass + 1, Ln = L;
        if (!more_pass) { passn = 0; Ln = more_item ? L + G : L; }
        const BlockRef nxt = last ? cur : make_ref(Ln, passn, Z, OC);
        causal_block(cur, nxt, lds, S, wid0);
        if (last) break;
        cur = nxt; pass = passn; L = Ln;
    }
}
}

#define AIN(k) ldptr(lds, (k))
struct Args { const float* in[28]; float* out; unsigned char* ws; int ph_lo, ph_hi; };
enum { I_X = 0, I_WIN, I_LQ1, I_LK1, I_LQ2, I_LK2, I_SUBLN, I_CDW, I_CLNG, I_CLNB, I_CPW, I_RCW, I_RCB, I_RWA, I_RBA, I_RWX, I_RBX, I_RLAM, I_WOUT,
       I_LN1G, I_LN1B, I_RTW, I_RTB, I_EWG, I_EWU, I_EWD, I_LN2G, I_LN2B };
constexpr int NPH = 12;
constexpr int NPHASES = 1 + NLAYER * NPH;

template <bool F8>
__device__ __forceinline__ void cvt_tile(const float* src, int ld, unsigned char* dst, int dpitch, float scale, LAS unsigned char* scr, int lane) {
    constexpr int NB = F8 ? 4 : 2;
    float va[32], vb[32];
#define CT_LOAD(v, b) do { _Pragma("unroll") for (int r = 0; r < 32; ++r) v[r] = src[(size_t)((b) * 32 + r) * ld]; } while (0)
#define CT_CONV(v, b) do { if constexpr (F8) { _Pragma("unroll") for (int i = 0; i < 4; ++i) { u32x2 w; \
            w.x = cvt4_fp8(v[8 * i + 0] * scale, v[8 * i + 1] * scale, v[8 * i + 2] * scale, v[8 * i + 3] * scale); \
            w.y = cvt4_fp8(v[8 * i + 4] * scale, v[8 * i + 5] * scale, v[8 * i + 6] * scale, v[8 * i + 7] * scale); \
            *(LAS u32x2*)(scr + lane * 136 + (b) * 32 + i * 8) = w; } } \
        else { _Pragma("unroll") for (int i = 0; i < 8; ++i) { u32x2 w; w.x = cvt_pk_bf16(v[4 * i + 0], v[4 * i + 1]); w.y = cvt_pk_bf16(v[4 * i + 2], v[4 * i + 3]); \
            *(LAS u32x2*)(scr + lane * 136 + (b) * 64 + i * 8) = w; } } } while (0)
    CT_LOAD(va, 0);
#pragma unroll
    for (int b = 0; b < NB; b += 2) {
        CT_LOAD(vb, b + 1);
        __builtin_amdgcn_sched_barrier(0);
        CT_CONV(va, b);
        if (b + 2 < NB) CT_LOAD(va, b + 2);
        __builtin_amdgcn_sched_barrier(0);
        CT_CONV(vb, b + 1);
    }
#undef CT_LOAD
#undef CT_CONV
    LDS_WAIT();
#pragma unroll
    for (int it = 0; it < 8; ++it) { const int id = it * 64 + lane, n = id >> 3, c = id & 7;
        const u32x2 a = *(const LAS u32x2*)(scr + n * 136 + c * 16), b = *(const LAS u32x2*)(scr + n * 136 + c * 16 + 8);
        u32x4 o; o.x = a.x; o.y = a.y; o.z = b.x; o.w = b.y;
        *(u32x4*)(dst + (size_t)n * dpitch + c * 16) = o; }
    LDS_WAIT();
}

struct F8Tile { const float* src; unsigned char* dst; int ld, dpitch, drow, dstep; float scale; };
__device__ __forceinline__ F8Tile f8_tile(const Args& a, LAS unsigned char* lds, unsigned char* ws, int t, int lane, int wave) {
    F8Tile T;
    if (t < 640) {
        const int l = t / 160, r = t % 160, kt = r / 20, nt = r % 20, sc = 4 * lane;
        T.src = AIN(I_WIN) + (size_t)l * DM * DIN + (size_t)(kt * 256 + 32 * wave) * DIN + nt * 256 + sc; T.ld = DIN; T.scale = WIN_SCALE;
        T.dst = ws + WS_WIN + (size_t)l * DIN * DM + (size_t)(nt * 256) * DM + kt * 256; T.dpitch = DM;
        if (nt < 8) { const int d = sc & 127; T.drow = (sc & 128) + 2 * (d & 63) + (d >> 6); T.dstep = 2; } else { T.drow = sc; T.dstep = 1; }
    } else if (t < 640 + 4096) {
        t -= 640; const int le = t / 64, r = t % 64, kt = r / 8, nt = r % 8, half = lane >> 5, lc = lane & 31;
        T.src = (half ? AIN(I_EWU) : AIN(I_EWG)) + (size_t)le * DM * DEXP + (size_t)(kt * 256 + 32 * wave) * DEXP + nt * 128 + 4 * lc; T.ld = DEXP; T.scale = W1_SCALE;
        T.dst = ws + WS_W1 + (size_t)le * 2048 * DM + (size_t)(nt * 256) * DM + kt * 256; T.dpitch = DM;
        T.drow = 8 * lc + half; T.dstep = 2;
    } else if (t >= 640 + 4096 + 2048) {
        t -= 640 + 4096 + 2048; const int l = t / 64, r = t % 64, kt = r / 8, nt = r % 8;
        T.src = AIN(I_WOUT) + (size_t)l * DM * DM + (size_t)(kt * 256 + 32 * wave) * DM + nt * 256 + 4 * lane; T.ld = DM; T.scale = WOUT_SCALE;
        T.dst = ws + WS_WOUT + (size_t)l * DM * DM + (size_t)(nt * 256) * DM + kt * 256; T.dpitch = DM;
        T.drow = 4 * lane; T.dstep = 1;
    } else {
        t -= 640 + 4096; const int le = t / 32, r = t % 32, kt = r / 8, nt = r % 8;
        T.src = AIN(I_EWD) + (size_t)le * DEXP * DM + (size_t)(kt * 256 + 32 * wave) * DM + nt * 256 + 4 * lane; T.ld = DM; T.scale = W2_SCALE;
        T.dst = ws + WS_W2 + (size_t)le * DM * DEXP + (size_t)(nt * 256) * DEXP + kt * 256; T.dpitch = DEXP;
        T.drow = 4 * lane; T.dstep = 1;
    }
    return T;
}
__device__ __forceinline__ int f8_tile_of(int l, int k) { return k < 160 ? l * 160 + k : (k < 1184 ? 640 + l * 1024 + (k - 160) : (k < 1696 ? 640 + 4096 + l * 512 + (k - 1184) : 640 + 4096 + 2048 + l * 64 + (k - 1696))); }
constexpr int F8_TILES_PER_LAYER = 1760;
template <bool STEAL>
__device__ __forceinline__ void f8_convert(const Args& a, LAS unsigned char* lds, unsigned char* ws, int l, int first, int stride, int quota, unsigned* ticket, int tid, int lane, int wave) {
    volatile LAS int* word = (volatile LAS int*)(lds + MISC_OFF) + 16;
    f32x4 v[32];
    int k, n = 0;
    if constexpr (STEAL) {
        __syncthreads();
        if (tid == 0) word[0] = (quota > 0) ? (int)__hip_atomic_fetch_add(ticket, 1u, __ATOMIC_RELAXED, __HIP_MEMORY_SCOPE_AGENT) : F8_TILES_PER_LAYER;
        __syncthreads();
        k = word[0];
    } else k = first;
    F8Tile T = f8_tile(a, lds, ws, f8_tile_of(l, k < F8_TILES_PER_LAYER ? k : 0), lane, wave);
#define F8_LOADS() do { _Pragma("unroll") for (int q = 0; q < 32; ++q) v[q] = __builtin_nontemporal_load((const f32x4*)(T.src + (size_t)q * T.ld)); } while (0)
    if (k < F8_TILES_PER_LAYER) F8_LOADS();
    while (k < F8_TILES_PER_LAYER) {
        LAS unsigned char* buf = lds + (n & 1) * 65536;
        if constexpr (STEAL) { if (tid == 0) word[(n + 1) & 1] = (n + 1 < quota) ? (int)__hip_atomic_fetch_add(ticket, 1u, __ATOMIC_RELAXED, __HIP_MEMORY_SCOPE_AGENT) : F8_TILES_PER_LAYER; }
        const float sc = T.scale;
#pragma unroll
        for (int c = 0; c < 4; ++c) {
            const int R = T.drow + c * T.dstep, sw = (R >> 2) & 15;
            u32x4 lo, hi;
            lo.x = cvt4_fp8(v[0][c] * sc, v[1][c] * sc, v[2][c] * sc, v[3][c] * sc);     lo.y = cvt4_fp8(v[4][c] * sc, v[5][c] * sc, v[6][c] * sc, v[7][c] * sc);
            lo.z = cvt4_fp8(v[8][c] * sc, v[9][c] * sc, v[10][c] * sc, v[11][c] * sc);   lo.w = cvt4_fp8(v[12][c] * sc, v[13][c] * sc, v[14][c] * sc, v[15][c] * sc);
            hi.x = cvt4_fp8(v[16][c] * sc, v[17][c] * sc, v[18][c] * sc, v[19][c] * sc); hi.y = cvt4_fp8(v[20][c] * sc, v[21][c] * sc, v[22][c] * sc, v[23][c] * sc);
            hi.z = cvt4_fp8(v[24][c] * sc, v[25][c] * sc, v[26][c] * sc, v[27][c] * sc); hi.w = cvt4_fp8(v[28][c] * sc, v[29][c] * sc, v[30][c] * sc, v[31][c] * sc);
            *(LAS u32x4*)(buf + R * 256 + (((2 * wave) ^ sw) << 4)) = lo;
            *(LAS u32x4*)(buf + R * 256 + (((2 * wave + 1) ^ sw) << 4)) = hi;
        }
        __syncthreads();
        unsigned char* const dst = T.dst; const int dpitch = T.dpitch;
        int kn; if constexpr (STEAL) kn = word[(n + 1) & 1]; else kn = k + stride;
        if (kn < F8_TILES_PER_LAYER) { T = f8_tile(a, lds, ws, f8_tile_of(l, kn), lane, wave); F8_LOADS(); }
        __builtin_amdgcn_sched_barrier(0);
#pragma unroll
        for (int it = 0; it < 8; ++it) { const int id = it * NTHREADS + tid, R = id >> 4, cl = id & 15;
            const u32x4 o = *(const LAS u32x4*)(buf + R * 256 + ((cl ^ ((R >> 2) & 15)) << 4));
            __builtin_nontemporal_store(o, (u32x4*)(dst + (size_t)R * dpitch + cl * 16)); }
        k = kn; ++n;
    }
#undef F8_LOADS
    __syncthreads();
}
__device__ __forceinline__ void phase_prologue(const Args& a, LAS unsigned char* lds, int G, int tid, int lane, int wave) {
    unsigned char* ws = a.ws;
    f8_convert<false>(a, lds, ws, 0, (int)blockIdx.x, G, 0, nullptr, tid, lane, wave);
    LAS unsigned char* scr = lds + wave * 8704;
    const int gw = blockIdx.x * NWAVES + wave, NGW = G * NWAVES;
    constexpr int nB = 4 * 32 * 32, nE = 4 * 8 * 8, nF = 16 * 2 * 4;
    constexpr int NITEMS = nB + nE + nF;
    for (int it0 = gw; it0 < NITEMS; it0 += NGW) {
        int it = it0; const float* src; unsigned char* dst; int ld, dpitch;
        if (it < nB) { continue;
            const int l = it / 1024, r = it % 1024, kt = r / 32, nt = r % 32;
            src = AIN(I_WOUT) + (size_t)l * DM * DM + (size_t)(kt * 64) * DM + nt * 64 + lane; ld = DM;
            dst = ws + WS_WOUT + ((size_t)l * DM * DM + (size_t)(nt * 64) * DM + kt * 64) * 2; dpitch = DM * 2; }
        else if ((it -= nB) < nE) { const int l = it / 64, r = it % 64, kt = r / 8, nt = r % 8;
            src = AIN(I_CPW) + (size_t)l * CW * CW + (size_t)(kt * 64) * CW + nt * 64 + lane; ld = CW;
            dst = ws + WS_PW + ((size_t)l * CW * CW + (size_t)(nt * 64) * CW + kt * 64) * 2; dpitch = CW * 2; }
        else { it -= nE; const int lb = it / 8, r = it % 8, kt = r / 4, nt = r % 4, np = nt * 64 + lane;
            src = ((np < 128) ? AIN(I_RWA) : AIN(I_RWX)) + (size_t)lb * 128 * 128 + (size_t)(kt * 64) * 128 + (np & 127); ld = 128;
            dst = ws + WS_WRG + ((size_t)lb * 256 * 128 + (size_t)(nt * 64) * 128 + kt * 64) * 2; dpitch = 128 * 2; }
        cvt_tile<false>(src, ld, dst, dpitch, 1.f, scr, lane);
    }
    const int gt = blockIdx.x * NTHREADS + tid, NGT = G * NTHREADS;
    { const float* x = AIN(I_X); unsigned char* xb = ws + WS_XB;
      for (int i = gt; i < MTOK * DM / 8; i += NGT) { const f32x4 v0 = *(const f32x4*)(x + (size_t)i * 8), v1 = *(const f32x4*)(x + (size_t)i * 8 + 4);
          u32x2 w; w.x = cvt4_fp8(v0[0], v0[1], v0[2], v0[3]); w.y = cvt4_fp8(v1[0], v1[1], v1[2], v1[3]);
          *(u32x2*)(xb + (size_t)i * 8) = w;
          u32x4 h; h.x = cvt_pk_bf16(v0[0], v0[1]); h.y = cvt_pk_bf16(v0[2], v0[3]); h.z = cvt_pk_bf16(v1[0], v1[1]); h.w = cvt_pk_bf16(v1[2], v1[3]);
          *(u32x4*)((bf16_t*)(ws + WS_XA) + (size_t)i * 8) = h; } }
    { const float* rtw = AIN(I_RTW); float* img = (float*)(ws + WS_RWT);
      for (int i = gt; i < DM * NEXP; i += NGT) img[(i & 15) * 2052 + (i >> 4)] = rtw[i];
      for (int i = gt; i < 16 * 4 + 448; i += NGT) { if (i < 64) img[(i >> 2) * 2052 + 2048 + (i & 3)] = 0.f; else img[16 * 2052 + (i - 64)] = 0.f; } }
    { float* cosT = (float*)(ws + WS_COS); float* sinT = (float*)(ws + WS_SIN);
      for (int i = gt; i < SEQ * 64; i += NGT) { const int pos = i >> 6, j = i & 63;
          const float inv = exp2f(-(float)j * 0.20762050593046014f);
          const float ang = (float)pos * inv;
          const double ad = (double)ang; const double n = rint(ad * 0.15915494309189535); const float r = (float)(ad - n * 6.283185307179586);
          cosT[i] = cosf(r); sinT[i] = sinf(r); } }
    { float* sp8 = (float*)(ws + WS_SP8);
      const float* rlam = AIN(I_RLAM);
      for (int i = gt; i < NLAYER * RW; i += NGT) { const float lam = rlam[i]; sp8[i] = 8.f * log1pf(expf(-lam)); } }
}

__device__ __forceinline__ void conv_unit(const Args& a, int l, int u, LAS unsigned char* lds, int tid, int lane, int wave) {
    unsigned char* ws = opaque_p(a.ws);
    const bf16_t* Z = (const bf16_t*)(ws + WS_Z);
    LAS float* gbuf = (LAS float*)lds;
    LAS float* cbuf = gbuf + 46 * 512;
    const int c = tid, rowbase = u * 16, t0 = rowbase & (SEQ - 1);
    {
        u32x4 r1[6], r2[6];
#pragma unroll
        for (int k = 0; k < 6; ++k) { const int i = tid + 512 * k, j = i >> 6, q = i & 63; const bool ok = (i < 46 * 64) && (t0 - 30 + j >= 0);
            const size_t ro = (size_t)(rowbase - 30 + (ok ? j : 30)) * DIN + ZC_OFF + 8 * q;
            r1[k] = *(const u32x4*)(Z + ro); r2[k] = *(const u32x4*)(Z + ro + CW);
            if (!ok) { r1[k] = (u32x4){0u, 0u, 0u, 0u}; } }
#pragma unroll
        for (int k = 0; k < 6; ++k) { const int i = tid + 512 * k, j = i >> 6, q = i & 63;
            if (i < 46 * 64) { f32x4 g0, g1;
                g0[0] = bflo(r1[k].x) * sigmoidf_(bflo(r2[k].x)); g0[1] = bfhi(r1[k].x) * sigmoidf_(bfhi(r2[k].x));
                g0[2] = bflo(r1[k].y) * sigmoidf_(bflo(r2[k].y)); g0[3] = bfhi(r1[k].y) * sigmoidf_(bfhi(r2[k].y));
                g1[0] = bflo(r1[k].z) * sigmoidf_(bflo(r2[k].z)); g1[1] = bfhi(r1[k].z) * sigmoidf_(bfhi(r2[k].z));
                g1[2] = bflo(r1[k].w) * sigmoidf_(bflo(r2[k].w)); g1[3] = bfhi(r1[k].w) * sigmoidf_(bfhi(r2[k].w));
                *(LAS f32x4*)(gbuf + j * 512 + 8 * q) = g0; *(LAS f32x4*)(gbuf + j * 512 + 8 * q + 4) = g1; } }
    }
    __syncthreads();
    float w[CK]; const float* cdw = AIN(I_CDW);
#pragma unroll
    for (int j = 0; j < CK; ++j) w[j] = cdw[(size_t)l * CK * CW + j * CW + c];
    for (int t = 0; t < 16; ++t) { float acc = 0.f;
#pragma unroll
        for (int j = 0; j < CK; ++j) acc = fmaf(w[j], gbuf[(t + j) * 512 + c], acc);
        cbuf[t * 512 + c] = acc; }
    __syncthreads();
    {
        const float* lg = AIN(I_CLNG) + l * CW + lane * 8; const float* lb = AIN(I_CLNB) + l * CW + lane * 8;
        const f32x4 g0 = *(const f32x4*)lg, g1 = *(const f32x4*)(lg + 4), b0 = *(const f32x4*)lb, b1 = *(const f32x4*)(lb + 4);
        bf16_t* SC = (bf16_t*)(ws + WS_SCONV);
#pragma unroll
        for (int q = 0; q < 2; ++q) { const int tt = wave + 8 * q;
            f32x4 v0 = *(const LAS f32x4*)(cbuf + tt * 512 + lane * 8), v1 = *(const LAS f32x4*)(cbuf + tt * 512 + lane * 8 + 4);
            const float mean = wave_sum((v0[0] + v0[1]) + (v0[2] + v0[3]) + (v1[0] + v1[1]) + (v1[2] + v1[3])) * (1.f / CW);
            v0 = v0 - mean; v1 = v1 - mean;
            const float var = wave_sum((v0[0] * v0[0] + v0[1] * v0[1]) + (v0[2] * v0[2] + v0[3] * v0[3]) + (v1[0] * v1[0] + v1[1] * v1[1]) + (v1[2] * v1[2] + v1[3] * v1[3])) * (1.f / CW);
            const float rstd = __builtin_amdgcn_rsqf(var + LN_EPS);
            v0 = v0 * rstd * g0 + b0; v1 = v1 * rstd * g1 + b1;
            float y[8] = {v0[0], v0[1], v0[2], v0[3], v1[0], v1[1], v1[2], v1[3]};
#pragma unroll
            for (int k = 0; k < 8; ++k) y[k] = y[k] * sigmoidf_(y[k]);
            u32x4 o; o.x = cvt_pk_bf16(y[0], y[1]); o.y = cvt_pk_bf16(y[2], y[3]); o.z = cvt_pk_bf16(y[4], y[5]); o.w = cvt_pk_bf16(y[6], y[7]);
            *(u32x4*)(SC + (size_t)(rowbase + tt) * CW + lane * 8) = o; }
    }
    {
        const float* rcw = AIN(I_RCW) + (size_t)l * 4 * RW + c;
        const float w0 = rcw[0], w1 = rcw[RW], w2 = rcw[2 * RW], w3 = rcw[3 * RW];
        const float bias = AIN(I_RCB)[l * RW + c];
        bf16_t* XC = (bf16_t*)(ws + WS_XC);
        float xs[19];
#pragma unroll
        for (int t = 0; t < 19; ++t) { const bool ok = (t >= 3) || (t0 >= 3); xs[t] = ok ? bf2f(Z[(size_t)(rowbase - 3 + t) * DIN + ZRX_OFF + c]) : 0.f; }
#pragma unroll
        for (int t = 0; t < 16; ++t) { const float xc = fmaf(w0, xs[t], fmaf(w1, xs[t + 1], fmaf(w2, xs[t + 2], w3 * xs[t + 3]))) + bias;
            XC[(size_t)(rowbase + t) * RW + c] = (bf16_t)(cvt_pk_bf16(xc, 0.f) & 0xffffu); }
    }
    __syncthreads();
}

__device__ __forceinline__ void moe_meta(const Args& a, LAS unsigned char* lds, int tid, int l) {
    volatile LAS int* meta = (volatile LAS int*)(lds + META_OFF);
    const unsigned* fill = (const unsigned*)(opaque_p(a.ws) + WS_CTL) + CW_FILL + 64 * l;
    __syncthreads();
    if (tid < 64) {
        const int c = (tid < 16) ? (int)__hip_atomic_load(fill + (tid & 15), __ATOMIC_RELAXED, __HIP_MEMORY_SCOPE_AGENT) : 0;
        const int p = ((c + 255) >> 8) << 8;
        int sc = p;
        sc += __builtin_amdgcn_update_dpp(0, sc, 0x111, 0xf, 0xf, true); sc += __builtin_amdgcn_update_dpp(0, sc, 0x112, 0xf, 0xf, true);
        sc += __builtin_amdgcn_update_dpp(0, sc, 0x114, 0xf, 0xf, true); sc += __builtin_amdgcn_update_dpp(0, sc, 0x118, 0xf, 0xf, true);
        if (tid < 16) { meta[tid] = c; meta[16 + tid] = sc - p; }
        if (tid == 15) meta[32] = sc >> 8;
    }
    __syncthreads();
    if (tid < 80) {
        const LAS int4_t* bp = (const LAS int4_t*)(lds + META_OFF + 64);
        const int4_t b0 = bp[0], b1 = bp[1], b2 = bp[2], b3 = bp[3]; const int r = tid * 256;
        const int e = (r >= b0.y) + (r >= b0.z) + (r >= b0.w) + (r >= b1.x) + (r >= b1.y) + (r >= b1.z) + (r >= b1.w) + (r >= b2.x) + (r >= b2.y) + (r >= b2.z) + (r >= b2.w)
                    + (r >= b3.x) + (r >= b3.y) + (r >= b3.z) + (r >= b3.w);
        meta[48 + tid] = e; }
    __syncthreads();
}

__global__ void __launch_bounds__(NTHREADS, 2) hybrid_fwd(Args a) {
    extern __shared__ __attribute__((aligned(16))) unsigned char lds_raw[];
    LAS unsigned char* const lds0 = (LAS unsigned char*)lds_raw;
    LAS unsigned char* lds = lds0;
    volatile LAS unsigned* MISC = (volatile LAS unsigned*)(lds + MISC_OFF);
    const int wid0 = __builtin_amdgcn_readfirstlane((int)threadIdx.x >> 6);
    const int tid = tidx(wid0), lane = tid & 63, wave = wid0;
    const int G = gridDim.x;
    unsigned char* ws = a.ws;
    unsigned* ctl = (unsigned*)(ws + WS_CTL);
    if (tid < 32) MISC[tid] = 0u;
    if (tid == 0) {
#pragma unroll
        for (int k = 0; k < 28; ++k) ((volatile LAS unsigned long long*)(lds + PTAB_OFF))[k] = (unsigned long long)a.in[k];
    }
    __syncthreads();
#if N_LAUNCH_MODE == 1
    if (blockIdx.x == 0) {
        u32x4* z = (u32x4*)ctl;
        for (int i = tid; i < 2560; i += NTHREADS) if (i != CW_FLAG / 4) z[i] = (u32x4){0u, 0u, 0u, 0u};
        asm volatile("s_waitcnt vmcnt(0)" ::: "memory");
        __syncthreads();
        if (tid == 0) { __builtin_amdgcn_fence(__ATOMIC_RELEASE, "agent"); __hip_atomic_store(ctl + CW_FLAG, CTL_MAGIC, __ATOMIC_RELAXED, __HIP_MEMORY_SCOPE_AGENT); }
    }
#endif
    const int lo = a.ph_lo, hi = a.ph_hi;
#ifndef ONLY_PH
#define ONLY_PH -1
#endif
#define PHEN(p) (ONLY_PH < 0 || ONLY_PH == (p))
#ifndef REPEAT_MASK
#define REPEAT_MASK 0
#endif
#define NREP(p) (((REPEAT_MASK >> (p)) & 1) ? 2 : 1)
#define IN(k) (lo <= (k) && (k) < hi)
#ifndef SEAM_REP
#define SEAM_REP 1
#endif
#define SEAM(k) do { if (IN(k) && IN((k) + 1)) for (int _r = 0; _r < SEAM_REP; ++_r) xcd_barrier(bar, wid0); } while (0)
    const int gw = blockIdx.x * NWAVES + wave, NGW = G * NWAVES;

    if (PHEN(0) && IN(0)) for (int rep = 0; rep < NREP(0); ++rep) { phase_prologue(a, lds, G, tid, lane, wave); __syncthreads(); }
#if N_LAUNCH_MODE == 1
    if (tid == 0 && blockIdx.x != 0) { unsigned sp = 0u;
        while (__hip_atomic_load(ctl + CW_FLAG, __ATOMIC_RELAXED, __HIP_MEMORY_SCOPE_AGENT) != CTL_MAGIC) { __builtin_amdgcn_s_sleep(2); if (++sp > (1u << 22)) break; }
        __builtin_amdgcn_fence(__ATOMIC_ACQUIRE, "agent"); asm volatile("s_waitcnt vmcnt(0)" ::: "memory"); }
    __syncthreads();
#endif
    XcdBarrier bar = xcd_barrier_post(ctl + CW_BAR, MISC + 8);
    SEAM(0);
#if N_LAUNCH_MODE == 1
    if (blockIdx.x == 0 && tid == 0) __hip_atomic_store(ctl + CW_FLAG, 0u, __ATOMIC_RELAXED, __HIP_MEMORY_SCOPE_AGENT);
#endif

    for (int l = 0; l < NLAYER; ++l) {
        const int pb = 1 + l * NPH;

        if (PHEN(1) && IN(pb + 0)) for (int rep = 0; rep < NREP(1); ++rep) { unsigned char* ws = opaque_p(a.ws); LAS unsigned char* lds = opaque_p(lds0); const int bid = opaque_s((int)blockIdx.x); const int tid = tidx(wid0), lane = tid & 63, wave = __builtin_amdgcn_readfirstlane(tid >> 6), gw = bid * NWAVES + wave; (void)lane; (void)gw;
            pg8::Gemm g{ws, (unsigned)WS_XB, (unsigned)(WS_WIN + (size_t)l * DIN * DM), DM / 2, DM / 2, opaque_s(DM / 2)};
            pg8::GridOrder S; S.init(MTOK, DIN, DM / 2, DM / 2, G, bid);
            EpiZ E{(bf16_t*)(ws + WS_Z), (const float*)(ws + WS_COS), (const float*)(ws + WS_SIN)};
            pg8::gemm_phase<EpiZ, pg8::GridOrder, true, true>(lds, g, S, E, wid0);
            if (l + 1 < NLAYER && G == 256 && bid >= 128)
                f8_convert<true>(a, lds, ws, l + 1, 0, 0, 2, (unsigned*)(ws + WS_CTL) + CW_TICK + 64 * (l + 1), tid, lane, wave);
        }
        SEAM(pb + 0);

        if (PHEN(2) && IN(pb + 1)) for (int rep = 0; rep < NREP(2); ++rep) { unsigned char* ws = opaque_p(a.ws); LAS unsigned char* lds = opaque_p(lds0); const int bid = opaque_s((int)blockIdx.x); const int tid = tidx(wid0), lane = tid & 63, wave = __builtin_amdgcn_readfirstlane(tid >> 6), gw = bid * NWAVES + wave; (void)lane; (void)gw;
#ifndef NO_ATT
            att::attn_phase((char*)lds, (const bf16_t*)(ws + WS_Z), (bf16_t*)(ws + WS_OC), G, (G == 256) ? ((bid & 7) * 32 + (bid >> 3)) : bid, wid0);
#endif
            __syncthreads();
#ifndef NO_CONV
            for (int u0 = bid; u0 < MTOK / 16; u0 += G) {
                const int u = (G == 256) ? ((bid & 7) * 64 + (bid >> 3) * 2 + (u0 >> 8)) : u0;
                conv_unit(a, l, u, lds, tid, lane, wave); }
#endif
        }
        SEAM(pb + 1);

        if (PHEN(3) && IN(pb + 2)) for (int rep = 0; rep < NREP(3); ++rep) { unsigned char* ws = opaque_p(a.ws); LAS unsigned char* lds = opaque_p(lds0); const int bid = opaque_s((int)blockIdx.x); const int tid = tidx(wid0), lane = tid & 63, wave = __builtin_amdgcn_readfirstlane(tid >> 6), gw = bid * NWAVES + wave; (void)lane; (void)gw;
            pg8::Gemm g{ws, (unsigned)WS_XC, (unsigned)(WS_WRG + (size_t)l * 4 * 256 * 128 * 2), RW, 128, opaque_s(128)};
            RgOrder S{G, bid};
            EpiGate E{(float*)(ws + WS_SA), (float*)(ws + WS_SB), (const bf16_t*)(ws + WS_XC), AIN(I_RBA) + l * RW, AIN(I_RBX) + l * RW, (const float*)(ws + WS_SP8) + l * RW, (float*)(ws + WS_SUMA), (float*)(ws + WS_SUMH)};
            pg8::gemm_phase<EpiGate, RgOrder, true>(lds, g, S, E, wid0);
            if (bid >= 128) {
                pg8::Gemm g2{ws, (unsigned)WS_SCONV, (unsigned)(WS_PW + (size_t)l * CW * CW * 2), CW, CW, CW};
                pg8::GridOrder S2; S2.init(MTOK, CW, CW, CW, G - 128, bid - 128);
                EpiBf16Off E2{ws + WS_CAT, DM, 1024};
                pg8::gemm_phase<EpiBf16Off, pg8::GridOrder, true>(lds, g2, S2, E2, wid0);
                if (l + 1 < NLAYER && G == 256)
                    f8_convert<true>(a, lds, ws, l + 1, 0, 0, bid >= 192 ? 2 : 1, (unsigned*)(ws + WS_CTL) + CW_TICK + 64 * (l + 1), tid, lane, wave);
            }
        }
        SEAM(pb + 2);

        if (PHEN(5) && IN(pb + 4)) for (int rep = 0; rep < NREP(5); ++rep) { unsigned char* ws = opaque_p(a.ws); LAS unsigned char* lds = opaque_p(lds0); const int bid = opaque_s((int)blockIdx.x); const int tid = tidx(wid0), lane = tid & 63, wave = __builtin_amdgcn_readfirstlane(tid >> 6), gw = bid * NWAVES + wave; (void)lane; (void)gw;
            unsigned char* CAT = ws + WS_CAT;
            {
                const float li = 0.8f - 0.6f * expf(-0.3f * (float)l);
                const float* q1 = AIN(I_LQ1) + l * 128 + lane; const float* k1 = AIN(I_LK1) + l * 128 + lane; const float* q2 = AIN(I_LQ2) + l * 128 + lane; const float* k2 = AIN(I_LK2) + l * 128 + lane;
                const float d1 = wave_sum(q1[0] * k1[0] + q1[64] * k1[64]);
                const float d2 = wave_sum(q2[0] * k2[0] + q2[64] * k2[64]);
                const float lam = expf(d1) - expf(d2) + li;
                const f32x4 sg = *(const f32x4*)(AIN(I_SUBLN) + l * 256 + lane * 4) * (1.f - li);
                const bf16_t* O0 = (const bf16_t*)(ws + WS_OC); const bf16_t* O1 = O0 + (size_t)MTOK * 1024;
                for (int row0 = gw; row0 < MTOK; row0 += 2 * NGW) {
                    f32x4 p0[2][4], p1[2][4];
#pragma unroll
                    for (int rr = 0; rr < 2; ++rr)
#pragma unroll
                        for (int h = 0; h < 4; ++h) { const int row = row0 + rr * NGW; const size_t off = (size_t)(row < MTOK ? row : row0) * 1024 + h * 256 + lane * 4;
                            const u32x2 a0 = *(const u32x2*)(O0 + off), a1 = *(const u32x2*)(O1 + off);
                            p0[rr][h] = (f32x4){bflo(a0.x), bfhi(a0.x), bflo(a0.y), bfhi(a0.y)}; p1[rr][h] = (f32x4){bflo(a1.x), bfhi(a1.x), bflo(a1.y), bfhi(a1.y)}; }
#pragma unroll
                    for (int rr = 0; rr < 2; ++rr) { const int row = row0 + rr * NGW;
                        if (row < MTOK) {
#pragma unroll
                            for (int h = 0; h < 4; ++h) {
                                const f32x4 o = p0[rr][h] - p1[rr][h] * lam;
                                const float ss = wave_sum((o[0] * o[0] + o[1] * o[1]) + (o[2] * o[2] + o[3] * o[3]));
                                const float r = __builtin_amdgcn_rsqf(ss * (1.f / 256.f) + LN_EPS);
                                const f32x4 y = o * r * sg;
                                __builtin_nontemporal_store(cvt4_fp8(y[0] * CAT_SCALE, y[1] * CAT_SCALE, y[2] * CAT_SCALE, y[3] * CAT_SCALE), (unsigned*)(CAT + (size_t)row * DM + h * 256 + lane * 4)); } } }
                }
            }
            {
                const float* SA = (const float*)(ws + WS_SA); const float* SB = (const float*)(ws + WS_SB);
                const float* sumA = (const float*)(ws + WS_SUMA); const float* sumH = (const float*)(ws + WS_SUMH);
                const bf16_t* Z = (const bf16_t*)(ws + WS_Z);
                for (int u = bid; u < MTOK / 32; u += G) {
                    const int j = u & 63; float carry = 0.f;
                    for (int jj0 = 0; jj0 < j; jj0 += 32) { float ca[32], ch[32];
#pragma unroll
                        for (int q = 0; q < 32; ++q) { const bool ok = jj0 + q < j; const int idx = (u - j + (ok ? jj0 + q : 0)) * RW + tid; ca[q] = sumA[idx]; ch[q] = sumH[idx]; if (!ok) { ca[q] = 1.f; ch[q] = 0.f; } }
#pragma unroll
                        for (int q = 0; q < 32; ++q) carry = fmaf(ca[q], carry, ch[q]); }
#pragma unroll
                    for (int hb = 0; hb < 2; ++hb) { float pa[16], hl[16], gx[16];
#pragma unroll
                        for (int t = 0; t < 16; ++t) { const size_t row = (size_t)u * 32 + hb * 16 + t; pa[t] = SA[row * RW + tid]; hl[t] = SB[row * RW + tid]; gx[t] = bf2f(Z[row * DIN + ZRG_OFF + tid]); }
#pragma unroll
                        for (int t = 0; t < 16; ++t) { const size_t row = (size_t)u * 32 + hb * 16 + t;
                            const float h = fmaf(pa[t], carry, hl[t]), x = gx[t];
                            const float y = 0.7978845608028654f * (x + 0.044715f * x * x * x);
                            const float th = 1.f - 2.f * __builtin_amdgcn_rcpf(__expf(2.f * y) + 1.f);
                            const float ge = 0.5f * x * (1.f + th);
                            const float cv = h * ge * CAT_SCALE; __builtin_nontemporal_store((unsigned char)(cvt4_fp8(cv, cv, cv, cv) & 0xffu), CAT + row * DM + 1536 + tid); } }
                }
            }
        }
        SEAM(pb + 4);

        if (PHEN(6) && IN(pb + 5)) for (int rep = 0; rep < NREP(6); ++rep) { unsigned char* ws = opaque_p(a.ws); LAS unsigned char* lds = opaque_p(lds0); const int bid = opaque_s((int)blockIdx.x); const int tid = tidx(wid0), lane = tid & 63, wave = __builtin_amdgcn_readfirstlane(tid >> 6), gw = bid * NWAVES + wave; (void)lane; (void)gw;
            pg8::Gemm g{ws, (unsigned)WS_CAT, (unsigned)(WS_WOUT + (size_t)l * DM * DM), DM / 2, DM / 2, opaque_s(DM / 2)};
            pg8::GridOrder S; S.init(MTOK, DM, DM / 2, DM / 2, G, bid);
            EpiResBf16 E{(bf16_t*)(ws + WS_YBUF), (const bf16_t*)(ws + WS_XA)};
            pg8::gemm_phase<EpiResBf16, pg8::GridOrder, true, true>(lds, g, S, E, wid0);
#ifdef DUP_P6
            { if (opaque_s(1)) pg8::gemm_phase<EpiResBf16, pg8::GridOrder, true, false, 1>(lds, g, S, E, wid0); }
#endif
        }
        SEAM(pb + 5);

        if (PHEN(7) && IN(pb + 6)) for (int rep = 0; rep < NREP(7); ++rep) { unsigned char* ws = opaque_p(a.ws); LAS unsigned char* lds = opaque_p(lds0); const int bid = opaque_s((int)blockIdx.x); const int tid = tidx(wid0), lane = tid & 63, wave = __builtin_amdgcn_readfirstlane(tid >> 6), gw = bid * NWAVES + wave; (void)lane; (void)gw;
            LAS float* rwT = (LAS float*)lds;
            LAS int* hist = (LAS int*)(lds + META_OFF);
            LAS int* ent = (LAS int*)(lds + 131328);
            {
                const unsigned char* img = ws + WS_RWT;
#pragma unroll
                for (int i = 0; i < 16; ++i) __builtin_amdgcn_global_load_lds((const unsigned*)(img + (size_t)(i * 8 + wave) * 1024 + lane * 16), (LAS unsigned*)(lds + (i * 8 + wave) * 1024), 16, 0, 0);
                if (wave == 0) __builtin_amdgcn_global_load_lds((const unsigned*)(img + (size_t)128 * 1024 + lane * 16), (LAS unsigned*)(lds + 128 * 1024), 16, 0, 0);
            }
            float rb[16]; const float* rtb = AIN(I_RTB);
#pragma unroll
            for (int e = 0; e < 16; ++e) rb[e] = rtb[e];
            const bf16_t* YB = (const bf16_t*)(ws + WS_YBUF); bf16_t* X1B = (bf16_t*)(ws + WS_X1B);
            int* tokE = (int*)(ws + WS_TOKE); int* tokP = (int*)(ws + WS_TOKS); int* lst = (int*)(ws + WS_LIST); float* lstW = (float*)(ws + WS_LISTW); unsigned char* X1F = ws + WS_XG;
            unsigned* fill = (unsigned*)(ws + WS_CTL) + CW_FILL + 64 * l;
            const float* lg = AIN(I_LN1G) + l * DM; const float* lb = AIN(I_LN1B) + l * DM;
            for (int v = bid; v < 256; v += G) {
                __syncthreads();
                if (tid < 16) hist[tid] = 0;
                __syncthreads();
                u32x2 raw[2][8];
#pragma unroll
                for (int q = 0; q < 2; ++q)
#pragma unroll
                    for (int j = 0; j < 8; ++j) raw[q][j] = __builtin_nontemporal_load((const u32x2*)(YB + (size_t)(v * 32 + wave + 8 * q) * DM + j * 256 + lane * 4));
                asm volatile("s_waitcnt vmcnt(0)" ::: "memory"); __syncthreads();
#define P7_LN(q_, ri_, YV_) do { const int row = v * 32 + wave + 8 * (q_); float s = 0.f;                                                                       \
                    _Pragma("unroll") for (int j = 0; j < 8; ++j) { const u32x2 p = raw[ri_][j]; YV_[j] = (f32x4){bflo(p.x), bfhi(p.x), bflo(p.y), bfhi(p.y)}; s += (YV_[j][0] + YV_[j][1]) + (YV_[j][2] + YV_[j][3]); } \
                    const float mean = wave_sum(s) * (1.f / DM); float s2 = 0.f;                                                                                 \
                    _Pragma("unroll") for (int j = 0; j < 8; ++j) { YV_[j] = YV_[j] - mean; s2 += (YV_[j][0] * YV_[j][0] + YV_[j][1] * YV_[j][1]) + (YV_[j][2] * YV_[j][2] + YV_[j][3] * YV_[j][3]); } \
                    const float rstd = __builtin_amdgcn_rsqf(wave_sum(s2) * (1.f / DM) + LN_EPS);                                                                \
                    const float* lgq = opaque_p(lg); const float* lbq = opaque_p(lb);     \
                    _Pragma("unroll") for (int j = 0; j < 8; ++j) { const f32x4 gg = *(const f32x4*)(lgq + j * 256 + lane * 4), bb = *(const f32x4*)(lbq + j * 256 + lane * 4); \
                        YV_[j] = YV_[j] * rstd * gg + bb;                                                                                                            \
                        u32x2 w; w.x = cvt_pk_bf16(YV_[j][0], YV_[j][1]); w.y = cvt_pk_bf16(YV_[j][2], YV_[j][3]);                                                       \
                        __builtin_nontemporal_store(w, (u32x2*)(X1B + (size_t)row * DM + j * 256 + lane * 4));                                                                            \
                        __builtin_nontemporal_store(cvt4_fp8(YV_[j][0], YV_[j][1], YV_[j][2], YV_[j][3]), (unsigned*)(X1F + (size_t)row * DM + j * 256 + lane * 4)); } } while (0)
#define P7_PICK(q_, AC_) do { float sc[16], bi[16];                                                                                                             \
                    _Pragma("unroll") for (int e = 0; e < 16; ++e) { AC_[e] = wave_sum(AC_[e]); sc[e] = sigmoidf_(AC_[e]); bi[e] = sc[e] + rb[e]; }              \
                    float bgs = -__builtin_inff(); int e1 = 0, e2 = 1; float s1 = 0.f, sv2 = 0.f;                                                                \
                    _Pragma("unroll") for (int g = 0; g < 4; ++g) {                                                                                              \
                        const float b0 = bi[4 * g], b1 = bi[4 * g + 1], b2 = bi[4 * g + 2], b3 = bi[4 * g + 3];                                                  \
                        const float t0 = sc[4 * g], t1 = sc[4 * g + 1], t2 = sc[4 * g + 2], t3 = sc[4 * g + 3];                                                  \
                        int i1 = 0; float m1 = b0, c1 = t0;                                                                                                      \
                        if (b1 > m1) { m1 = b1; i1 = 1; c1 = t1; } if (b2 > m1) { m1 = b2; i1 = 2; c1 = t2; } if (b3 > m1) { m1 = b3; i1 = 3; c1 = t3; }          \
                        int i2 = 0; float m2 = -__builtin_inff(), c2 = 0.f;                                                                                      \
                        if (i1 != 0 && b0 > m2) { m2 = b0; i2 = 0; c2 = t0; } if (i1 != 1 && b1 > m2) { m2 = b1; i2 = 1; c2 = t1; }                              \
                        if (i1 != 2 && b2 > m2) { m2 = b2; i2 = 2; c2 = t2; } if (i1 != 3 && b3 > m2) { m2 = b3; i2 = 3; c2 = t3; }                              \
                        const float gs = m1 + m2;                                                                                                                \
                        if (gs > bgs) { bgs = gs; e1 = 4 * g + i1; e2 = 4 * g + i2; s1 = c1; sv2 = c2; }                                                         \
                    }                                                                                                                                            \
                    if (lane == 0) { const float inv = 1.f / (s1 + sv2); const int rl = wave + 8 * (q_);                                                         \
                        const int r1 = __hip_atomic_fetch_add(hist + e1, 1, __ATOMIC_RELAXED, __HIP_MEMORY_SCOPE_WORKGROUP), r2 = __hip_atomic_fetch_add(hist + e2, 1, __ATOMIC_RELAXED, __HIP_MEMORY_SCOPE_WORKGROUP); \
                        ent[rl * 6 + 0] = e1; ent[rl * 6 + 1] = r1; ent[rl * 6 + 2] = __float_as_int(s1 * inv); ent[rl * 6 + 3] = e2; ent[rl * 6 + 4] = r2; ent[rl * 6 + 5] = __float_as_int(sv2 * inv); } } while (0)
#pragma unroll
                for (int qp = 0; qp < 2; ++qp) {
                    __builtin_amdgcn_sched_barrier(0);
                    f32x4 ya[8], yb[8];
                    P7_LN(2 * qp, 0, ya);
                    __builtin_amdgcn_sched_barrier(0);
                    P7_LN(2 * qp + 1, 1, yb);
                    __builtin_amdgcn_sched_barrier(0);
                    if (qp == 0) {
#pragma unroll
                        for (int q = 0; q < 2; ++q)
#pragma unroll
                            for (int j = 0; j < 8; ++j) raw[q][j] = __builtin_nontemporal_load((const u32x2*)(YB + (size_t)(v * 32 + wave + 8 * (2 + q)) * DM + j * 256 + lane * 4));
                        __builtin_amdgcn_sched_barrier(0);
                    }
                    f32x2 y2[8][4];
#pragma unroll
                    for (int j = 0; j < 8; ++j)
#pragma unroll
                        for (int c = 0; c < 4; ++c) y2[j][c] = (f32x2){ya[j][c], yb[j][c]};
                    f32x2 acc2[16];
#pragma unroll
                    for (int e = 0; e < 16; ++e) acc2[e] = (f32x2){0.f, 0.f};
#pragma unroll
                    for (int j = 0; j < 8; ++j) {
#pragma unroll
                        for (int e = 0; e < 16; ++e) { const f32x4 w = *(const LAS f32x4*)(rwT + e * 2052 + j * 256 + lane * 4);
                            acc2[e] += y2[j][0] * (f32x2){w[0], w[0]}; acc2[e] += y2[j][1] * (f32x2){w[1], w[1]};
                            acc2[e] += y2[j][2] * (f32x2){w[2], w[2]}; acc2[e] += y2[j][3] * (f32x2){w[3], w[3]}; }
                        __builtin_amdgcn_sched_barrier(0);
                    }
                    float acca[16], accb[16];
#pragma unroll
                    for (int e = 0; e < 16; ++e) { acca[e] = acc2[e][0]; accb[e] = acc2[e][1]; }
                    P7_PICK(2 * qp, acca);
                    __builtin_amdgcn_sched_barrier(0);
                    P7_PICK(2 * qp + 1, accb);
                }
#undef P7_LN
#undef P7_PICK
                __syncthreads();
                if (tid < 16) hist[16 + tid] = (int)__hip_atomic_fetch_add(fill + tid, (unsigned)hist[tid], __ATOMIC_RELAXED, __HIP_MEMORY_SCOPE_AGENT);
                __syncthreads();
                if (tid < 64) { const int rl = tid >> 1, k = tid & 1, e = ent[rl * 6 + 3 * k], p = hist[16 + e] + ent[rl * 6 + 3 * k + 1], row = v * 32 + rl;
                    lst[e * MTOK + p] = row; lstW[e * MTOK + p] = __int_as_float(ent[rl * 6 + 3 * k + 2]); tokE[row * 2 + k] = e; tokP[row * 2 + k] = p; }
            }
            __syncthreads();
        }
        SEAM(pb + 6);

        if (PHEN(9) && IN(pb + 8)) for (int rep = 0; rep < NREP(9); ++rep) { unsigned char* ws = opaque_p(a.ws); LAS unsigned char* lds = opaque_p(lds0); const int bid = opaque_s((int)blockIdx.x); const int tid = tidx(wid0), lane = tid & 63, wave = __builtin_amdgcn_readfirstlane(tid >> 6), gw = bid * NWAVES + wave; (void)lane; (void)gw;
            moe_meta(a, lds, tid, l);
            volatile LAS int* meta = (volatile LAS int*)(lds + META_OFF);
            const int tot = meta[32] * 8, F = 2 * G;
            pg8::Gemm g{ws, (unsigned)WS_XG, (unsigned)(WS_W1 + (size_t)l * NEXP * 2048 * DM), DM / 2, DM / 2, opaque_s(DM / 2)};
            MoeOrder<true> S{G, bid, 0, tot < F ? tot : F, DM / 2, DM / 2, meta, (unsigned)(2048 * DM), G == 256 && tot >= 512, (const int*)(ws + WS_LIST)};
            EpiSwiGLU E{ws + WS_HB};
            pg8::gemm_phase<EpiSwiGLU, MoeOrder<true>, true, true>(lds, g, S, E, wid0);
        }
        SEAM(pb + 8);
        if (PHEN(10) && IN(pb + 9)) for (int rep = 0; rep < NREP(10); ++rep) { unsigned char* ws = opaque_p(a.ws); LAS unsigned char* lds = opaque_p(lds0); const int bid = opaque_s((int)blockIdx.x); const int tid = tidx(wid0), lane = tid & 63, wave = __builtin_amdgcn_readfirstlane(tid >> 6), gw = bid * NWAVES + wave; (void)lane; (void)gw;
#if N_LAUNCH_MODE != 1
            moe_meta(a, lds, tid, l);
#endif
            volatile LAS int* meta = (volatile LAS int*)(lds + META_OFF);
            const int tot = meta[32] * 8, F = 2 * G, R = tot > F ? tot - F : 0, done8 = (tot < F ? tot : F) & ~7;
            if (bid < R) {
                pg8::Gemm g{ws, (unsigned)WS_XG, (unsigned)(WS_W1 + (size_t)l * NEXP * 2048 * DM), DM / 2, DM / 2, opaque_s(DM / 2)};
                MoeOrder<true> S{G, bid, F, tot, DM / 2, DM / 2, meta, (unsigned)(2048 * DM), false, (const int*)(ws + WS_LIST)};
                EpiSwiGLU E{ws + WS_HB};
                pg8::gemm_phase<EpiSwiGLU, MoeOrder<true>, true, true, 1>(lds, g, S, E, wid0);
            } else {
                const int Gp = G - R; int hiB = 2 * Gp; if (hiB > done8) hiB = done8; if (hiB < 0) hiB = 0;
                pg8::Gemm g{ws, (unsigned)WS_HB, (unsigned)(WS_W2 + (size_t)l * NEXP * DM * DEXP), DEXP / 2, DEXP / 2, opaque_s(DEXP / 2)};
                MoeOrder<false> S{Gp, bid - R, 0, hiB, DEXP / 2, DEXP / 2, meta, (unsigned)(DM * DEXP), false, nullptr, ((Gp & 7) == 0 && (R & 7) == 0) ? 2 : 0};
                EpiScaleBf16 E{ws + WS_Y2, (const float*)(ws + WS_LISTW)};
                pg8::gemm_phase<EpiScaleBf16, MoeOrder<false>, true, true, 1>(lds, g, S, E, wid0);
            }
        }
        SEAM(pb + 9);
        if (PHEN(11) && IN(pb + 10)) for (int rep = 0; rep < NREP(11); ++rep) { unsigned char* ws = opaque_p(a.ws); LAS unsigned char* lds = opaque_p(lds0); const int bid = opaque_s((int)blockIdx.x); const int tid = tidx(wid0), lane = tid & 63, wave = __builtin_amdgcn_readfirstlane(tid >> 6), gw = bid * NWAVES + wave; (void)lane; (void)gw;
#if N_LAUNCH_MODE != 1
            moe_meta(a, lds, tid, l);
#endif
            volatile LAS int* meta = (volatile LAS int*)(lds + META_OFF);
            const int tot = meta[32] * 8, F = 2 * G, R = tot > F ? tot - F : 0, done8 = (tot < F ? tot : F) & ~7;
            int hiB = 2 * (G - R); if (hiB > done8) hiB = done8; if (hiB < 0) hiB = 0;
            pg8::Gemm g{ws, (unsigned)WS_HB, (unsigned)(WS_W2 + (size_t)l * NEXP * DM * DEXP), DEXP / 2, DEXP / 2, opaque_s(DEXP / 2)};
            const bool xm = (G & 7) == 0 && tot - hiB <= G;
            MoeOrder<false> S{G, bid, hiB, tot, DEXP / 2, DEXP / 2, meta, (unsigned)(DM * DEXP), false, nullptr, xm ? 1 : 0};
            EpiScaleBf16 E{ws + WS_Y2, (const float*)(ws + WS_LISTW)};
            pg8::gemm_phase<EpiScaleBf16, MoeOrder<false>, true, true>(lds, g, S, E, wid0);
            if (l + 1 < NLAYER && G == 256 && (xm ? ((bid & 7) * (G >> 3) + (bid >> 3)) : bid) >= tot - hiB)
                f8_convert<true>(a, lds, ws, l + 1, 0, 0, 1, (unsigned*)(ws + WS_CTL) + CW_TICK + 64 * (l + 1), tid, lane, wave);
        }
        SEAM(pb + 10);

        if (PHEN(12) && IN(pb + 11)) for (int rep = 0; rep < NREP(12); ++rep) { unsigned char* ws = opaque_p(a.ws); LAS unsigned char* lds = opaque_p(lds0); const int bid = opaque_s((int)blockIdx.x); const int tid = tidx(wid0), lane = tid & 63, wave = __builtin_amdgcn_readfirstlane(tid >> 6), gw = bid * NWAVES + wave; (void)lane; (void)gw;
            const bool lastl = (l == NLAYER - 1); bf16_t* XA16 = (bf16_t*)(ws + WS_XA);
            const bf16_t* X1B = (const bf16_t*)(ws + WS_X1B); const unsigned char* Y2 = ws + WS_Y2; const int* tokS = (const int*)(ws + WS_TOKS); const int* tokE = (const int*)(ws + WS_TOKE);
#if N_LAUNCH_MODE != 1
            moe_meta(a, lds, tid, l);
#endif
            volatile LAS int* meta = (volatile LAS int*)(lds + META_OFF);
            unsigned char* XB = ws + WS_XB;
            const float* lg = AIN(I_LN2G) + l * DM; const float* lb = AIN(I_LN2B) + l * DM;
            for (int row0 = gw; row0 < MTOK; row0 += 2 * NGW) {
                int sl[2][2];
#pragma unroll
                for (int rr = 0; rr < 2; ++rr) { const int row = row0 + rr * NGW; sl[rr][0] = meta[16 + tokE[row * 2]] + tokS[row * 2]; sl[rr][1] = meta[16 + tokE[row * 2 + 1]] + tokS[row * 2 + 1]; }
                u32x2 xw[2][8]; unsigned pw_[2][8], qw[2][8];
#pragma unroll
                for (int rr = 0; rr < 2; ++rr) { const int row = row0 + rr * NGW;
#pragma unroll
                    for (int j = 0; j < 8; ++j) { xw[rr][j] = __builtin_nontemporal_load((const u32x2*)(X1B + (size_t)row * DM + j * 256 + lane * 4));
                        pw_[rr][j] = __builtin_nontemporal_load((const unsigned*)(Y2 + (size_t)sl[rr][0] * DM + j * 256 + lane * 4)); qw[rr][j] = __builtin_nontemporal_load((const unsigned*)(Y2 + (size_t)sl[rr][1] * DM + j * 256 + lane * 4)); } }
#pragma unroll
                for (int rr = 0; rr < 2; ++rr) { const int row = row0 + rr * NGW;
                    f32x4 y[8]; float s = 0.f;
#pragma unroll
                    for (int j = 0; j < 8; ++j) { const u32x2 x = xw[rr][j]; const int p = (int)pw_[rr][j], q = (int)qw[rr][j];
                        const f32x2 p0 = __builtin_amdgcn_cvt_pk_f32_fp8(p, false), p1 = __builtin_amdgcn_cvt_pk_f32_fp8(p, true), q0 = __builtin_amdgcn_cvt_pk_f32_fp8(q, false), q1 = __builtin_amdgcn_cvt_pk_f32_fp8(q, true);
                        y[j][0] = bflo(x.x) * ALPHA + (p0.x + q0.x) * (1.f / Y2_SCALE); y[j][1] = bfhi(x.x) * ALPHA + (p0.y + q0.y) * (1.f / Y2_SCALE);
                        y[j][2] = bflo(x.y) * ALPHA + (p1.x + q1.x) * (1.f / Y2_SCALE); y[j][3] = bfhi(x.y) * ALPHA + (p1.y + q1.y) * (1.f / Y2_SCALE);
                        s += (y[j][0] + y[j][1]) + (y[j][2] + y[j][3]); }
                    const float mean = wave_sum(s) * (1.f / DM); float s2 = 0.f;
#pragma unroll
                    for (int j = 0; j < 8; ++j) { y[j] = y[j] - mean; s2 += (y[j][0] * y[j][0] + y[j][1] * y[j][1]) + (y[j][2] * y[j][2] + y[j][3] * y[j][3]); }
                    const float rstd = __builtin_amdgcn_rsqf(wave_sum(s2) * (1.f / DM) + LN_EPS);
#pragma unroll
                    for (int j = 0; j < 8; ++j) { const f32x4 gg = *(const f32x4*)(lg + j * 256 + lane * 4), bb = *(const f32x4*)(lb + j * 256 + lane * 4);
                        y[j] = y[j] * rstd * gg + bb;
                        if (lastl) __builtin_nontemporal_store(y[j], (f32x4*)(a.out + (size_t)row * DM + j * 256 + lane * 4));
                        else { u32x2 w; w.x = cvt_pk_bf16(y[j][0], y[j][1]); w.y = cvt_pk_bf16(y[j][2], y[j][3]); __builtin_nontemporal_store(w, (u32x2*)(XA16 + (size_t)row * DM + j * 256 + lane * 4)); }
                        if (!lastl) __builtin_nontemporal_store(cvt4_fp8(y[j][0], y[j][1], y[j][2], y[j][3]), (unsigned*)(XB + (size_t)row * DM + j * 256 + lane * 4)); }
                }
            }
            if (l + 1 < NLAYER)
                f8_convert<true>(a, lds, ws, l + 1, 0, 0, 1 << 30, (unsigned*)(ws + WS_CTL) + CW_TICK + 64 * (l + 1), tid, lane, wave);
        }
        SEAM(pb + 11);
    }
#undef IN
#undef SEAM
}

extern "C" void kernel_launch(void* const* d_in, const int* in_sizes, int n_in, void* d_out, int out_size, void* d_ws, size_t ws_size, hipStream_t stream) {
    static int grid = 0;
    if (grid == 0) {
        if (n_in != 28 || out_size != MTOK * DM || ws_size < WS_END) { fprintf(stderr, "kernel_launch: unexpected shapes (n_in %d out %d ws %zu)\n", n_in, out_size, ws_size); grid = -1; return; }
        int dev = 0, cus = 0, per_cu = 0;
        if (hipGetDevice(&dev) != hipSuccess || hipDeviceGetAttribute(&cus, hipDeviceAttributeMultiprocessorCount, dev) != hipSuccess) { grid = -1; return; }
        if (hipFuncSetAttribute((const void*)hybrid_fwd, hipFuncAttributeMaxDynamicSharedMemorySize, LDS_BYTES) != hipSuccess) { fprintf(stderr, "kernel_launch: hipFuncSetAttribute failed\n"); grid = -1; return; }
        if (hipOccupancyMaxActiveBlocksPerMultiprocessor(&per_cu, (const void*)hybrid_fwd, NTHREADS, LDS_BYTES) != hipSuccess || per_cu < 1) { fprintf(stderr, "kernel_launch: occupancy query says %d\n", per_cu); (void)hipGetLastError(); grid = -1; return; }
        grid = cus < 256 ? cus : 256;
    }
    if (grid < 0) return;
#if N_LAUNCH_MODE != 1
    (void)hipMemsetAsync((char*)d_ws + WS_CTL, 0, CTL_ZERO_BYTES, stream);
#endif
    Args a{};
    for (int i = 0; i < 28; ++i) a.in[i] = (const float*)d_in[i];
    a.out = (float*)d_out; a.ws = (unsigned char*)d_ws;
#if N_LAUNCH_MODE == 1
    a.ph_lo = 0; a.ph_hi = NPHASES;
    hipLaunchKernelGGL(hybrid_fwd, dim3(grid), dim3(NTHREADS), LDS_BYTES, stream, a);
#else
    for (int p = 0; p < NPHASES; ++p) { a.ph_lo = p; a.ph_hi = p + 1; hipLaunchKernelGGL(hybrid_fwd, dim3(grid), dim3(NTHREADS), LDS_BYTES, stream, a); }
#endif
}
```

```cpp
#include <hip/hip_runtime.h>
#include <cstdio>
#include <cstdint>

#ifndef N_LAUNCH_MODE
#define N_LAUNCH_MODE 1
#endif

#define GAS __attribute__((address_space(1)))
#define LAS __attribute__((address_space(3)))
typedef unsigned short bf16_t;
typedef short bf16x8 __attribute__((ext_vector_type(8)));
typedef short s16x4 __attribute__((ext_vector_type(4)));
typedef float f32x2 __attribute__((ext_vector_type(2)));
typedef int int4_t __attribute__((ext_vector_type(4)));
typedef float f32x4 __attribute__((ext_vector_type(4)));
typedef float f32x16 __attribute__((ext_vector_type(16)));
typedef unsigned u32x2 __attribute__((ext_vector_type(2)));
typedef unsigned u32x4 __attribute__((ext_vector_type(4)));
typedef int i32x4 __attribute__((ext_vector_type(4)));
typedef int i32x8 __attribute__((ext_vector_type(8)));

constexpr int DM = 2048, NBATCH = 4, SEQ = 2048, NLAYER = 4, MTOK = NBATCH * SEQ;
constexpr int DIN = 5120, ZK_OFF = 1024, ZV_OFF = 2048, ZC_OFF = 3072, ZRX_OFF = 4096, ZRG_OFF = 4608;
constexpr int CW = 512, RW = 512, NEXP = 16, DEXP = 1024, CK = 31;
constexpr float ALPHA = 1.6817928305074290f;
constexpr float LN_EPS = 1e-5f;
constexpr int NWAVES = 8, NTHREADS = 512;
constexpr int MOE_ROWS = 20480;
constexpr float W1_SCALE = 32.f, W2_SCALE = 64.f, H_SCALE = 4.f, WIN_SCALE = 32.f, WOUT_SCALE = 64.f, CAT_SCALE = 4.f, Y2_SCALE = 16.f;

constexpr size_t MiB = 1u << 20;
constexpr size_t WS_CTL = 0, CTL_ZERO_BYTES = 1 * MiB;
constexpr size_t WS_COS = 1 * MiB;
constexpr size_t WS_SIN = WS_COS + 512 * 1024;
constexpr size_t WS_SP8 = 2 * MiB;
constexpr size_t WS_TOKE = WS_SP8 + 64 * 1024;
constexpr size_t WS_TOKW = WS_TOKE + 64 * 1024;
constexpr size_t WS_TOKS = WS_TOKW + 64 * 1024;
constexpr size_t WS_SLOTW = WS_TOKS + 64 * 1024;
constexpr size_t WS_CNT = WS_SLOTW + 128 * 1024;
constexpr size_t WS_SUMA = 3 * MiB;
constexpr size_t WS_SUMH = WS_SUMA + 512 * 1024;
constexpr size_t WS_WIN = 8 * MiB;
constexpr size_t WS_WOUT = 88 * MiB;
constexpr size_t WS_PW = 120 * MiB;
constexpr size_t WS_WRG = 122 * MiB;
constexpr size_t WS_W1 = 128 * MiB;
constexpr size_t WS_W2 = 640 * MiB;
constexpr size_t WS_XA = 896 * MiB;
constexpr size_t WS_X1 = 960 * MiB;
constexpr size_t WS_XB = 1024 * MiB;
constexpr size_t WS_X1B = 1056 * MiB;
constexpr size_t WS_Z = 1088 * MiB;
constexpr size_t WS_OC = 1168 * MiB;
constexpr size_t WS_SCONV = 1232 * MiB;
constexpr size_t WS_XC = 1240 * MiB;
constexpr size_t WS_SA = 1248 * MiB;
constexpr size_t WS_SB = 1264 * MiB;
constexpr size_t WS_CAT = 1280 * MiB;
constexpr size_t WS_YBUF = 1312 * MiB;
constexpr size_t WS_XG = 1376 * MiB;
constexpr size_t WS_HB = 1456 * MiB;
constexpr size_t WS_Y2 = 1496 * MiB;
constexpr size_t WS_END = 1576 * MiB;
constexpr int CW_TMO = 0, CW_FLAG = 2048, CW_BAR = 4096, CW_FILL = 8192, CW_TICK = 9216; constexpr unsigned CTL_MAGIC = 0x51C0FFEEu;
constexpr int CW_TMO_ = 0;
constexpr size_t WS_LIST = 5 * MiB;
constexpr size_t WS_LISTW = 6 * MiB;
constexpr size_t WS_RWT = 7 * MiB;

constexpr int RING_BYTES = 131072;
constexpr int META_OFF = 132096;
constexpr int MISC_OFF = 132608;
constexpr int LDS_BYTES = 147456;

__device__ __forceinline__ unsigned cvt_pk_bf16(float lo, float hi) { unsigned r; asm volatile("v_cvt_pk_bf16_f32 %0, %1, %2" : "=v"(r) : "v"(lo), "v"(hi)); return r; }
__device__ __forceinline__ unsigned cvt4_fp8(float a, float b, float c, float d) {
    a = __builtin_amdgcn_fmed3f(a, -448.f, 448.f); b = __builtin_amdgcn_fmed3f(b, -448.f, 448.f); c = __builtin_amdgcn_fmed3f(c, -448.f, 448.f); d = __builtin_amdgcn_fmed3f(d, -448.f, 448.f);
    int w = 0; w = __builtin_amdgcn_cvt_pk_fp8_f32(a, b, w, false); w = __builtin_amdgcn_cvt_pk_fp8_f32(c, d, w, true); return (unsigned)w; }
__device__ __forceinline__ float bf2f(unsigned short b) { return __uint_as_float((unsigned)b << 16); }
__device__ __forceinline__ float bflo(unsigned w) { return __uint_as_float(w << 16); }
__device__ __forceinline__ float bfhi(unsigned w) { return __uint_as_float(w & 0xffff0000u); }
__device__ __forceinline__ float wave_sum(float v) {
#define WS_STEP(ctrl) v += __int_as_float(__builtin_amdgcn_update_dpp(0, __float_as_int(v), (ctrl), 0xf, 0xf, true))
    WS_STEP(0xB1); WS_STEP(0x4E); WS_STEP(0x124); WS_STEP(0x128);
#undef WS_STEP
    const auto r16 = __builtin_amdgcn_permlane16_swap(__float_as_uint(v), __float_as_uint(v), false, false);
    v = __uint_as_float(r16[0]) + __uint_as_float(r16[1]);
    const auto rr = __builtin_amdgcn_permlane32_swap(__float_as_uint(v), __float_as_uint(v), false, false);
    return __uint_as_float(rr[0]) + __uint_as_float(rr[1]);
}
__device__ __forceinline__ float sigmoidf_(float x) { return __builtin_amdgcn_rcpf(1.f + __expf(-x)); }
#define LDS_WAIT() asm volatile("s_waitcnt lgkmcnt(0)" ::: "memory")
constexpr int PTAB_OFF = 132736;
__device__ __forceinline__ const float* ldptr(LAS unsigned char* lds, int k) {
    int off = PTAB_OFF + 8 * k; asm volatile("" : "+s"(off));
    const unsigned long long v = *(volatile LAS unsigned long long*)(lds + off);
    const unsigned lo = __builtin_amdgcn_readfirstlane((unsigned)v), hi = __builtin_amdgcn_readfirstlane((unsigned)(v >> 32));
    return (const float*)(const GAS float*)(((unsigned long long)hi << 32) | lo);
}
template <class T> __device__ __forceinline__ T* opaque_p(T* p) { asm volatile("" : "+s"(p)); return p; }
__device__ __forceinline__ int tidx(int wid) { int l; asm volatile("v_mbcnt_lo_u32_b32 %0, -1, 0\n\tv_mbcnt_hi_u32_b32 %0, -1, %0" : "=v"(l)); return (wid << 6) + l; }
__device__ __forceinline__ int opaque_s(int v) { asm volatile("" : "+s"(v)); return v; }

#define XB_TMO      128
#define XB_XCNT(j)  (256  + 64 * (j))
#define XB_XSUB(j)  (1280 + 64 * (j))
#define XB_XGEN(j)  (2304 + 64 * (j))
#define XB_TOP      3328
#define XB_TOPGEN   3392
#define XCD_BAR_WORDS 3456
#define XB_SPIN_CAP (1u << 18)
__device__ __forceinline__ unsigned xb_ld(unsigned* p)              { return __hip_atomic_load(p, __ATOMIC_RELAXED, __HIP_MEMORY_SCOPE_AGENT); }
__device__ __forceinline__ unsigned xb_add(unsigned* p, unsigned v) { return __hip_atomic_fetch_add(p, v, __ATOMIC_RELAXED, __HIP_MEMORY_SCOPE_AGENT); }
__device__ __forceinline__ unsigned xb_xcc_id() { return (unsigned)__builtin_amdgcn_s_getreg((3 << 11) | 20) & 0xFu; }
#define XB_SPIN(cond, bar) do { unsigned _sp = 0; while (cond) { __builtin_amdgcn_s_sleep(1); \
    if ((++_sp & 255u) == 0u) { if (xb_ld(&(bar)[XB_TMO])) break; if (_sp > XB_SPIN_CAP) { atomicAdd(&(bar)[XB_TMO], 1u); break; } } } } while (0)
struct XcdBarrier { unsigned* bar; unsigned x; volatile LAS unsigned* st; };
__device__ __forceinline__ XcdBarrier xcd_barrier_post(unsigned* bar, volatile LAS unsigned* st) {
    XcdBarrier b; b.bar = bar; b.x = xb_xcc_id(); b.st = st;
    if (threadIdx.x == 0) (void)xb_add(&bar[XB_XCNT(b.x)], 1u);
    return b;
}
__device__ __forceinline__ void xcd_barrier_complete(unsigned* bar, unsigned x, unsigned& nloc, unsigned& nx) {
    const unsigned G = gridDim.x * gridDim.y * gridDim.z;
    asm volatile("" : "+s"(x));
    unsigned sum, cnt, mine, sp = 0u;
    for (;;) {
        sum = 0u; cnt = 0u; mine = 0u;
#pragma unroll
        for (unsigned j = 0; j < 16; ++j) { const unsigned c = xb_ld(&bar[XB_XCNT(j)]); sum += c; cnt += (c > 0u) ? 1u : 0u; mine = (j == x) ? c : mine; }
        if (sum == G) break;
        __builtin_amdgcn_s_sleep(1);
        if ((++sp & 255u) == 0u) { if (xb_ld(&bar[XB_TMO])) break; if (sp > XB_SPIN_CAP) { atomicAdd(&bar[XB_TMO], 1u); break; } }
    }
    nloc = mine > 0u ? mine : 1u; nx = cnt > 0u ? cnt : 1u;
}
__device__ __forceinline__ void xcd_barrier(const XcdBarrier& b, int wid0) {
    asm volatile("s_waitcnt vmcnt(0)" ::: "memory");
    __syncthreads();
    if (tidx(wid0) == 0) {
        unsigned* bar = opaque_p(b.bar);
        __builtin_amdgcn_s_waitcnt(0);
        unsigned nloc = b.st[0], nx = b.st[1];
        if (nloc == 0u) { xcd_barrier_complete(bar, b.x, nloc, nx); b.st[0] = nloc; b.st[1] = nx; }
        const unsigned old = xb_add(&bar[XB_XSUB(b.x)], 1u);
        const unsigned gen = old / nloc;
        if (old + 1u == (gen + 1u) * nloc) {
            __builtin_amdgcn_fence(__ATOMIC_RELEASE, "agent");
            asm volatile("s_waitcnt vmcnt(0)" ::: "memory");
            const unsigned og = xb_add(&bar[XB_TOP], 1u);
            const unsigned tg = og / nx;
            if (og + 1u == (tg + 1u) * nx) xb_add(&bar[XB_TOPGEN], 1u);
            else XB_SPIN(xb_ld(&bar[XB_TOPGEN]) == tg, bar);
            __builtin_amdgcn_fence(__ATOMIC_ACQUIRE, "agent");
            xb_add(&bar[XB_XGEN(b.x)], 1u);
            asm volatile("s_waitcnt vmcnt(0)" ::: "memory");
        } else {
            XB_SPIN(xb_ld(&bar[XB_XGEN(b.x)]) == gen, bar);
            __builtin_amdgcn_fence(__ATOMIC_ACQUIRE, "agent");
            asm volatile("s_waitcnt vmcnt(0)" ::: "memory");
        }
    }
    __syncthreads();
}

namespace pg8 {
constexpr int BM = 256, BK = 64, HALF = 128, HTB = HALF * BK * 2, STAGE_BYTES = 8 * HTB, NXCD = 8, WGM = 8;
__host__ __device__ __forceinline__ int lds_byte(int r, int c) { const int st = (r >> 4) * 2 + (c >> 5), rr = r & 15, cc = c & 31, ob = rr * 64 + cc * 2; return st * 1024 + (ob ^ (((ob >> 9) & 1) << 5)); }
__host__ __device__ __forceinline__ void stage_rc(int b, int& R, int& C) { const int st = b / 1024, sb = b % 1024, swz = sb ^ (((sb >> 9) & 1) << 5); R = (st >> 1) * 16 + swz / 64; C = (st & 1) * 32 + (swz % 64) / 2; }
__host__ __device__ __forceinline__ int perm32(int rho) { const int n = rho >> 4, i = rho & 15; return 8 * (i >> 2) + 4 * n + (i & 3); }

struct Unit { int pm, pn; unsigned aoff, boff; int pb, cnt, lb; };
struct Gemm { const unsigned char* base; unsigned A, Bt; int lda, ldb, K; };

struct GridOrder {
    int nM, nN, nwg, G, c; unsigned atile, btile;
    __device__ void init(int M, int N, int lda, int ldb, int G_, int c_) { nM = M / BM; nN = N / BM; nwg = nM * nN; G = G_; c = c_; atile = (unsigned)BM * lda * 2; btile = (unsigned)BM * ldb * 2; }
    __device__ bool next(int i, Unit& u) const {
        const long L = (long)i * G + c; if (L >= nwg) return false;
        int wgid = (int)L; { const int q = nwg / NXCD, r = nwg % NXCD, xcd = wgid % NXCD, off = wgid / NXCD; wgid = (xcd < r ? xcd * (q + 1) : r * (q + 1) + (xcd - r) * q) + off; }
        const int nig = WGM * nN, gid = wgid / nig, fm = gid * WGM, gsz = (nM - fm) < WGM ? (nM - fm) : WGM;
        u.pm = fm + ((wgid % nig) % gsz); u.pn = (wgid % nig) / gsz; u.aoff = (unsigned)u.pm * atile; u.boff = (unsigned)u.pn * btile; return true;
    }
    static constexpr bool GATHER = false;
    __device__ __forceinline__ unsigned arow(const Unit&, int) const { return 0u; }
    __device__ __forceinline__ void a_ready(const Unit&) const {}
    __device__ __forceinline__ void done(const Unit&) const {}
};

template <class Epi, class Sched, bool ALIGN_EPI, bool F8 = false, int COPY = 0>
__device__ __forceinline__ void gemm_phase(LAS unsigned char* lds, const Gemm g, const Sched& S, const Epi& E, int wid0) {
    const int tid = tidx(wid0), wid = __builtin_amdgcn_readfirstlane(tid >> 6), lane = tid & 63, wr = wid >> 2, wc = wid & 3, fr = lane & 15, fq = lane >> 4;
    const int K = g.K, nt = K / BK;
    unsigned vA0[2], vA1[2], nA0[2], nA1[2], voffB[2]; int Rr[2], Cc[2];
    const unsigned hsA_ = (unsigned)HALF * g.lda * 2;
#pragma unroll
    for (int i = 0; i < 2; ++i) { int R, C; stage_rc(tid * 16 + i * 8192, R, C); const int Rb = Epi::PERM ? ((R & ~31) + perm32(R & 31)) : R;
        Rr[i] = R; Cc[i] = C * 2; vA0[i] = (unsigned)(R * g.lda + C) * 2u; vA1[i] = vA0[i] + hsA_; voffB[i] = (unsigned)(Rb * g.ldb + C) * 2u; }
#define PG8_GATHER(d0, d1, U) do { _Pragma("unroll") for (int _i = 0; _i < 2; ++_i) { d0[_i] = S.arow(U, Rr[_i]) * (unsigned)(g.lda * 2) + (unsigned)Cc[_i]; d1[_i] = S.arow(U, Rr[_i] + HALF) * (unsigned)(g.lda * 2) + (unsigned)Cc[_i]; } } while (0)
    const unsigned kstep = (unsigned)(BK * 2);
    const unsigned hsB = (unsigned)HALF * g.ldb * 2;
    const __amdgpu_buffer_rsrc_t rs = __builtin_amdgcn_make_buffer_rsrc((void*)g.base, (short)0, 0x7fffffff, 0x00020000);
    const unsigned ldsw = (unsigned)wid * 1024u;
    const int aoff = lds_byte(wr * 64 + fr, fq * 8), boff = lds_byte(wc * 32 + fr, fq * 8);
#define PG8_SA(b, h) (((b) * 2 + (h)) * HTB)
#define PG8_SB(b, h) ((4 + (b) * 2 + (h)) * HTB)
#define PG8_STAGE(bufoff, soff, voff) do { _Pragma("unroll") for (int _i = 0; _i < 2; ++_i) \
        __builtin_amdgcn_raw_ptr_buffer_load_lds(rs, (LAS void*)(lds + (bufoff) + ldsw + _i * 8192), 16, (int)(voff)[_i], (int)(soff), 0, 0); } while (0)
#define PG8_LDA(dst, b, h) do { _Pragma("unroll") for (int m = 0; m < 4; ++m) { if constexpr (F8) { \
        dst##8[m].lo = *(const LAS i32x4*)(lds + PG8_SA(b, h) + aoff + m * 2048); dst##8[m].hi = *(const LAS i32x4*)(lds + PG8_SA(b, h) + aoff + m * 2048 + 1024); } else { \
        _Pragma("unroll") for (int k = 0; k < 2; ++k) dst[m][k] = *(const LAS bf16x8*)(lds + PG8_SA(b, h) + aoff + m * 2048 + k * 1024); } } } while (0)
#define PG8_LDB(dst, b, h) do { _Pragma("unroll") for (int n = 0; n < 2; ++n) { if constexpr (F8) { \
        dst##8[n].lo = *(const LAS i32x4*)(lds + PG8_SB(b, h) + boff + n * 2048); dst##8[n].hi = *(const LAS i32x4*)(lds + PG8_SB(b, h) + boff + n * 2048 + 1024); } else { \
        _Pragma("unroll") for (int k = 0; k < 2; ++k) dst[n][k] = *(const LAS bf16x8*)(lds + PG8_SB(b, h) + boff + n * 2048 + k * 1024); } } } while (0)
#define PG8_MMA(ai, bj, At, Bt) do { __builtin_amdgcn_s_setprio(1); _Pragma("unroll") for (int m = 0; m < 4; ++m) _Pragma("unroll") for (int n = 0; n < 2; ++n) _Pragma("unroll") for (int k = 0; k < 2; ++k) \
        acc[ai][bj][m][n] = __builtin_amdgcn_mfma_f32_16x16x32_bf16(Bt[n][k], At[m][k], acc[ai][bj][m][n], 0, 0, 0); __builtin_amdgcn_s_setprio(0); } while (0)
#define PG8_MMA8(ai, bj, At, Bt) do { __builtin_amdgcn_s_setprio(1); _Pragma("unroll") for (int m = 0; m < 4; ++m) _Pragma("unroll") for (int n = 0; n < 2; ++n) \
        asm volatile("v_mfma_f32_16x16x128_f8f6f4 %0, %1, %2, %0" : "+v"(acc[ai][bj][m][n]) : "v"(Bt##8[n]), "v"(At##8[m])); __builtin_amdgcn_s_setprio(0); } while (0)
#define PG8_MM(ai, bj, At, Bt) do { if constexpr (F8) PG8_MMA8(ai, bj, At, Bt); else PG8_MMA(ai, bj, At, Bt); } while (0)
#define PG8_WAIT_V(n) asm volatile("s_waitcnt vmcnt(" #n ")" ::: "memory")
#define PG8_WAIT_L(n) asm volatile("s_waitcnt lgkmcnt(" #n ")" ::: "memory")
#define PG8_BAR __builtin_amdgcn_s_barrier()
#define PG8_SCHED __builtin_amdgcn_sched_barrier(0)
    Unit cur, nxt; int ui = 0;
    if (!S.next(0, cur)) return;
    f32x4 acc[2][2][4][2];
#pragma unroll
    for (int a = 0; a < 2; ++a)
#pragma unroll
        for (int b = 0; b < 2; ++b)
#pragma unroll
            for (int m = 0; m < 4; ++m)
#pragma unroll
                for (int n = 0; n < 2; ++n) acc[a][b][m][n] = (f32x4){0.f, 0.f, 0.f, 0.f};
    bf16x8 At[4][2], B0[2][2], B1[2][2]; i32x8 At8[4], B08[2], B18[2];
    unsigned cA = g.A + cur.aoff, cB = g.Bt + cur.boff;
    S.a_ready(cur);
    if constexpr (Sched::GATHER) PG8_GATHER(vA0, vA1, cur);
    PG8_STAGE(PG8_SB(0, 0), cB, voffB); PG8_STAGE(PG8_SB(0, 1), cB + hsB, voffB); PG8_STAGE(PG8_SA(0, 0), cA, vA0); PG8_STAGE(PG8_SA(0, 1), cA, vA1);
    if (wr == 1) PG8_BAR;
    PG8_WAIT_V(2); PG8_BAR;
    PG8_STAGE(PG8_SB(1, 0), cB + kstep, voffB); PG8_STAGE(PG8_SA(1, 0), cA + kstep, vA0); PG8_STAGE(PG8_SB(1, 1), cB + hsB + kstep, voffB);
    PG8_WAIT_V(6); PG8_BAR;
    for (;;) {
        const bool has_next = S.next(ui + 1, nxt);
        const unsigned nA = has_next ? g.A + nxt.aoff : cA, nB = has_next ? g.Bt + nxt.boff : cB;
        if (Sched::GATHER && has_next) PG8_GATHER(nA0, nA1, nxt);
        else {
#pragma unroll
            for (int _i = 0; _i < 2; ++_i) { nA0[_i] = vA0[_i]; nA1[_i] = vA1[_i]; } }
        for (int t = 0; t < nt; t += 2) {
            const bool last = (t == nt - 2);
            const unsigned a1 = cA + (unsigned)(t + 1) * kstep;
            const unsigned a2 = last ? nA : cA + (unsigned)(t + 2) * kstep, b2 = last ? nB : cB + (unsigned)(t + 2) * kstep;
            const unsigned a3 = a2 + kstep, b3 = b2 + kstep;
            if (last && has_next) S.a_ready(nxt);
            const unsigned w0[2] = {last ? nA0[0] : vA0[0], last ? nA0[1] : vA0[1]}, w1[2] = {last ? nA1[0] : vA1[0], last ? nA1[1] : vA1[1]};
            PG8_LDB(B0, 0, 0); PG8_LDB(B1, 0, 1); PG8_SCHED; PG8_LDA(At, 0, 0); PG8_STAGE(PG8_SA(1, 1), a1, vA1);
            PG8_WAIT_V(8); PG8_WAIT_L(0); PG8_BAR; PG8_MM(0, 0, At, B0); PG8_MM(0, 1, At, B1); PG8_BAR; PG8_SCHED;
            PG8_LDA(At, 0, 1); PG8_STAGE(PG8_SB(0, 0), b2, voffB); PG8_STAGE(PG8_SB(0, 1), b2 + hsB, voffB); PG8_STAGE(PG8_SA(0, 0), a2, w0);
            PG8_WAIT_V(8); PG8_WAIT_L(0); PG8_BAR; PG8_MM(1, 0, At, B0); PG8_MM(1, 1, At, B1); PG8_BAR; PG8_SCHED;
            PG8_LDB(B0, 1, 0); PG8_LDB(B1, 1, 1); PG8_SCHED; PG8_LDA(At, 1, 0); PG8_STAGE(PG8_SA(0, 1), a2, w1);
            PG8_WAIT_V(8); PG8_WAIT_L(0); PG8_BAR; PG8_MM(0, 0, At, B0); PG8_MM(0, 1, At, B1); PG8_BAR; PG8_SCHED;
            PG8_LDA(At, 1, 1); PG8_STAGE(PG8_SB(1, 0), b3, voffB); PG8_STAGE(PG8_SB(1, 1), b3 + hsB, voffB); PG8_STAGE(PG8_SA(1, 0), a3, w0);
            PG8_WAIT_V(8); PG8_WAIT_L(0); PG8_BAR; PG8_MM(1, 0, At, B0); PG8_MM(1, 1, At, B1); PG8_BAR; PG8_SCHED;
        }
        if constexpr (ALIGN_EPI) { if (wr == 0) PG8_BAR; }
        if constexpr (F8) asm volatile("s_nop 15\n\ts_nop 15" ::: "memory");
        E(acc, cur, wr, wc, fr, fq); S.done(cur);
        if (!has_next) break;
#pragma unroll
        for (int a = 0; a < 2; ++a)
#pragma unroll
            for (int b = 0; b < 2; ++b)
#pragma unroll
                for (int m = 0; m < 4; ++m)
#pragma unroll
                    for (int n = 0; n < 2; ++n) acc[a][b][m][n] = (f32x4){0.f, 0.f, 0.f, 0.f};
        cur = nxt; cA = nA; cB = nB; ++ui;
#pragma unroll
        for (int _i = 0; _i < 2; ++_i) { vA0[_i] = nA0[_i]; vA1[_i] = nA1[_i]; }
        if constexpr (ALIGN_EPI) { if (wr == 1) PG8_BAR; }
    }
    PG8_WAIT_V(0);
    if constexpr (!ALIGN_EPI) { if (wr == 0) PG8_BAR; }
    PG8_BAR;
#undef PG8_SA
#undef PG8_SB
#undef PG8_STAGE
#undef PG8_GATHER
#undef PG8_LDA
#undef PG8_LDB
#undef PG8_MMA
#undef PG8_MMA8
#undef PG8_MM
#undef PG8_WAIT_V
#undef PG8_WAIT_L
#undef PG8_BAR
#undef PG8_SCHED
}
}

typedef const f32x4 (&AccRef)[2][2][4][2];

struct EpiZ {
    static constexpr bool PERM = true;
    bf16_t* Z; const float* cosT; const float* sinT;
    __device__ __forceinline__ void operator()(AccRef acc, const pg8::Unit& u, int wr, int wc, int fr, int fq) const {
        asm volatile("" : "+v"(fr), "+v"(fq));
        const int row0 = u.pm * 256 + wr * 64 + fr, col0 = u.pn * 256 + wc * 32 + 8 * fq;
        const bool rope = u.pn < 8;
#pragma unroll
        for (int ai = 0; ai < 2; ++ai)
#pragma unroll
            for (int m = 0; m < 4; ++m) {
                const int row = row0 + ai * 128 + m * 16, pos = row & (SEQ - 1);
                f32x4 cs = {1.f, 1.f, 1.f, 1.f}, sn = {0.f, 0.f, 0.f, 0.f};
                if (rope) { cs = *(const f32x4*)(cosT + pos * 64 + 16 * wc + 4 * fq); sn = *(const f32x4*)(sinT + pos * 64 + 16 * wc + 4 * fq); }
                bf16_t* rowp = Z + (size_t)row * DIN + col0;
#pragma unroll
                for (int bj = 0; bj < 2; ++bj) {
                    const f32x4 v0 = acc[ai][bj][m][0] * (1.f / WIN_SCALE), v1 = acc[ai][bj][m][1] * (1.f / WIN_SCALE);
                    u32x4 w;
                    w.x = cvt_pk_bf16(v0[0] * cs[0] - v0[1] * sn[0], v0[1] * cs[0] + v0[0] * sn[0]);
                    w.y = cvt_pk_bf16(v0[2] * cs[1] - v0[3] * sn[1], v0[3] * cs[1] + v0[2] * sn[1]);
                    w.z = cvt_pk_bf16(v1[0] * cs[2] - v1[1] * sn[2], v1[1] * cs[2] + v1[0] * sn[2]);
                    w.w = cvt_pk_bf16(v1[2] * cs[3] - v1[3] * sn[3], v1[3] * cs[3] + v1[2] * sn[3]);
                    *(u32x4*)(rowp + bj * 128) = w;
                }
            }
    }
};
struct EpiBf16Off {
    static constexpr bool PERM = true;
    unsigned char* O; int ldc, coloff;
    __device__ __forceinline__ void operator()(AccRef acc, const pg8::Unit& u, int wr, int wc, int fr, int fq) const {
        const int row0 = u.pm * 256 + wr * 64 + fr, col0 = coloff + u.pn * 256 + wc * 32 + 8 * fq;
#pragma unroll
        for (int ai = 0; ai < 2; ++ai)
#pragma unroll
            for (int m = 0; m < 4; ++m) { unsigned char* rowp = O + (size_t)(row0 + ai * 128 + m * 16) * ldc + col0;
#pragma unroll
                for (int bj = 0; bj < 2; ++bj) { const f32x4 v0 = acc[ai][bj][m][0] * CAT_SCALE, v1 = acc[ai][bj][m][1] * CAT_SCALE;
                    u32x2 w; w.x = cvt4_fp8(v0[0], v0[1], v0[2], v0[3]); w.y = cvt4_fp8(v1[0], v1[1], v1[2], v1[3]);
                    *(u32x2*)(rowp + bj * 128) = w; } }
    }
};
struct EpiResBf16 {
    static constexpr bool PERM = true;
    bf16_t* C; const bf16_t* res;
    __device__ __forceinline__ void operator()(AccRef acc, const pg8::Unit& u, int wr, int wc, int fr, int fq) const {
        const int row0 = u.pm * 256 + wr * 64 + fr, col0 = u.pn * 256 + wc * 32 + 8 * fq;
#pragma unroll
        for (int ai = 0; ai < 2; ++ai)
#pragma unroll
            for (int m = 0; m < 4; ++m) { const size_t ro = (size_t)(row0 + ai * 128 + m * 16) * DM + col0;
#pragma unroll
                for (int bj = 0; bj < 2; ++bj) { const u32x4 r = *(const u32x4*)(res + ro + bj * 128);
                    const f32x4 v0 = acc[ai][bj][m][0] * (1.f / (CAT_SCALE * WOUT_SCALE)), v1 = acc[ai][bj][m][1] * (1.f / (CAT_SCALE * WOUT_SCALE));
                    u32x4 w;
                    w.x = cvt_pk_bf16(v0[0] + ALPHA * bflo(r.x), v0[1] + ALPHA * bfhi(r.x)); w.y = cvt_pk_bf16(v0[2] + ALPHA * bflo(r.y), v0[3] + ALPHA * bfhi(r.y));
                    w.z = cvt_pk_bf16(v1[0] + ALPHA * bflo(r.z), v1[1] + ALPHA * bfhi(r.z)); w.w = cvt_pk_bf16(v1[2] + ALPHA * bflo(r.w), v1[3] + ALPHA * bfhi(r.w));
                    *(u32x4*)(C + ro + bj * 128) = w; } }
    }
};
__device__ __forceinline__ float dpp_shr(float v, float oldv, int d) {
    const int o = __float_as_int(oldv), x = __float_as_int(v);
    return __int_as_float(d == 1 ? __builtin_amdgcn_update_dpp(o, x, 0x111, 0xf, 0xf, false) : d == 2 ? __builtin_amdgcn_update_dpp(o, x, 0x112, 0xf, 0xf, false)
                        : d == 4 ? __builtin_amdgcn_update_dpp(o, x, 0x114, 0xf, 0xf, false) : __builtin_amdgcn_update_dpp(o, x, 0x118, 0xf, 0xf, false));
}
struct EpiGate {
    static constexpr bool PERM = false;
    float* SA; float* SB; const bf16_t* XC; const float* ba; const float* bx; const float* sp8; float* sumA; float* sumH;
    __device__ __forceinline__ void operator()(AccRef acc, const pg8::Unit& u, int wr, int wc, int fr, int fq) const {
        const int row0 = u.pm * 256 + wr * 64 + fr, ch0 = u.pn * 128 + wc * 32 + 4 * fq;
        const int l15 = (fq * 16 + 15) * 4;
#pragma unroll
        for (int n = 0; n < 2; ++n) {
            const int ch = ch0 + 16 * n;
            const f32x4 vba = *(const f32x4*)(ba + ch), vbx = *(const f32x4*)(bx + ch), vsp = *(const f32x4*)(sp8 + ch);
#pragma unroll
            for (int ai = 0; ai < 2; ++ai)
#pragma unroll
                for (int mp = 0; mp < 2; ++mp) {
                    float A[8], B[8];
#pragma unroll
                    for (int sg = 0; sg < 2; ++sg) { const int m = 2 * mp + sg;
                        const size_t ro = (size_t)(row0 + ai * 128 + m * 16) * RW + ch;
                        const u32x2 xw = *(const u32x2*)(XC + ro);
                        const float xc[4] = {bflo(xw.x), bfhi(xw.x), bflo(xw.y), bfhi(xw.y)};
                        const f32x4 ar = acc[ai][0][m][n], ain = acc[ai][1][m][n];
#pragma unroll
                        for (int q = 0; q < 4; ++q) {
                            const float r = sigmoidf_(ar[q] + vba[q]), ig = sigmoidf_(ain[q] + vbx[q]);
                            const float la = -r * vsp[q];
                            const float a = __expf(la);
                            A[sg * 4 + q] = a; B[sg * 4 + q] = __builtin_amdgcn_sqrtf((1.f - a) * (1.f + a)) * (ig * xc[q]);
                        }
                    }
#define GS_F(i, j, D) "v_fmac_f32_dpp %" #j ", %" #j ", %" #i " row_shr:" #D " row_mask:0xf bank_mask:0xf\n\t"
#define GS_M(i, D) "v_mul_f32_dpp %" #i ", %" #i ", %" #i " row_shr:" #D " row_mask:0xf bank_mask:0xf\n\t"
#define GATE_SCAN_STEP(D) asm volatile("s_nop 1\n\t" GS_F(0, 8, D) GS_F(1, 9, D) GS_F(2, 10, D) GS_F(3, 11, D) GS_F(4, 12, D) GS_F(5, 13, D) GS_F(6, 14, D) GS_F(7, 15, D) \
                        GS_M(0, D) GS_M(1, D) GS_M(2, D) GS_M(3, D) GS_M(4, D) GS_M(5, D) GS_M(6, D) GS_M(7, D) \
                        : "+v"(A[0]), "+v"(A[1]), "+v"(A[2]), "+v"(A[3]), "+v"(A[4]), "+v"(A[5]), "+v"(A[6]), "+v"(A[7]), \
                          "+v"(B[0]), "+v"(B[1]), "+v"(B[2]), "+v"(B[3]), "+v"(B[4]), "+v"(B[5]), "+v"(B[6]), "+v"(B[7]))
                    GATE_SCAN_STEP(1); GATE_SCAN_STEP(2); GATE_SCAN_STEP(4); GATE_SCAN_STEP(8);
#undef GATE_SCAN_STEP
#undef GS_M
#undef GS_F
#pragma unroll
                    for (int q = 0; q < 4; ++q) {
                        const float A1 = __int_as_float(__builtin_amdgcn_ds_bpermute(l15, __float_as_int(A[q]))), H1 = __int_as_float(__builtin_amdgcn_ds_bpermute(l15, __float_as_int(B[q])));
                        B[4 + q] = fmaf(A[4 + q], H1, B[4 + q]); A[4 + q] *= A1; }
#pragma unroll
                    for (int sg = 0; sg < 2; ++sg) { const size_t ro = (size_t)(row0 + ai * 128 + (2 * mp + sg) * 16) * RW + ch;
                        *(f32x4*)(SA + ro) = (f32x4){A[sg * 4], A[sg * 4 + 1], A[sg * 4 + 2], A[sg * 4 + 3]}; *(f32x4*)(SB + ro) = (f32x4){B[sg * 4], B[sg * 4 + 1], B[sg * 4 + 2], B[sg * 4 + 3]}; }
                    if (fr == 15) { const size_t so = (size_t)(u.pm * 8 + ai * 4 + wr * 2 + mp) * RW + ch;
                        *(f32x4*)(sumA + so) = (f32x4){A[4], A[5], A[6], A[7]}; *(f32x4*)(sumH + so) = (f32x4){B[4], B[5], B[6], B[7]}; }
                    asm volatile("" ::: "memory");
                }
        }
    }
};
struct EpiSwiGLU {
    static constexpr bool PERM = true;
    unsigned char* H;
    __device__ __forceinline__ void operator()(AccRef acc, const pg8::Unit& u, int wr, int wc, int fr, int fq) const {
        const int row0 = u.pm * 256 + wr * 64 + fr, j0 = (u.pn * 256 + wc * 32 + 8 * fq) >> 1;
        constexpr float ds = 1.f / W1_SCALE;
#pragma unroll
        for (int ai = 0; ai < 2; ++ai)
#pragma unroll
            for (int m = 0; m < 4; ++m) { unsigned char* rowp = H + (size_t)(row0 + ai * 128 + m * 16) * DEXP + j0;
#pragma unroll
                for (int bj = 0; bj < 2; ++bj) { const f32x4 v0 = acc[ai][bj][m][0] * ds, v1 = acc[ai][bj][m][1] * ds;
                    const float h0 = v0[0] * sigmoidf_(v0[0]) * v0[1], h1 = v0[2] * sigmoidf_(v0[2]) * v0[3];
                    const float h2 = v1[0] * sigmoidf_(v1[0]) * v1[1], h3 = v1[2] * sigmoidf_(v1[2]) * v1[3];
                    *(unsigned*)(rowp + bj * 64) = cvt4_fp8(h0 * H_SCALE, h1 * H_SCALE, h2 * H_SCALE, h3 * H_SCALE); } }
    }
};
struct EpiScaleBf16 {
    static constexpr bool PERM = true;
    unsigned char* O; const float* sw;
    __device__ __forceinline__ void operator()(AccRef acc, const pg8::Unit& u, int wr, int wc, int fr, int fq) const {
        const int row0 = u.pm * 256 + wr * 64 + fr, col0 = u.pn * 256 + wc * 32 + 8 * fq;
#pragma unroll
        for (int ai = 0; ai < 2; ++ai)
#pragma unroll
            for (int m = 0; m < 4; ++m) { const int row = row0 + ai * 128 + m * 16; const float s = sw[u.lb + u.pb - u.pm * 256 + row] * (Y2_SCALE / (H_SCALE * W2_SCALE)); unsigned char* rowp = O + (size_t)row * DM + col0;
#pragma unroll
                for (int bj = 0; bj < 2; ++bj) { const f32x4 v0 = acc[ai][bj][m][0] * s, v1 = acc[ai][bj][m][1] * s;
                    u32x2 w; w.x = cvt4_fp8(v0[0], v0[1], v0[2], v0[3]); w.y = cvt4_fp8(v1[0], v1[1], v1[2], v1[3]);
                    *(u32x2*)(rowp + bj * 128) = w; } }
    }
};
struct RgOrder {
    static constexpr bool GATHER = false;
    __device__ __forceinline__ unsigned arow(const pg8::Unit&, int) const { return 0u; }
    int G, c;
    __device__ bool next(int i, pg8::Unit& u) const {
        const int L = i * G + c; if (L >= 128) return false;
        u.pm = L >> 2; u.pn = L & 3; u.aoff = ((unsigned)u.pm * 256 * RW + (unsigned)u.pn * 128) * 2; u.boff = (unsigned)u.pn * 256 * 128 * 2; return true;
    }
    __device__ __forceinline__ void a_ready(const pg8::Unit&) const {}
    __device__ __forceinline__ void done(const pg8::Unit&) const {}
};
template <bool GATHER_>
struct MoeOrder {
    static constexpr bool GATHER = GATHER_;
    int Gp, c, lo, hi, lda, ldb; const volatile LAS int* meta; unsigned estride; bool xcdmap; const int* list; int xr = 0;
    __device__ bool next(int i, pg8::Unit& u) const {
        int L = lo + i * Gp + c;
        if (xr > 0) { if (i >= xr) return false; const int n = Gp >> 3; L = lo + ((c & 7) * xr + i) * n + (c >> 3); }
        if (c < 0 || L >= hi) return false;
        if (xcdmap) {
            const int x = c & 7, r = c >> 3; L = (((i * 8 + x) * 4 + (r >> 3)) << 3) | (r & 7); }
        u.pm = L >> 3; u.pn = L & 7; const int e = __builtin_amdgcn_readfirstlane(meta[48 + u.pm]);
        u.cnt = __builtin_amdgcn_readfirstlane(meta[e]); u.pb = u.pm * 256 - __builtin_amdgcn_readfirstlane(meta[16 + e]); u.lb = e * MTOK;
        u.aoff = GATHER_ ? 0u : (unsigned)u.pm * 256 * lda * 2; u.boff = (unsigned)e * estride + (unsigned)u.pn * 256 * ldb * 2; return true;
    }
    __device__ __forceinline__ unsigned arow(const pg8::Unit& u, int r) const { const int p = u.pb + r; return (p < u.cnt) ? (unsigned)list[u.lb + p] : 0u; }
    __device__ __forceinline__ void a_ready(const pg8::Unit&) const {}
    __device__ __forceinline__ void done(const pg8::Unit&) const {}
};

namespace att {
constexpr int D = 128, PQ = DIN, PO = 1024;
constexpr float SCALE = 0.08838834764831845f;
constexpr float THR = 8.f;
constexpr int NW = 8, QBLK = 32, KVBLK = 64, QB = NW * QBLK;
constexpr int SHM_V = KVBLK * D * 2, SHM_K = KVBLK * D * 2;
constexpr int LDS_ATT = 2 * SHM_V + 2 * SHM_K + NW * 64 * 4;
#define KSWZ(row, colB) ((row) * 256 + ((colB) ^ (((row) & 7) << 4)))
#define SBAR() __builtin_amdgcn_sched_barrier(0)
__device__ __forceinline__ int v_st(int k, int c) { const int kk = (k & ~0xC) | ((k & 4) << 1) | ((k & 8) >> 1); return ((kk >> 3) * 4 + (c >> 5)) * 512 + ((kk & 7) * 32 + (c & 31)) * 2; }
__device__ __forceinline__ int v_rd_base(int lane) { return ((lane & 3) << 3) | (((lane >> 2) & 3) << 6) | (((lane >> 4) & 1) << 5) | (((lane >> 5) & 1) << 8); }
constexpr int v_rd_off(int d0, int ks, int half) { return d0 * 512 + ks * 4096 + half * 2048; }
__device__ __forceinline__ int crow(int r, int hi) { return (r & 3) + 8 * (r >> 2) + 4 * hi; }
__device__ __forceinline__ unsigned cvtpk(float lo, float hi) { unsigned r; asm volatile("v_cvt_pk_bf16_f32 %0, %1, %2" : "=v"(r) : "v"(lo), "v"(hi)); return r; }
__device__ __forceinline__ bf16x8 load8(const bf16_t* p) { return *reinterpret_cast<const bf16x8*>(p); }
__device__ __forceinline__ void mask_tile(f32x16& p0, f32x16& p1, int dq, unsigned W) {
    const float NEG = -__builtin_inff();
#pragma unroll
    for (int r = 0; r < 16; ++r) {
        const int c = (r & 3) + 8 * (r >> 2);
        if ((unsigned)(dq - c) >= W) p0[r] = NEG;
        if ((unsigned)(dq - c - 32) >= W) p1[r] = NEG;
    }
}
__device__ __forceinline__ void partialSM(f32x16& p0, f32x16& p1, float& m_reg, float& mn, float& alpha) {
    float pmax = p0[0]; for (int r = 1; r < 16; ++r) pmax = fmaxf(pmax, p0[r]); for (int r = 0; r < 16; ++r) pmax = fmaxf(pmax, p1[r]);
    { auto rr = __builtin_amdgcn_permlane32_swap(__float_as_uint(pmax), __float_as_uint(pmax), false, false);
      pmax = fmaxf(__uint_as_float(rr[0]), __uint_as_float(rr[1])); }
    constexpr float C2 = 1.4426950408889634f * SCALE;
    if (__builtin_expect(__all((pmax - m_reg) * SCALE <= THR), 1)) { mn = m_reg; alpha = 1.f; }
    else { mn = fmaxf(m_reg, pmax); alpha = __builtin_amdgcn_exp2f((m_reg - mn) * C2); m_reg = mn; }
    const float mnL = -mn * C2;
    for (int r = 0; r < 16; ++r) p0[r] = fmaf(p0[r], C2, mnL); for (int r = 0; r < 16; ++r) p1[r] = fmaf(p1[r], C2, mnL);
    for (int r = 0; r < 16; ++r) p0[r] = __builtin_amdgcn_exp2f(p0[r]);
}
__device__ __forceinline__ void finishSM(f32x16& p0, f32x16& p1, float alpha, float& l_reg, bf16x8& pa0, bf16x8& pa1, bf16x8& pa2, bf16x8& pa3) {
    for (int r = 0; r < 16; ++r) p1[r] = __builtin_amdgcn_exp2f(p1[r]);
    float ps = 0; for (int r = 0; r < 16; ++r) ps += p0[r]; for (int r = 0; r < 16; ++r) ps += p1[r];
    { auto rr = __builtin_amdgcn_permlane32_swap(__float_as_uint(ps), __float_as_uint(ps), false, false);
      ps = __uint_as_float(rr[0]) + __uint_as_float(rr[1]); }
    l_reg = l_reg * alpha + ps;
#define PK4(P, B_, OUT) do { unsigned a0 = cvtpk(P[B_+0], P[B_+1]), a1 = cvtpk(P[B_+2], P[B_+3]);                          \
        unsigned b0 = cvtpk(P[B_+4], P[B_+5]), b1 = cvtpk(P[B_+6], P[B_+7]);                                             \
        auto r0 = __builtin_amdgcn_permlane32_swap(a0, b0, false, false); auto r1 = __builtin_amdgcn_permlane32_swap(a1, b1, false, false); \
        u32x4 w = {r0[0], r1[0], r0[1], r1[1]}; OUT = *reinterpret_cast<bf16x8*>(&w); } while (0)
    PK4(p0, 0, pa0); PK4(p0, 8, pa1); PK4(p1, 0, pa2); PK4(p1, 8, pa3);
#undef PK4
}
template <int KB>
__device__ __forceinline__ void qkt(f32x16& p0, f32x16& p1, const char* K_lds, int r32, int hi, const bf16x8* qr) {
    p0 = f32x16{}; p1 = f32x16{};
    const char* kb[4];
#pragma unroll
    for (int dd = 0; dd < 4; ++dd) kb[dd] = K_lds + KB * SHM_K + KSWZ(r32, (dd * 16 + hi * 8) * 2);
#pragma unroll
    for (int d0 = 0; d0 < 8; ++d0) { const char* a = kb[d0 & 3] + (d0 >> 2) * 128;
        bf16x8 b0 = *reinterpret_cast<const bf16x8*>(a);
        bf16x8 b1 = *reinterpret_cast<const bf16x8*>(a + 32 * 256);
        p0 = __builtin_amdgcn_mfma_f32_32x32x16_bf16(b0, qr[d0], p0, 0, 0, 0);
        p1 = __builtin_amdgcn_mfma_f32_32x32x16_bf16(b1, qr[d0], p1, 0, 0, 0); }
}
template <int VB>
__device__ __forceinline__ void pv_tile(f32x16* o, int vb0, bf16x8 pa0, bf16x8 pa1, bf16x8 pa2, bf16x8 pa3) {
#define TRRD(dst, off) asm volatile("ds_read_b64_tr_b16 %0, %1 offset:%2" : "=&v"(dst) : "v"(vb0), "i"(off) : "memory")
#define PV_D0(d0) do { s16x4 l0, l1, l2, l3, h0, h1, h2, h3; constexpr int b_ = VB * SHM_V + v_rd_off(d0, 0, 0); \
        TRRD(l0, b_); TRRD(h0, b_ + 2048); TRRD(l1, b_ + 4096); TRRD(h1, b_ + 6144); TRRD(l2, b_ + 8192); TRRD(h2, b_ + 10240); TRRD(l3, b_ + 12288); TRRD(h3, b_ + 14336); \
        asm volatile("s_waitcnt lgkmcnt(0)" ::: "memory"); SBAR();   \
        o[d0] = __builtin_amdgcn_mfma_f32_32x32x16_bf16(pa0, (bf16x8){l0[0], l0[1], l0[2], l0[3], h0[0], h0[1], h0[2], h0[3]}, o[d0], 0, 0, 0);   \
        o[d0] = __builtin_amdgcn_mfma_f32_32x32x16_bf16(pa1, (bf16x8){l1[0], l1[1], l1[2], l1[3], h1[0], h1[1], h1[2], h1[3]}, o[d0], 0, 0, 0);   \
        o[d0] = __builtin_amdgcn_mfma_f32_32x32x16_bf16(pa2, (bf16x8){l2[0], l2[1], l2[2], l2[3], h2[0], h2[1], h2[2], h2[3]}, o[d0], 0, 0, 0);   \
        o[d0] = __builtin_amdgcn_mfma_f32_32x32x16_bf16(pa3, (bf16x8){l3[0], l3[1], l3[2], l3[3], h3[0], h3[1], h3[2], h3[3]}, o[d0], 0, 0, 0); } while (0)
    PV_D0(0); PV_D0(1); PV_D0(2); PV_D0(3);
#undef PV_D0
#undef TRRD
}
struct BlockRef { const bf16_t* Q; const bf16_t* K; const bf16_t* V; bf16_t* O; int P0; };
struct Seam { bf16x8 qr[8]; bf16x8 st_v0, st_v1, st_k0, st_k1; };
#define ROW(p, k0, rr) ((p) + (size_t)((k0) + (rr)) * PQ + sc)
#define VMW() asm volatile("s_waitcnt vmcnt(0)" ::: "memory")
#define VMWN(n) asm volatile("s_waitcnt vmcnt(%0)" :: "i"(n) : "memory")
#define SLOAD_H(Kp, Vp, k0) do { S.st_v0 = load8(ROW(Vp, k0, sr)); S.st_v1 = load8(ROW(Vp, k0, 32 + sr));              \
                         S.st_k0 = load8(ROW(Kp, k0, sr)); S.st_k1 = load8(ROW(Kp, k0, 32 + sr)); } while (0)
#define SWRITE_HK(bf) do { *(bf16x8*)(K_lds + (bf) * SHM_K + kws) = S.st_k0; *(bf16x8*)(K_lds + (bf) * SHM_K + kws + 32 * 256) = S.st_k1; } while (0)
#define SWRITE_HV(bf) do { *(bf16x8*)(V_lds + (bf) * SHM_V + vst0) = S.st_v0; *(bf16x8*)(V_lds + (bf) * SHM_V + vst1) = S.st_v1; } while (0)
#define SWRITE_H(bf) do { SWRITE_HV(bf); SWRITE_HK(bf); } while (0)
__device__ __forceinline__ void causal_prime(const BlockRef& cur, char* lds, Seam& S, int wid0) {
    const int tid = tidx(wid0), wid = __builtin_amdgcn_readfirstlane(tid >> 6), lane = tid & 63, r32 = lane & 31, hi = lane >> 5;
    const int sr = tid >> 4, sc = (tid & 15) * 8, kws = KSWZ(sr, sc * 2); char* K_lds = lds + 2 * SHM_V;
    const int kb0 = 0;
    for (int d0 = 0; d0 < 8; ++d0) S.qr[d0] = load8(cur.Q + (size_t)(wid * QBLK + r32) * PQ + d0 * 16 + hi * 8);
    SLOAD_H(cur.K, cur.V, kb0); VMW(); SWRITE_HK(0);
    __syncthreads();
}
__device__ __forceinline__ void causal_block(const BlockRef& cur, const BlockRef& nxt, char* lds, Seam& S, int wid0) {
    const int tid = tidx(wid0), wid = __builtin_amdgcn_readfirstlane(tid >> 6), lane = tid & 63, r32 = lane & 31, hi = lane >> 5;
    const int W = 1 << 30;
    const int j_lo = 0;
    const int j_hi = (cur.P0 + QB - 1) / KVBLK + 1;
    const int NT = j_hi - j_lo;
    const int kbn = 0;
    const int qlo = cur.P0 + wid * QBLK, qm = qlo + r32 - 4 * hi;
    char* V_lds = lds; char* K_lds = lds + 2 * SHM_V;
    float* ws = (float*)(lds + 2 * SHM_V + 2 * SHM_K) + wid * 64; float* li_l = ws, * al_l = ws + 32;
    float m_reg = -1e30f, l_reg = 0; f32x16 o[4] = {};
    const int sr = tid >> 4, sc = (tid & 15) * 8, vst0 = v_st(sr, sc), vst1 = v_st(32 + sr, sc), kws = KSWZ(sr, sc * 2);
    const int vb0 = (int)(uintptr_t)V_lds + v_rd_base(lane);
    const bf16_t* Kh = cur.K; const bf16_t* Vh = cur.V;
#define RESC(a) do { if (__any((a) < 1.f)) { if (hi == 0) al_l[r32] = (a); asm volatile("s_waitcnt lgkmcnt(0)" ::: "memory");              \
                     for (int d_ = 0; d_ < 4; ++d_) for (int r = 0; r < 16; ++r) o[d_][r] *= al_l[crow(r, hi)]; } } while (0)
#define KBASE(t) ((j_lo + (t)) * KVBLK)
#define MASKT(P0_, P1_, t) do { const int kb_ = KBASE(t); if (kb_ + KVBLK - 1 > qlo) mask_tile(P0_, P1_, qm - kb_, (unsigned)W); } while (0)
    constexpr int NQL = 8;
#define SEAM_K0() do { VMWN(NQL); SWRITE_HK(0); SBAR(); } while (0)
    f32x16 pA0, pA1, pB0, pB1; float mnA, mnB, alA, alB; bf16x8 pa0, pa1, pa2, pa3;
    SWRITE_HV(0); SBAR();
    if (NT > 1) { SLOAD_H(Kh, Vh, KBASE(1)); }
    SBAR(); qkt<0>(pA0, pA1, K_lds, r32, hi, S.qr);
    MASKT(pA0, pA1, 0); partialSM(pA0, pA1, m_reg, mnA, alA);
    if (NT > 1) { VMW(); SWRITE_H(1); }
    __syncthreads();
#define HALF_STEP(PX0, PX1, mnX, alX, PY0, PY1, alY, t, KB, VB, SB) do {                                                      \
        SBAR(); qkt<KB>(PX0, PX1, K_lds, r32, hi, S.qr);                                                         \
        finishSM(PY0, PY1, alY, l_reg, pa0, pa1, pa2, pa3); SBAR();                                                           \
        if ((t) + 1 < NT) { SLOAD_H(Kh, Vh, KBASE((t) + 1)); SBAR(); }                                                        \
        pv_tile<VB>(o, vb0, pa0, pa1, pa2, pa3); MASKT(PX0, PX1, (t)); partialSM(PX0, PX1, m_reg, mnX, alX);                  \
        __syncthreads();                                                                                                      \
        if ((t) + 1 < NT) { VMW(); SWRITE_H(SB); }                                                                            \
        RESC(alX); __syncthreads(); } while (0)
    for (int t = 1; t + 1 < NT; t += 2) {
        HALF_STEP(pB0, pB1, mnB, alB, pA0, pA1, alA, t, 1, 0, 0);
        HALF_STEP(pA0, pA1, mnA, alA, pB0, pB1, alB, t + 1, 0, 1, 1);
    }
    const bool even = (NT & 1) == 0;
    if (even) { SBAR(); qkt<1>(pB0, pB1, K_lds, r32, hi, S.qr); SBAR(); }
    SLOAD_H(nxt.K, nxt.V, kbn); SBAR();
#pragma unroll
    for (int d0 = 0; d0 < 8; ++d0) S.qr[d0] = load8(nxt.Q + (size_t)(wid * QBLK + r32) * PQ + d0 * 16 + hi * 8);
    SBAR();
    finishSM(pA0, pA1, alA, l_reg, pa0, pa1, pa2, pa3); SBAR();
    pv_tile<0>(o, vb0, pa0, pa1, pa2, pa3);
    if (even) { MASKT(pB0, pB1, NT - 1); partialSM(pB0, pB1, m_reg, mnB, alB); __syncthreads(); RESC(alB);
        finishSM(pB0, pB1, alB, l_reg, pa0, pa1, pa2, pa3); SBAR(); pv_tile<1>(o, vb0, pa0, pa1, pa2, pa3); }
    SBAR(); SEAM_K0();
    if (hi == 0) li_l[r32] = l_reg; asm volatile("s_waitcnt lgkmcnt(0)" ::: "memory");
    float rli[16];
#pragma unroll
    for (int r = 0; r < 16; ++r) rli[r] = __builtin_amdgcn_rcpf(li_l[crow(r, hi)]);
    bf16_t* Ow = cur.O + (size_t)(wid * QBLK) * PO;
#pragma unroll
    for (int r = 0; r < 16; ++r) { const int orow = crow(r, hi);
#pragma unroll
        for (int d0 = 0; d0 < 4; ++d0) { const float v = o[d0][r] * rli[r];
            const float vn = __int_as_float(__builtin_amdgcn_mov_dpp(__float_as_int(v), 0xB1, 0xf, 0xf, true));
            if ((r32 & 1) == 0) *(unsigned*)(Ow + (size_t)orow * PO + d0 * 32 + r32) = cvtpk(v, vn); } }
    __syncthreads();
#undef RESC
#undef KBASE
#undef MASKT
#undef SEAM_K0
#undef HALF_STEP
}
#undef ROW
#undef VMW
#undef VMWN
#undef SLOAD_H
#undef SWRITE_HK
#undef SWRITE_HV
#undef SWRITE_H
__device__ __forceinline__ BlockRef make_ref(int L, int pass, const bf16_t* Z, bf16_t* OC) {
    const int bh = L >> 2, x = L & 3, b = bh >> 4, vh = bh & 15, h = vh >> 2, c = (vh >> 1) & 1, vhalf = vh & 1;
    const int qb = pass ? 7 - x : x;
    const size_t row0 = (size_t)b * SEQ;
    BlockRef r;
    r.Q = Z + (row0 + (size_t)qb * QB) * PQ + h * 256 + c * 128;
    r.K = Z + row0 * PQ + ZK_OFF + h * 256 + c * 128;
    r.V = Z + row0 * PQ + ZV_OFF + h * 256 + vhalf * 128;
    r.O = OC + (size_t)c * MTOK * PO + (row0 + (size_t)qb * QB) * PO + h * 256 + vhalf * 128;
    r.P0 = qb * QB;
    return r;
}
__device__ __forceinline__ void attn_phase(char* lds, const bf16_t* Z, bf16_t* OC, int G, int c0, int wid0) {
    constexpr int total = 256;
    int L = c0; if (L >= total) return;
    int pass = 0;
    BlockRef cur = make_ref(L, 0, Z, OC);
    Seam S;
    causal_prime(cur, lds, S, wid0);
    for (;;) {
        const bool more_pass = pass == 0, more_item = L + G < total, last = !more_pass && !more_item;
        int passn = pass + 1, Ln = L;
        if (!more_pass) { passn = 0; Ln = more_item ? L + G : L; }
        const BlockRef nxt = last ? cur : make_ref(Ln, passn, Z, OC);
        causal_block(cur, nxt, lds, S, wid0);
        if (last) break;
        cur = nxt; pass = passn; L = Ln;
    }
}
}

#define AIN(k) ldptr(lds, (k))
struct Args { const float* in[28]; float* out; unsigned char* ws; int ph_lo, ph_hi; };
enum { I_X = 0, I_WIN, I_LQ1, I_LK1, I_LQ2, I_LK2, I_SUBLN, I_CDW, I_CLNG, I_CLNB, I_CPW, I_RCW, I_RCB, I_RWA, I_RBA, I_RWX, I_RBX, I_RLAM, I_WOUT,
       I_LN1G, I_LN1B, I_RTW, I_RTB, I_EWG, I_EWU, I_EWD, I_LN2G, I_LN2B };
constexpr int NPH = 12;
constexpr int NPHASES = 1 + NLAYER * NPH;

template <bool F8>
__device__ __forceinline__ void cvt_tile(const float* src, int ld, unsigned char* dst, int dpitch, float scale, LAS unsigned char* scr, int lane) {
    constexpr int NB = F8 ? 4 : 2;
    float va[32], vb[32];
#define CT_LOAD(v, b) do { _Pragma("unroll") for (int r = 0; r < 32; ++r) v[r] = src[(size_t)((b) * 32 + r) * ld]; } while (0)
#define CT_CONV(v, b) do { if constexpr (F8) { _Pragma("unroll") for (int i = 0; i < 4; ++i) { u32x2 w; \
            w.x = cvt4_fp8(v[8 * i + 0] * scale, v[8 * i + 1] * scale, v[8 * i + 2] * scale, v[8 * i + 3] * scale); \
            w.y = cvt4_fp8(v[8 * i + 4] * scale, v[8 * i + 5] * scale, v[8 * i + 6] * scale, v[8 * i + 7] * scale); \
            *(LAS u32x2*)(scr + lane * 136 + (b) * 32 + i * 8) = w; } } \
        else { _Pragma("unroll") for (int i = 0; i < 8; ++i) { u32x2 w; w.x = cvt_pk_bf16(v[4 * i + 0], v[4 * i + 1]); w.y = cvt_pk_bf16(v[4 * i + 2], v[4 * i + 3]); \
            *(LAS u32x2*)(scr + lane * 136 + (b) * 64 + i * 8) = w; } } } while (0)
    CT_LOAD(va, 0);
#pragma unroll
    for (int b = 0; b < NB; b += 2) {
        CT_LOAD(vb, b + 1);
        __builtin_amdgcn_sched_barrier(0);
        CT_CONV(va, b);
        if (b + 2 < NB) CT_LOAD(va, b + 2);
        __builtin_amdgcn_sched_barrier(0);
        CT_CONV(vb, b + 1);
    }
#undef CT_LOAD
#undef CT_CONV
    LDS_WAIT();
#pragma unroll
    for (int it = 0; it < 8; ++it) { const int id = it * 64 + lane, n = id >> 3, c = id & 7;
        const u32x2 a = *(const LAS u32x2*)(scr + n * 136 + c * 16), b = *(const LAS u32x2*)(scr + n * 136 + c * 16 + 8);
        u32x4 o; o.x = a.x; o.y = a.y; o.z = b.x; o.w = b.y;
        *(u32x4*)(dst + (size_t)n * dpitch + c * 16) = o; }
    LDS_WAIT();
}

struct F8Tile { const float* src; unsigned char* dst; int ld, dpitch, drow, dstep; float scale; };
__device__ __forceinline__ F8Tile f8_tile(const Args& a, LAS unsigned char* lds, unsigned char* ws, int t, int lane, int wave) {
    F8Tile T;
    if (t < 640) {
        const int l = t / 160, r = t % 160, kt = r / 20, nt = r % 20, sc = 4 * lane;
        T.src = AIN(I_WIN) + (size_t)l * DM * DIN + (size_t)(kt * 256 + 32 * wave) * DIN + nt * 256 + sc; T.ld = DIN; T.scale = WIN_SCALE;
        T.dst = ws + WS_WIN + (size_t)l * DIN * DM + (size_t)(nt * 256) * DM + kt * 256; T.dpitch = DM;
        if (nt < 8) { const int d = sc & 127; T.drow = (sc & 128) + 2 * (d & 63) + (d >> 6); T.dstep = 2; } else { T.drow = sc; T.dstep = 1; }
    } else if (t < 640 + 4096) {
        t -= 640; const int le = t / 64, r = t % 64, kt = r / 8, nt = r % 8, half = lane >> 5, lc = lane & 31;
        T.src = (half ? AIN(I_EWU) : AIN(I_EWG)) + (size_t)le * DM * DEXP + (size_t)(kt * 256 + 32 * wave) * DEXP + nt * 128 + 4 * lc; T.ld = DEXP; T.scale = W1_SCALE;
        T.dst = ws + WS_W1 + (size_t)le * 2048 * DM + (size_t)(nt * 256) * DM + kt * 256; T.dpitch = DM;
        T.drow = 8 * lc + half; T.dstep = 2;
    } else if (t >= 640 + 4096 + 2048) {
        t -= 640 + 4096 + 2048; const int l = t / 64, r = t % 64, kt = r / 8, nt = r % 8;
        T.src = AIN(I_WOUT) + (size_t)l * DM * DM + (size_t)(kt * 256 + 32 * wave) * DM + nt * 256 + 4 * lane; T.ld = DM; T.scale = WOUT_SCALE;
        T.dst = ws + WS_WOUT + (size_t)l * DM * DM + (size_t)(nt * 256) * DM + kt * 256; T.dpitch = DM;
        T.drow = 4 * lane; T.dstep = 1;
    } else {
        t -= 640 + 4096; const int le = t / 32, r = t % 32, kt = r / 8, nt = r % 8;
        T.src = AIN(I_EWD) + (size_t)le * DEXP * DM + (size_t)(kt * 256 + 32 * wave) * DM + nt * 256 + 4 * lane; T.ld = DM; T.scale = W2_SCALE;
        T.dst = ws + WS_W2 + (size_t)le * DM * DEXP + (size_t)(nt * 256) * DEXP + kt * 256; T.dpitch = DEXP;
        T.drow = 4 * lane; T.dstep = 1;
    }
    return T;
}
__device__ __forceinline__ int f8_tile_of(int l, int k) { return k < 160 ? l * 160 + k : (k < 1184 ? 640 + l * 1024 + (k - 160) : (k < 1696 ? 640 + 4096 + l * 512 + (k - 1184) : 640 + 4096 + 2048 + l * 64 + (k - 1696))); }
constexpr int F8_TILES_PER_LAYER = 1760;
template <bool STEAL>
__device__ __forceinline__ void f8_convert(const Args& a, LAS unsigned char* lds, unsigned char* ws, int l, int first, int stride, int quota, unsigned* ticket, int tid, int lane, int wave) {
    volatile LAS int* word = (volatile LAS int*)(lds + MISC_OFF) + 16;
    f32x4 v[32];
    int k, n = 0;
    if constexpr (STEAL) {
        __syncthreads();
        if (tid == 0) word[0] = (quota > 0) ? (int)__hip_atomic_fetch_add(ticket, 1u, __ATOMIC_RELAXED, __HIP_MEMORY_SCOPE_AGENT) : F8_TILES_PER_LAYER;
        __syncthreads();
        k = word[0];
    } else k = first;
    F8Tile T = f8_tile(a, lds, ws, f8_tile_of(l, k < F8_TILES_PER_LAYER ? k : 0), lane, wave);
#define F8_LOADS() do { _Pragma("unroll") for (int q = 0; q < 32; ++q) v[q] = __builtin_nontemporal_load((const f32x4*)(T.src + (size_t)q * T.ld)); } while (0)
    if (k < F8_TILES_PER_LAYER) F8_LOADS();
    while (k < F8_TILES_PER_LAYER) {
        LAS unsigned char* buf = lds + (n & 1) * 65536;
        if constexpr (STEAL) { if (tid == 0) word[(n + 1) & 1] = (n + 1 < quota) ? (int)__hip_atomic_fetch_add(ticket, 1u, __ATOMIC_RELAXED, __HIP_MEMORY_SCOPE_AGENT) : F8_TILES_PER_LAYER; }
        const float sc = T.scale;
#pragma unroll
        for (int c = 0; c < 4; ++c) {
            const int R = T.drow + c * T.dstep, sw = (R >> 2) & 15;
            u32x4 lo, hi;
            lo.x = cvt4_fp8(v[0][c] * sc, v[1][c] * sc, v[2][c] * sc, v[3][c] * sc);     lo.y = cvt4_fp8(v[4][c] * sc, v[5][c] * sc, v[6][c] * sc, v[7][c] * sc);
            lo.z = cvt4_fp8(v[8][c] * sc, v[9][c] * sc, v[10][c] * sc, v[11][c] * sc);   lo.w = cvt4_fp8(v[12][c] * sc, v[13][c] * sc, v[14][c] * sc, v[15][c] * sc);
            hi.x = cvt4_fp8(v[16][c] * sc, v[17][c] * sc, v[18][c] * sc, v[19][c] * sc); hi.y = cvt4_fp8(v[20][c] * sc, v[21][c] * sc, v[22][c] * sc, v[23][c] * sc);
            hi.z = cvt4_fp8(v[24][c] * sc, v[25][c] * sc, v[26][c] * sc, v[27][c] * sc); hi.w = cvt4_fp8(v[28][c] * sc, v[29][c] * sc, v[30][c] * sc, v[31][c] * sc);
            *(LAS u32x4*)(buf + R * 256 + (((2 * wave) ^ sw) << 4)) = lo;
            *(LAS u32x4*)(buf + R * 256 + (((2 * wave + 1) ^ sw) << 4)) = hi;
        }
        __syncthreads();
        unsigned char* const dst = T.dst; const int dpitch = T.dpitch;
        int kn; if constexpr (STEAL) kn = word[(n + 1) & 1]; else kn = k + stride;
        if (kn < F8_TILES_PER_LAYER) { T = f8_tile(a, lds, ws, f8_tile_of(l, kn), lane, wave); F8_LOADS(); }
        __builtin_amdgcn_sched_barrier(0);
#pragma unroll
        for (int it = 0; it < 8; ++it) { const int id = it * NTHREADS + tid, R = id >> 4, cl = id & 15;
            const u32x4 o = *(const LAS u32x4*)(buf + R * 256 + ((cl ^ ((R >> 2) & 15)) << 4));
            __builtin_nontemporal_store(o, (u32x4*)(dst + (size_t)R * dpitch + cl * 16)); }
        k = kn; ++n;
    }
#undef F8_LOADS
    __syncthreads();
}
__device__ __forceinline__ void phase_prologue(const Args& a, LAS unsigned char* lds, int G, int tid, int lane, int wave) {
    unsigned char* ws = a.ws;
    f8_convert<false>(a, lds, ws, 0, (int)blockIdx.x, G, 0, nullptr, tid, lane, wave);
    LAS unsigned char* scr = lds + wave * 8704;
    const int gw = blockIdx.x * NWAVES + wave, NGW = G * NWAVES;
    constexpr int nB = 4 * 32 * 32, nE = 4 * 8 * 8, nF = 16 * 2 * 4;
    constexpr int NITEMS = nB + nE + nF;
    for (int it0 = gw; it0 < NITEMS; it0 += NGW) {
        int it = it0; const float* src; unsigned char* dst; int ld, dpitch;
        if (it < nB) { continue;
            const int l = it / 1024, r = it % 1024, kt = r / 32, nt = r % 32;
            src = AIN(I_WOUT) + (size_t)l * DM * DM + (size_t)(kt * 64) * DM + nt * 64 + lane; ld = DM;
            dst = ws + WS_WOUT + ((size_t)l * DM * DM + (size_t)(nt * 64) * DM + kt * 64) * 2; dpitch = DM * 2; }
        else if ((it -= nB) < nE) { const int l = it / 64, r = it % 64, kt = r / 8, nt = r % 8;
            src = AIN(I_CPW) + (size_t)l * CW * CW + (size_t)(kt * 64) * CW + nt * 64 + lane; ld = CW;
            dst = ws + WS_PW + ((size_t)l * CW * CW + (size_t)(nt * 64) * CW + kt * 64) * 2; dpitch = CW * 2; }
        else { it -= nE; const int lb = it / 8, r = it % 8, kt = r / 4, nt = r % 4, np = nt * 64 + lane;
            src = ((np < 128) ? AIN(I_RWA) : AIN(I_RWX)) + (size_t)lb * 128 * 128 + (size_t)(kt * 64) * 128 + (np & 127); ld = 128;
            dst = ws + WS_WRG + ((size_t)lb * 256 * 128 + (size_t)(nt * 64) * 128 + kt * 64) * 2; dpitch = 128 * 2; }
        cvt_tile<false>(src, ld, dst, dpitch, 1.f, scr, lane);
    }
    const int gt = blockIdx.x * NTHREADS + tid, NGT = G * NTHREADS;
    { const float* x = AIN(I_X); unsigned char* xb = ws + WS_XB;
      for (int i = gt; i < MTOK * DM / 8; i += NGT) { const f32x4 v0 = *(const f32x4*)(x + (size_t)i * 8), v1 = *(const f32x4*)(x + (size_t)i * 8 + 4);
          u32x2 w; w.x = cvt4_fp8(v0[0], v0[1], v0[2], v0[3]); w.y = cvt4_fp8(v1[0], v1[1], v1[2], v1[3]);
          *(u32x2*)(xb + (size_t)i * 8) = w;
          u32x4 h; h.x = cvt_pk_bf16(v0[0], v0[1]); h.y = cvt_pk_bf16(v0[2], v0[3]); h.z = cvt_pk_bf16(v1[0], v1[1]); h.w = cvt_pk_bf16(v1[2], v1[3]);
          *(u32x4*)((bf16_t*)(ws + WS_XA) + (size_t)i * 8) = h; } }
    { const float* rtw = AIN(I_RTW); float* img = (float*)(ws + WS_RWT);
      for (int i = gt; i < DM * NEXP; i += NGT) img[(i & 15) * 2052 + (i >> 4)] = rtw[i];
      for (int i = gt; i < 16 * 4 + 448; i += NGT) { if (i < 64) img[(i >> 2) * 2052 + 2048 + (i & 3)] = 0.f; else img[16 * 2052 + (i - 64)] = 0.f; } }
    { float* cosT = (float*)(ws + WS_COS); float* sinT = (float*)(ws + WS_SIN);
      for (int i = gt; i < SEQ * 64; i += NGT) { const int pos = i >> 6, j = i & 63;
          const float inv = exp2f(-(float)j * 0.20762050593046014f);
          const float ang = (float)pos * inv;
          const double ad = (double)ang; const double n = rint(ad * 0.15915494309189535); const float r = (float)(ad - n * 6.283185307179586);
          cosT[i] = cosf(r); sinT[i] = sinf(r); } }
    { float* sp8 = (float*)(ws + WS_SP8);
      const float* rlam = AIN(I_RLAM);
      for (int i = gt; i < NLAYER * RW; i += NGT) { const float lam = rlam[i]; sp8[i] = 8.f * log1pf(expf(-lam)); } }
}

__device__ __forceinline__ void conv_unit(const Args& a, int l, int u, LAS unsigned char* lds, int tid, int lane, int wave) {
    unsigned char* ws = opaque_p(a.ws);
    const bf16_t* Z = (const bf16_t*)(ws + WS_Z);
    LAS float* gbuf = (LAS float*)lds;
    LAS float* cbuf = gbuf + 46 * 512;
    const int c = tid, rowbase = u * 16, t0 = rowbase & (SEQ - 1);
    {
        u32x4 r1[6], r2[6];
#pragma unroll
        for (int k = 0; k < 6; ++k) { const int i = tid + 512 * k, j = i >> 6, q = i & 63; const bool ok = (i < 46 * 64) && (t0 - 30 + j >= 0);
            const size_t ro = (size_t)(rowbase - 30 + (ok ? j : 30)) * DIN + ZC_OFF + 8 * q;
            r1[k] = *(const u32x4*)(Z + ro); r2[k] = *(const u32x4*)(Z + ro + CW);
            if (!ok) { r1[k] = (u32x4){0u, 0u, 0u, 0u}; } }
#pragma unroll
        for (int k = 0; k < 6; ++k) { const int i = tid + 512 * k, j = i >> 6, q = i & 63;
            if (i < 46 * 64) { f32x4 g0, g1;
                g0[0] = bflo(r1[k].x) * sigmoidf_(bflo(r2[k].x)); g0[1] = bfhi(r1[k].x) * sigmoidf_(bfhi(r2[k].x));
                g0[2] = bflo(r1[k].y) * sigmoidf_(bflo(r2[k].y)); g0[3] = bfhi(r1[k].y) * sigmoidf_(bfhi(r2[k].y));
                g1[0] = bflo(r1[k].z) * sigmoidf_(bflo(r2[k].z)); g1[1] = bfhi(r1[k].z) * sigmoidf_(bfhi(r2[k].z));
                g1[2] = bflo(r1[k].w) * sigmoidf_(bflo(r2[k].w)); g1[3] = bfhi(r1[k].w) * sigmoidf_(bfhi(r2[k].w));
                *(LAS f32x4*)(gbuf + j * 512 + 8 * q) = g0; *(LAS f32x4*)(gbuf + j * 512 + 8 * q + 4) = g1; } }
    }
    __syncthreads();
    float w[CK]; const float* cdw = AIN(I_CDW);
#pragma unroll
    for (int j = 0; j < CK; ++j) w[j] = cdw[(size_t)l * CK * CW + j * CW + c];
    for (int t = 0; t < 16; ++t) { float acc = 0.f;
#pragma unroll
        for (int j = 0; j < CK; ++j) acc = fmaf(w[j], gbuf[(t + j) * 512 + c], acc);
        cbuf[t * 512 + c] = acc; }
    __syncthreads();
    {
        const float* lg = AIN(I_CLNG) + l * CW + lane * 8; const float* lb = AIN(I_CLNB) + l * CW + lane * 8;
        const f32x4 g0 = *(const f32x4*)lg, g1 = *(const f32x4*)(lg + 4), b0 = *(const f32x4*)lb, b1 = *(const f32x4*)(lb + 4);
        bf16_t* SC = (bf16_t*)(ws + WS_SCONV);
#pragma unroll
        for (int q = 0; q < 2; ++q) { const int tt = wave + 8 * q;
            f32x4 v0 = *(const LAS f32x4*)(cbuf + tt * 512 + lane * 8), v1 = *(const LAS f32x4*)(cbuf + tt * 512 + lane * 8 + 4);
            const float mean = wave_sum((v0[0] + v0[1]) + (v0[2] + v0[3]) + (v1[0] + v1[1]) + (v1[2] + v1[3])) * (1.f / CW);
            v0 = v0 - mean; v1 = v1 - mean;
            const float var = wave_sum((v0[0] * v0[0] + v0[1] * v0[1]) + (v0[2] * v0[2] + v0[3] * v0[3]) + (v1[0] * v1[0] + v1[1] * v1[1]) + (v1[2] * v1[2] + v1[3] * v1[3])) * (1.f / CW);
            const float rstd = __builtin_amdgcn_rsqf(var + LN_EPS);
            v0 = v0 * rstd * g0 + b0; v1 = v1 * rstd * g1 + b1;
            float y[8] = {v0[0], v0[1], v0[2], v0[3], v1[0], v1[1], v1[2], v1[3]};
#pragma unroll
            for (int k = 0; k < 8; ++k) y[k] = y[k] * sigmoidf_(y[k]);
            u32x4 o; o.x = cvt_pk_bf16(y[0], y[1]); o.y = cvt_pk_bf16(y[2], y[3]); o.z = cvt_pk_bf16(y[4], y[5]); o.w = cvt_pk_bf16(y[6], y[7]);
            *(u32x4*)(SC + (size_t)(rowbase + tt) * CW + lane * 8) = o; }
    }
    {
        const float* rcw = AIN(I_RCW) + (size_t)l * 4 * RW + c;
        const float w0 = rcw[0], w1 = rcw[RW], w2 = rcw[2 * RW], w3 = rcw[3 * RW];
        const float bias = AIN(I_RCB)[l * RW + c];
        bf16_t* XC = (bf16_t*)(ws + WS_XC);
        float xs[19];
#pragma unroll
        for (int t = 0; t < 19; ++t) { const bool ok = (t >= 3) || (t0 >= 3); xs[t] = ok ? bf2f(Z[(size_t)(rowbase - 3 + t) * DIN + ZRX_OFF + c]) : 0.f; }
#pragma unroll
        for (int t = 0; t < 16; ++t) { const float xc = fmaf(w0, xs[t], fmaf(w1, xs[t + 1], fmaf(w2, xs[t + 2], w3 * xs[t + 3]))) + bias;
            XC[(size_t)(rowbase + t) * RW + c] = (bf16_t)(cvt_pk_bf16(xc, 0.f) & 0xffffu); }
    }
    __syncthreads();
}

__device__ __forceinline__ void moe_meta(const Args& a, LAS unsigned char* lds, int tid, int l) {
    volatile LAS int* meta = (volatile LAS int*)(lds + META_OFF);
    const unsigned* fill = (const unsigned*)(opaque_p(a.ws) + WS_CTL) + CW_FILL + 64 * l;
    __syncthreads();
    if (tid < 64) {
        const int c = (tid < 16) ? (int)__hip_atomic_load(fill + (tid & 15), __ATOMIC_RELAXED, __HIP_MEMORY_SCOPE_AGENT) : 0;
        const int p = ((c + 255) >> 8) << 8;
        int sc = p;
        sc += __builtin_amdgcn_update_dpp(0, sc, 0x111, 0xf, 0xf, true); sc += __builtin_amdgcn_update_dpp(0, sc, 0x112, 0xf, 0xf, true);
        sc += __builtin_amdgcn_update_dpp(0, sc, 0x114, 0xf, 0xf, true); sc += __builtin_amdgcn_update_dpp(0, sc, 0x118, 0xf, 0xf, true);
        if (tid < 16) { meta[tid] = c; meta[16 + tid] = sc - p; }
        if (tid == 15) meta[32] = sc >> 8;
    }
    __syncthreads();
    if (tid < 80) {
        const LAS int4_t* bp = (const LAS int4_t*)(lds + META_OFF + 64);
        const int4_t b0 = bp[0], b1 = bp[1], b2 = bp[2], b3 = bp[3]; const int r = tid * 256;
        const int e = (r >= b0.y) + (r >= b0.z) + (r >= b0.w) + (r >= b1.x) + (r >= b1.y) + (r >= b1.z) + (r >= b1.w) + (r >= b2.x) + (r >= b2.y) + (r >= b2.z) + (r >= b2.w)
                    + (r >= b3.x) + (r >= b3.y) + (r >= b3.z) + (r >= b3.w);
        meta[48 + tid] = e; }
    __syncthreads();
}

__global__ void __launch_bounds__(NTHREADS, 2) hybrid_fwd(Args a) {
    extern __shared__ __attribute__((aligned(16))) unsigned char lds_raw[];
    LAS unsigned char* const lds0 = (LAS unsigned char*)lds_raw;
    LAS unsigned char* lds = lds0;
    volatile LAS unsigned* MISC = (volatile LAS unsigned*)(lds + MISC_OFF);
    const int wid0 = __builtin_amdgcn_readfirstlane((int)threadIdx.x >> 6);
    const int tid = tidx(wid0), lane = tid & 63, wave = wid0;
    const int G = gridDim.x;
    unsigned char* ws = a.ws;
    unsigned* ctl = (unsigned*)(ws + WS_CTL);
    if (tid < 32) MISC[tid] = 0u;
    if (tid == 0) {
#pragma unroll
        for (int k = 0; k < 28; ++k) ((volatile LAS unsigned long long*)(lds + PTAB_OFF))[k] = (unsigned long long)a.in[k];
    }
    __syncthreads();
#if N_LAUNCH_MODE == 1
    if (blockIdx.x == 0) {
        u32x4* z = (u32x4*)ctl;
        for (int i = tid; i < 4096; i += NTHREADS) if (i != CW_FLAG / 4) z[i] = (u32x4){0u, 0u, 0u, 0u};
        asm volatile("s_waitcnt vmcnt(0)" ::: "memory");
        __syncthreads();
        if (tid == 0) { __builtin_amdgcn_fence(__ATOMIC_RELEASE, "agent"); __hip_atomic_store(ctl + CW_FLAG, CTL_MAGIC, __ATOMIC_RELAXED, __HIP_MEMORY_SCOPE_AGENT); }
    }
#endif
    const int lo = a.ph_lo, hi = a.ph_hi;
#ifndef ONLY_PH
#define ONLY_PH -1
#endif
#define PHEN(p) (ONLY_PH < 0 || ONLY_PH == (p))
#ifndef REPEAT_MASK
#define REPEAT_MASK 0
#endif
#define NREP(p) (((REPEAT_MASK >> (p)) & 1) ? 2 : 1)
#define IN(k) (lo <= (k) && (k) < hi)
#ifndef SEAM_REP
#define SEAM_REP 1
#endif
#define SEAM(k) do { if (IN(k) && IN((k) + 1)) for (int _r = 0; _r < SEAM_REP; ++_r) xcd_barrier(bar, wid0); } while (0)
    const int gw = blockIdx.x * NWAVES + wave, NGW = G * NWAVES;

    if (PHEN(0) && IN(0)) for (int rep = 0; rep < NREP(0); ++rep) { phase_prologue(a, lds, G, tid, lane, wave); __syncthreads(); }
#if N_LAUNCH_MODE == 1
    if (tid == 0 && blockIdx.x != 0) { unsigned sp = 0u;
        while (__hip_atomic_load(ctl + CW_FLAG, __ATOMIC_RELAXED, __HIP_MEMORY_SCOPE_AGENT) != CTL_MAGIC) { __builtin_amdgcn_s_sleep(2); if (++sp > (1u << 22)) break; }
        __builtin_amdgcn_fence(__ATOMIC_ACQUIRE, "agent"); asm volatile("s_waitcnt vmcnt(0)" ::: "memory"); }
    __syncthreads();
#endif
    XcdBarrier bar = xcd_barrier_post(ctl + CW_BAR, MISC + 8);
    SEAM(0);
#if N_LAUNCH_MODE == 1
    if (blockIdx.x == 0 && tid == 0) __hip_atomic_store(ctl + CW_FLAG, 0u, __ATOMIC_RELAXED, __HIP_MEMORY_SCOPE_AGENT);
#endif

    for (int l = 0; l < NLAYER; ++l) {
        const int pb = 1 + l * NPH;

        if (PHEN(1) && IN(pb + 0)) for (int rep = 0; rep < NREP(1); ++rep) { unsigned char* ws = opaque_p(a.ws); LAS unsigned char* lds = opaque_p(lds0); const int bid = opaque_s((int)blockIdx.x); const int tid = tidx(wid0), lane = tid & 63, wave = __builtin_amdgcn_readfirstlane(tid >> 6), gw = bid * NWAVES + wave; (void)lane; (void)gw;
            pg8::Gemm g{ws, (unsigned)WS_XB, (unsigned)(WS_WIN + (size_t)l * DIN * DM), DM / 2, DM / 2, opaque_s(DM / 2)};
            pg8::GridOrder S; S.init(MTOK, DIN, DM / 2, DM / 2, G, bid);
            EpiZ E{(bf16_t*)(ws + WS_Z), (const float*)(ws + WS_COS), (const float*)(ws + WS_SIN)};
            pg8::gemm_phase<EpiZ, pg8::GridOrder, true, true>(lds, g, S, E, wid0);
            if (l + 1 < NLAYER && G == 256 && bid >= 128)
                f8_convert<true>(a, lds, ws, l + 1, 0, 0, 2, (unsigned*)(ws + WS_CTL) + CW_TICK + 64 * (l + 1), tid, lane, wave);
        }
        SEAM(pb + 0);

        if (PHEN(2) && IN(pb + 1)) for (int rep = 0; rep < NREP(2); ++rep) { unsigned char* ws = opaque_p(a.ws); LAS unsigned char* lds = opaque_p(lds0); const int bid = opaque_s((int)blockIdx.x); const int tid = tidx(wid0), lane = tid & 63, wave = __builtin_amdgcn_readfirstlane(tid >> 6), gw = bid * NWAVES + wave; (void)lane; (void)gw;
#ifndef NO_ATT
            att::attn_phase((char*)lds, (const bf16_t*)(ws + WS_Z), (bf16_t*)(ws + WS_OC), G, (G == 256) ? ((bid & 7) * 32 + (bid >> 3)) : bid, wid0);
#endif
            __syncthreads();
#ifndef NO_CONV
            for (int u0 = bid; u0 < MTOK / 16; u0 += G) {
                const int u = (G == 256) ? ((bid & 7) * 64 + (bid >> 3) * 2 + (u0 >> 8)) : u0;
                conv_unit(a, l, u, lds, tid, lane, wave); }
#endif
        }
        SEAM(pb + 1);

        if (PHEN(3) && IN(pb + 2)) for (int rep = 0; rep < NREP(3); ++rep) { unsigned char* ws = opaque_p(a.ws); LAS unsigned char* lds = opaque_p(lds0); const int bid = opaque_s((int)blockIdx.x); const int tid = tidx(wid0), lane = tid & 63, wave = __builtin_amdgcn_readfirstlane(tid >> 6), gw = bid * NWAVES + wave; (void)lane; (void)gw;
            pg8::Gemm g{ws, (unsigned)WS_XC, (unsigned)(WS_WRG + (size_t)l * 4 * 256 * 128 * 2), RW, 128, opaque_s(128)};
            RgOrder S{G, bid};
            EpiGate E{(float*)(ws + WS_SA), (float*)(ws + WS_SB), (const bf16_t*)(ws + WS_XC), AIN(I_RBA) + l * RW, AIN(I_RBX) + l * RW, (const float*)(ws + WS_SP8) + l * RW, (float*)(ws + WS_SUMA), (float*)(ws + WS_SUMH)};
            pg8::gemm_phase<EpiGate, RgOrder, true>(lds, g, S, E, wid0);
            if (bid >= 128) {
                pg8::Gemm g2{ws, (unsigned)WS_SCONV, (unsigned)(WS_PW + (size_t)l * CW * CW * 2), CW, CW, CW};
                pg8::GridOrder S2; S2.init(MTOK, CW, CW, CW, G - 128, bid - 128);
                EpiBf16Off E2{ws + WS_CAT, DM, 1024};
                pg8::gemm_phase<EpiBf16Off, pg8::GridOrder, true>(lds, g2, S2, E2, wid0);
                if (l + 1 < NLAYER && G == 256)
                    f8_convert<true>(a, lds, ws, l + 1, 0, 0, bid >= 192 ? 2 : 1, (unsigned*)(ws + WS_CTL) + CW_TICK + 64 * (l + 1), tid, lane, wave);
            }
        }
        SEAM(pb + 2);

        if (PHEN(5) && IN(pb + 4)) for (int rep = 0; rep < NREP(5); ++rep) { unsigned char* ws = opaque_p(a.ws); LAS unsigned char* lds = opaque_p(lds0); const int bid = opaque_s((int)blockIdx.x); const int tid = tidx(wid0), lane = tid & 63, wave = __builtin_amdgcn_readfirstlane(tid >> 6), gw = bid * NWAVES + wave; (void)lane; (void)gw;
            unsigned char* CAT = ws + WS_CAT;
            {
                const float li = 0.8f - 0.6f * expf(-0.3f * (float)l);
                const float* q1 = AIN(I_LQ1) + l * 128 + lane; const float* k1 = AIN(I_LK1) + l * 128 + lane; const float* q2 = AIN(I_LQ2) + l * 128 + lane; const float* k2 = AIN(I_LK2) + l * 128 + lane;
                const float d1 = wave_sum(q1[0] * k1[0] + q1[64] * k1[64]);
                const float d2 = wave_sum(q2[0] * k2[0] + q2[64] * k2[64]);
                const float lam = expf(d1) - expf(d2) + li;
                const f32x4 sg = *(const f32x4*)(AIN(I_SUBLN) + l * 256 + lane * 4) * (1.f - li);
                const bf16_t* O0 = (const bf16_t*)(ws + WS_OC); const bf16_t* O1 = O0 + (size_t)MTOK * 1024;
                for (int row0 = gw; row0 < MTOK; row0 += 2 * NGW) {
                    f32x4 p0[2][4], p1[2][4];
#pragma unroll
                    for (int rr = 0; rr < 2; ++rr)
#pragma unroll
                        for (int h = 0; h < 4; ++h) { const int row = row0 + rr * NGW; const size_t off = (size_t)(row < MTOK ? row : row0) * 1024 + h * 256 + lane * 4;
                            const u32x2 a0 = *(const u32x2*)(O0 + off), a1 = *(const u32x2*)(O1 + off);
                            p0[rr][h] = (f32x4){bflo(a0.x), bfhi(a0.x), bflo(a0.y), bfhi(a0.y)}; p1[rr][h] = (f32x4){bflo(a1.x), bfhi(a1.x), bflo(a1.y), bfhi(a1.y)}; }
#pragma unroll
                    for (int rr = 0; rr < 2; ++rr) { const int row = row0 + rr * NGW;
                        if (row < MTOK) {
#pragma unroll
                            for (int h = 0; h < 4; ++h) {
                                const f32x4 o = p0[rr][h] - p1[rr][h] * lam;
                                const float ss = wave_sum((o[0] * o[0] + o[1] * o[1]) + (o[2] * o[2] + o[3] * o[3]));
                                const float r = __builtin_amdgcn_rsqf(ss * (1.f / 256.f) + LN_EPS);
                                const f32x4 y = o * r * sg;
                                __builtin_nontemporal_store(cvt4_fp8(y[0] * CAT_SCALE, y[1] * CAT_SCALE, y[2] * CAT_SCALE, y[3] * CAT_SCALE), (unsigned*)(CAT + (size_t)row * DM + h * 256 + lane * 4)); } } }
                }
            }
            {
                const float* SA = (const float*)(ws + WS_SA); const float* SB = (const float*)(ws + WS_SB);
                const float* sumA = (const float*)(ws + WS_SUMA); const float* sumH = (const float*)(ws + WS_SUMH);
                const bf16_t* Z = (const bf16_t*)(ws + WS_Z);
                for (int u = bid; u < MTOK / 32; u += G) {
                    const int j = u & 63; float carry = 0.f;
                    for (int jj0 = 0; jj0 < j; jj0 += 32) { float ca[32], ch[32];
#pragma unroll
                        for (int q = 0; q < 32; ++q) { const bool ok = jj0 + q < j; const int idx = (u - j + (ok ? jj0 + q : 0)) * RW + tid; ca[q] = sumA[idx]; ch[q] = sumH[idx]; if (!ok) { ca[q] = 1.f; ch[q] = 0.f; } }
#pragma unroll
                        for (int q = 0; q < 32; ++q) carry = fmaf(ca[q], carry, ch[q]); }
#pragma unroll
                    for (int hb = 0; hb < 2; ++hb) { float pa[16], hl[16], gx[16];
#pragma unroll
                        for (int t = 0; t < 16; ++t) { const size_t row = (size_t)u * 32 + hb * 16 + t; pa[t] = SA[row * RW + tid]; hl[t] = SB[row * RW + tid]; gx[t] = bf2f(Z[row * DIN + ZRG_OFF + tid]); }
#pragma unroll
                        for (int t = 0; t < 16; ++t) { const size_t row = (size_t)u * 32 + hb * 16 + t;
                            const float h = fmaf(pa[t], carry, hl[t]), x = gx[t];
                            const float y = 0.7978845608028654f * (x + 0.044715f * x * x * x);
                            const float th = 1.f - 2.f * __builtin_amdgcn_rcpf(__expf(2.f * y) + 1.f);
                            const float ge = 0.5f * x * (1.f + th);
                            const float cv = h * ge * CAT_SCALE; __builtin_nontemporal_store((unsigned char)(cvt4_fp8(cv, cv, cv, cv) & 0xffu), CAT + row * DM + 1536 + tid); } }
                }
            }
        }
        SEAM(pb + 4);

        if (PHEN(6) && IN(pb + 5)) for (int rep = 0; rep < NREP(6); ++rep) { unsigned char* ws = opaque_p(a.ws); LAS unsigned char* lds = opaque_p(lds0); const int bid = opaque_s((int)blockIdx.x); const int tid = tidx(wid0), lane = tid & 63, wave = __builtin_amdgcn_readfirstlane(tid >> 6), gw = bid * NWAVES + wave; (void)lane; (void)gw;
            pg8::Gemm g{ws, (unsigned)WS_CAT, (unsigned)(WS_WOUT + (size_t)l * DM * DM), DM / 2, DM / 2, opaque_s(DM / 2)};
            pg8::GridOrder S; S.init(MTOK, DM, DM / 2, DM / 2, G, bid);
            EpiResBf16 E{(bf16_t*)(ws + WS_YBUF), (const bf16_t*)(ws + WS_XA)};
            pg8::gemm_phase<EpiResBf16, pg8::GridOrder, true, true>(lds, g, S, E, wid0);
#ifdef DUP_P6
            { if (opaque_s(1)) pg8::gemm_phase<EpiResBf16, pg8::GridOrder, true, false, 1>(lds, g, S, E, wid0); }
#endif
        }
        SEAM(pb + 5);

        if (PHEN(7) && IN(pb + 6)) for (int rep = 0; rep < NREP(7); ++rep) { unsigned char* ws = opaque_p(a.ws); LAS unsigned char* lds = opaque_p(lds0); const int bid = opaque_s((int)blockIdx.x); const int tid = tidx(wid0), lane = tid & 63, wave = __builtin_amdgcn_readfirstlane(tid >> 6), gw = bid * NWAVES + wave; (void)lane; (void)gw;
            LAS float* rwT = (LAS float*)lds;
            LAS int* hist = (LAS int*)(lds + META_OFF);
            LAS int* ent = (LAS int*)(lds + 131328);
            {
                const unsigned char* img = ws + WS_RWT;
#pragma unroll
                for (int i = 0; i < 16; ++i) __builtin_amdgcn_global_load_lds((const unsigned*)(img + (size_t)(i * 8 + wave) * 1024 + lane * 16), (LAS unsigned*)(lds + (i * 8 + wave) * 1024), 16, 0, 0);
                if (wave == 0) __builtin_amdgcn_global_load_lds((const unsigned*)(img + (size_t)128 * 1024 + lane * 16), (LAS unsigned*)(lds + 128 * 1024), 16, 0, 0);
            }
            float rb[16]; const float* rtb = AIN(I_RTB);
#pragma unroll
            for (int e = 0; e < 16; ++e) rb[e] = rtb[e];
            const bf16_t* YB = (const bf16_t*)(ws + WS_YBUF); bf16_t* X1B = (bf16_t*)(ws + WS_X1B);
            int* tokE = (int*)(ws + WS_TOKE); int* tokP = (int*)(ws + WS_TOKS); int* lst = (int*)(ws + WS_LIST); float* lstW = (float*)(ws + WS_LISTW); unsigned char* X1F = ws + WS_XG;
            unsigned* fill = (unsigned*)(ws + WS_CTL) + CW_FILL + 64 * l;
            const float* lg = AIN(I_LN1G) + l * DM; const float* lb = AIN(I_LN1B) + l * DM;
            for (int v = bid; v < 256; v += G) {
                __syncthreads();
                if (tid < 16) hist[tid] = 0;
                __syncthreads();
                u32x2 raw[2][8];
#pragma unroll
                for (int q = 0; q < 2; ++q)
#pragma unroll
                    for (int j = 0; j < 8; ++j) raw[q][j] = __builtin_nontemporal_load((const u32x2*)(YB + (size_t)(v * 32 + wave + 8 * q) * DM + j * 256 + lane * 4));
                asm volatile("s_waitcnt vmcnt(0)" ::: "memory"); __syncthreads();
#define P7_LN(q_, ri_, YV_) do { const int row = v * 32 + wave + 8 * (q_); float s = 0.f;                                                                       \
                    _Pragma("unroll") for (int j = 0; j < 8; ++j) { const u32x2 p = raw[ri_][j]; YV_[j] = (f32x4){bflo(p.x), bfhi(p.x), bflo(p.y), bfhi(p.y)}; s += (YV_[j][0] + YV_[j][1]) + (YV_[j][2] + YV_[j][3]); } \
                    const float mean = wave_sum(s) * (1.f / DM); float s2 = 0.f;                                                                                 \
                    _Pragma("unroll") for (int j = 0; j < 8; ++j) { YV_[j] = YV_[j] - mean; s2 += (YV_[j][0] * YV_[j][0] + YV_[j][1] * YV_[j][1]) + (YV_[j][2] * YV_[j][2] + YV_[j][3] * YV_[j][3]); } \
                    const float rstd = __builtin_amdgcn_rsqf(wave_sum(s2) * (1.f / DM) + LN_EPS);                                                                \
                    const float* lgq = opaque_p(lg); const float* lbq = opaque_p(lb);     \
                    _Pragma("unroll") for (int j = 0; j < 8; ++j) { const f32x4 gg = *(const f32x4*)(lgq + j * 256 + lane * 4), bb = *(const f32x4*)(lbq + j * 256 + lane * 4); \
                        YV_[j] = YV_[j] * rstd * gg + bb;                                                                                                            \
                        u32x2 w; w.x = cvt_pk_bf16(YV_[j][0], YV_[j][1]); w.y = cvt_pk_bf16(YV_[j][2], YV_[j][3]);                                                       \
                        __builtin_nontemporal_store(w, (u32x2*)(X1B + (size_t)row * DM + j * 256 + lane * 4));                                                                            \
                        __builtin_nontemporal_store(cvt4_fp8(YV_[j][0], YV_[j][1], YV_[j][2], YV_[j][3]), (unsigned*)(X1F + (size_t)row * DM + j * 256 + lane * 4)); } } while (0)
#define P7_PICK(q_, AC_) do { float sc[16], bi[16];                                                                                                             \
                    _Pragma("unroll") for (int e = 0; e < 16; ++e) { AC_[e] = wave_sum(AC_[e]); sc[e] = sigmoidf_(AC_[e]); bi[e] = sc[e] + rb[e]; }              \
                    float bgs = -__builtin_inff(); int e1 = 0, e2 = 1; float s1 = 0.f, sv2 = 0.f;                                                                \
                    _Pragma("unroll") for (int g = 0; g < 4; ++g) {                                                                                              \
                        const float b0 = bi[4 * g], b1 = bi[4 * g + 1], b2 = bi[4 * g + 2], b3 = bi[4 * g + 3];                                                  \
                        const float t0 = sc[4 * g], t1 = sc[4 * g + 1], t2 = sc[4 * g + 2], t3 = sc[4 * g + 3];                                                  \
                        int i1 = 0; float m1 = b0, c1 = t0;                                                                                                      \
                        if (b1 > m1) { m1 = b1; i1 = 1; c1 = t1; } if (b2 > m1) { m1 = b2; i1 = 2; c1 = t2; } if (b3 > m1) { m1 = b3; i1 = 3; c1 = t3; }          \
                        int i2 = 0; float m2 = -__builtin_inff(), c2 = 0.f;                                                                                      \
                        if (i1 != 0 && b0 > m2) { m2 = b0; i2 = 0; c2 = t0; } if (i1 != 1 && b1 > m2) { m2 = b1; i2 = 1; c2 = t1; }                              \
                        if (i1 != 2 && b2 > m2) { m2 = b2; i2 = 2; c2 = t2; } if (i1 != 3 && b3 > m2) { m2 = b3; i2 = 3; c2 = t3; }                              \
                        const float gs = m1 + m2;                                                                                                                \
                        if (gs > bgs) { bgs = gs; e1 = 4 * g + i1; e2 = 4 * g + i2; s1 = c1; sv2 = c2; }                                                         \
                    }                                                                                                                                            \
                    if (lane == 0) { const float inv = 1.f / (s1 + sv2); const int rl = wave + 8 * (q_);                                                         \
                        const int r1 = __hip_atomic_fetch_add(hist + e1, 1, __ATOMIC_RELAXED, __HIP_MEMORY_SCOPE_WORKGROUP), r2 = __hip_atomic_fetch_add(hist + e2, 1, __ATOMIC_RELAXED, __HIP_MEMORY_SCOPE_WORKGROUP); \
                        ent[rl * 6 + 0] = e1; ent[rl * 6 + 1] = r1; ent[rl * 6 + 2] = __float_as_int(s1 * inv); ent[rl * 6 + 3] = e2; ent[rl * 6 + 4] = r2; ent[rl * 6 + 5] = __float_as_int(sv2 * inv); } } while (0)
#pragma unroll
                for (int qp = 0; qp < 2; ++qp) {
                    __builtin_amdgcn_sched_barrier(0);
                    f32x4 ya[8], yb[8];
                    P7_LN(2 * qp, 0, ya);
                    __builtin_amdgcn_sched_barrier(0);
                    P7_LN(2 * qp + 1, 1, yb);
                    __builtin_amdgcn_sched_barrier(0);
                    if (qp == 0) {
#pragma unroll
                        for (int q = 0; q < 2; ++q)
#pragma unroll
                            for (int j = 0; j < 8; ++j) raw[q][j] = __builtin_nontemporal_load((const u32x2*)(YB + (size_t)(v * 32 + wave + 8 * (2 + q)) * DM + j * 256 + lane * 4));
                        __builtin_amdgcn_sched_barrier(0);
                    }
                    f32x2 y2[8][4];
#pragma unroll
                    for (int j = 0; j < 8; ++j)
#pragma unroll
                        for (int c = 0; c < 4; ++c) y2[j][c] = (f32x2){ya[j][c], yb[j][c]};
                    f32x2 acc2[16];
#pragma unroll
                    for (int e = 0; e < 16; ++e) acc2[e] = (f32x2){0.f, 0.f};
#pragma unroll
                    for (int j = 0; j < 8; ++j) {
#pragma unroll
                        for (int e = 0; e < 16; ++e) { const f32x4 w = *(const LAS f32x4*)(rwT + e * 2052 + j * 256 + lane * 4);
                            acc2[e] += y2[j][0] * (f32x2){w[0], w[0]}; acc2[e] += y2[j][1] * (f32x2){w[1], w[1]};
                            acc2[e] += y2[j][2] * (f32x2){w[2], w[2]}; acc2[e] += y2[j][3] * (f32x2){w[3], w[3]}; }
                        if (j & 1) __builtin_amdgcn_sched_barrier(0);
                    }
                    float acca[16], accb[16];
#pragma unroll
                    for (int e = 0; e < 16; ++e) { acca[e] = acc2[e][0]; accb[e] = acc2[e][1]; }
                    P7_PICK(2 * qp, acca);
                    __builtin_amdgcn_sched_barrier(0);
                    P7_PICK(2 * qp + 1, accb);
                }
#undef P7_LN
#undef P7_PICK
                __syncthreads();
                if (tid < 16) hist[16 + tid] = (int)__hip_atomic_fetch_add(fill + tid, (unsigned)hist[tid], __ATOMIC_RELAXED, __HIP_MEMORY_SCOPE_AGENT);
                __syncthreads();
                if (tid < 64) { const int rl = tid >> 1, k = tid & 1, e = ent[rl * 6 + 3 * k], p = hist[16 + e] + ent[rl * 6 + 3 * k + 1], row = v * 32 + rl;
                    lst[e * MTOK + p] = row; lstW[e * MTOK + p] = __int_as_float(ent[rl * 6 + 3 * k + 2]); tokE[row * 2 + k] = e; tokP[row * 2 + k] = p; }
            }
            __syncthreads();
        }
        SEAM(pb + 6);

        if (PHEN(9) && IN(pb + 8)) for (int rep = 0; rep < NREP(9); ++rep) { unsigned char* ws = opaque_p(a.ws); LAS unsigned char* lds = opaque_p(lds0); const int bid = opaque_s((int)blockIdx.x); const int tid = tidx(wid0), lane = tid & 63, wave = __builtin_amdgcn_readfirstlane(tid >> 6), gw = bid * NWAVES + wave; (void)lane; (void)gw;
            moe_meta(a, lds, tid, l);
            volatile LAS int* meta = (volatile LAS int*)(lds + META_OFF);
            const int tot = meta[32] * 8, F = 2 * G;
            pg8::Gemm g{ws, (unsigned)WS_XG, (unsigned)(WS_W1 + (size_t)l * NEXP * 2048 * DM), DM / 2, DM / 2, opaque_s(DM / 2)};
            MoeOrder<true> S{G, bid, 0, tot < F ? tot : F, DM / 2, DM / 2, meta, (unsigned)(2048 * DM), G == 256 && tot >= 512, (const int*)(ws + WS_LIST)};
            EpiSwiGLU E{ws + WS_HB};
            pg8::gemm_phase<EpiSwiGLU, MoeOrder<true>, true, true>(lds, g, S, E, wid0);
        }
        SEAM(pb + 8);
        if (PHEN(10) && IN(pb + 9)) for (int rep = 0; rep < NREP(10); ++rep) { unsigned char* ws = opaque_p(a.ws); LAS unsigned char* lds = opaque_p(lds0); const int bid = opaque_s((int)blockIdx.x); const int tid = tidx(wid0), lane = tid & 63, wave = __builtin_amdgcn_readfirstlane(tid >> 6), gw = bid * NWAVES + wave; (void)lane; (void)gw;
#if N_LAUNCH_MODE != 1
            moe_meta(a, lds, tid, l);
#endif
            volatile LAS int* meta = (volatile LAS int*)(lds + META_OFF);
            const int tot = meta[32] * 8, F = 2 * G, R = tot > F ? tot - F : 0, done8 = (tot < F ? tot : F) & ~7;
            if (bid < R) {
                pg8::Gemm g{ws, (unsigned)WS_XG, (unsigned)(WS_W1 + (size_t)l * NEXP * 2048 * DM), DM / 2, DM / 2, opaque_s(DM / 2)};
                MoeOrder<true> S{G, bid, F, tot, DM / 2, DM / 2, meta, (unsigned)(2048 * DM), false, (const int*)(ws + WS_LIST)};
                EpiSwiGLU E{ws + WS_HB};
                pg8::gemm_phase<EpiSwiGLU, MoeOrder<true>, true, true, 1>(lds, g, S, E, wid0);
            } else {
                const int Gp = G - R; int hiB = 2 * Gp; if (hiB > done8) hiB = done8; if (hiB < 0) hiB = 0;
                pg8::Gemm g{ws, (unsigned)WS_HB, (unsigned)(WS_W2 + (size_t)l * NEXP * DM * DEXP), DEXP / 2, DEXP / 2, opaque_s(DEXP / 2)};
                MoeOrder<false> S{Gp, bid - R, 0, hiB, DEXP / 2, DEXP / 2, meta, (unsigned)(DM * DEXP), false, nullptr, ((Gp & 7) == 0 && (R & 7) == 0) ? 2 : 0};
                EpiScaleBf16 E{ws + WS_Y2, (const float*)(ws + WS_LISTW)};
                pg8::gemm_phase<EpiScaleBf16, MoeOrder<false>, true, true, 1>(lds, g, S, E, wid0);
            }
        }
        SEAM(pb + 9);
        if (PHEN(11) && IN(pb + 10)) for (int rep = 0; rep < NREP(11); ++rep) { unsigned char* ws = opaque_p(a.ws); LAS unsigned char* lds = opaque_p(lds0); const int bid = opaque_s((int)blockIdx.x); const int tid = tidx(wid0), lane = tid & 63, wave = __builtin_amdgcn_readfirstlane(tid >> 6), gw = bid * NWAVES + wave; (void)lane; (void)gw;
#if N_LAUNCH_MODE != 1
            moe_meta(a, lds, tid, l);
#endif
            volatile LAS int* meta = (volatile LAS int*)(lds + META_OFF);
            const int tot = meta[32] * 8, F = 2 * G, R = tot > F ? tot - F : 0, done8 = (tot < F ? tot : F) & ~7;
            int hiB = 2 * (G - R); if (hiB > done8) hiB = done8; if (hiB < 0) hiB = 0;
            pg8::Gemm g{ws, (unsigned)WS_HB, (unsigned)(WS_W2 + (size_t)l * NEXP * DM * DEXP), DEXP / 2, DEXP / 2, opaque_s(DEXP / 2)};
            const bool xm = (G & 7) == 0 && tot - hiB <= G;
            MoeOrder<false> S{G, bid, hiB, tot, DEXP / 2, DEXP / 2, meta, (unsigned)(DM * DEXP), false, nullptr, xm ? 1 : 0};
            EpiScaleBf16 E{ws + WS_Y2, (const float*)(ws + WS_LISTW)};
            pg8::gemm_phase<EpiScaleBf16, MoeOrder<false>, true, true>(lds, g, S, E, wid0);
            if (l + 1 < NLAYER && G == 256 && (xm ? ((bid & 7) * (G >> 3) + (bid >> 3)) : bid) >= tot - hiB)
                f8_convert<true>(a, lds, ws, l + 1, 0, 0, 1, (unsigned*)(ws + WS_CTL) + CW_TICK + 64 * (l + 1), tid, lane, wave);
        }
        SEAM(pb + 10);

        if (PHEN(12) && IN(pb + 11)) for (int rep = 0; rep < NREP(12); ++rep) { unsigned char* ws = opaque_p(a.ws); LAS unsigned char* lds = opaque_p(lds0); const int bid = opaque_s((int)blockIdx.x); const int tid = tidx(wid0), lane = tid & 63, wave = __builtin_amdgcn_readfirstlane(tid >> 6), gw = bid * NWAVES + wave; (void)lane; (void)gw;
            const bool lastl = (l == NLAYER - 1); bf16_t* XA16 = (bf16_t*)(ws + WS_XA);
            const bf16_t* X1B = (const bf16_t*)(ws + WS_X1B); const unsigned char* Y2 = ws + WS_Y2; const int* tokS = (const int*)(ws + WS_TOKS); const int* tokE = (const int*)(ws + WS_TOKE);
#if N_LAUNCH_MODE != 1
            moe_meta(a, lds, tid, l);
#endif
            volatile LAS int* meta = (volatile LAS int*)(lds + META_OFF);
            unsigned char* XB = ws + WS_XB;
            const float* lg = AIN(I_LN2G) + l * DM; const float* lb = AIN(I_LN2B) + l * DM;
            for (int row0 = gw; row0 < MTOK; row0 += 2 * NGW) {
                int sl[2][2];
#pragma unroll
                for (int rr = 0; rr < 2; ++rr) { const int row = row0 + rr * NGW; sl[rr][0] = meta[16 + tokE[row * 2]] + tokS[row * 2]; sl[rr][1] = meta[16 + tokE[row * 2 + 1]] + tokS[row * 2 + 1]; }
                u32x2 xw[2][8]; unsigned pw_[2][8], qw[2][8];
#pragma unroll
                for (int rr = 0; rr < 2; ++rr) { const int row = row0 + rr * NGW;
#pragma unroll
                    for (int j = 0; j < 8; ++j) { xw[rr][j] = __builtin_nontemporal_load((const u32x2*)(X1B + (size_t)row * DM + j * 256 + lane * 4));
                        pw_[rr][j] = __builtin_nontemporal_load((const unsigned*)(Y2 + (size_t)sl[rr][0] * DM + j * 256 + lane * 4)); qw[rr][j] = __builtin_nontemporal_load((const unsigned*)(Y2 + (size_t)sl[rr][1] * DM + j * 256 + lane * 4)); } }
#pragma unroll
                for (int rr = 0; rr < 2; ++rr) { const int row = row0 + rr * NGW;
                    f32x4 y[8]; float s = 0.f;
#pragma unroll
                    for (int j = 0; j < 8; ++j) { const u32x2 x = xw[rr][j]; const int p = (int)pw_[rr][j], q = (int)qw[rr][j];
                        const f32x2 p0 = __builtin_amdgcn_cvt_pk_f32_fp8(p, false), p1 = __builtin_amdgcn_cvt_pk_f32_fp8(p, true), q0 = __builtin_amdgcn_cvt_pk_f32_fp8(q, false), q1 = __builtin_amdgcn_cvt_pk_f32_fp8(q, true);
                        y[j][0] = bflo(x.x) * ALPHA + (p0.x + q0.x) * (1.f / Y2_SCALE); y[j][1] = bfhi(x.x) * ALPHA + (p0.y + q0.y) * (1.f / Y2_SCALE);
                        y[j][2] = bflo(x.y) * ALPHA + (p1.x + q1.x) * (1.f / Y2_SCALE); y[j][3] = bfhi(x.y) * ALPHA + (p1.y + q1.y) * (1.f / Y2_SCALE);
                        s += (y[j][0] + y[j][1]) + (y[j][2] + y[j][3]); }
                    const float mean = wave_sum(s) * (1.f / DM); float s2 = 0.f;
#pragma unroll
                    for (int j = 0; j < 8; ++j) { y[j] = y[j] - mean; s2 += (y[j][0] * y[j][0] + y[j][1] * y[j][1]) + (y[j][2] * y[j][2] + y[j][3] * y[j][3]); }
                    const float rstd = __builtin_amdgcn_rsqf(wave_sum(s2) * (1.f / DM) + LN_EPS);
#pragma unroll
                    for (int j = 0; j < 8; ++j) { const f32x4 gg = *(const f32x4*)(lg + j * 256 + lane * 4), bb = *(const f32x4*)(lb + j * 256 + lane * 4);
                        y[j] = y[j] * rstd * gg + bb;
                        if (lastl) __builtin_nontemporal_store(y[j], (f32x4*)(a.out + (size_t)row * DM + j * 256 + lane * 4));
                        else { u32x2 w; w.x = cvt_pk_bf16(y[j][0], y[j][1]); w.y = cvt_pk_bf16(y[j][2], y[j][3]); __builtin_nontemporal_store(w, (u32x2*)(XA16 + (size_t)row * DM + j * 256 + lane * 4)); }
                        if (!lastl) __builtin_nontemporal_store(cvt4_fp8(y[j][0], y[j][1], y[j][2], y[j][3]), (unsigned*)(XB + (size_t)row * DM + j * 256 + lane * 4)); }
                }
            }
            if (l + 1 < NLAYER)
                f8_convert<true>(a, lds, ws, l + 1, 0, 0, 1 << 30, (unsigned*)(ws + WS_CTL) + CW_TICK + 64 * (l + 1), tid, lane, wave);
        }
        SEAM(pb + 11);
    }
#undef IN
#undef SEAM
}

extern "C" void kernel_launch(void* const* d_in, const int* in_sizes, int n_in, void* d_out, int out_size, void* d_ws, size_t ws_size, hipStream_t stream) {
    static int grid = 0;
    if (grid == 0) {
        if (n_in != 28 || out_size != MTOK * DM || ws_size < WS_END) { fprintf(stderr, "kernel_launch: unexpected shapes (n_in %d out %d ws %zu)\n", n_in, out_size, ws_size); grid = -1; return; }
        int dev = 0, cus = 0, per_cu = 0;
        if (hipGetDevice(&dev) != hipSuccess || hipDeviceGetAttribute(&cus, hipDeviceAttributeMultiprocessorCount, dev) != hipSuccess) { grid = -1; return; }
        if (hipFuncSetAttribute((const void*)hybrid_fwd, hipFuncAttributeMaxDynamicSharedMemorySize, LDS_BYTES) != hipSuccess) { fprintf(stderr, "kernel_launch: hipFuncSetAttribute failed\n"); grid = -1; return; }
        if (hipOccupancyMaxActiveBlocksPerMultiprocessor(&per_cu, (const void*)hybrid_fwd, NTHREADS, LDS_BYTES) != hipSuccess || per_cu < 1) { fprintf(stderr, "kernel_launch: occupancy query says %d\n", per_cu); (void)hipGetLastError(); grid = -1; return; }
        grid = cus < 256 ? cus : 256;
    }
    if (grid < 0) return;
#if N_LAUNCH_MODE != 1
    (void)hipMemsetAsync((char*)d_ws + WS_CTL, 0, CTL_ZERO_BYTES, stream);
#endif
    Args a{};
    for (int i = 0; i < 28; ++i) a.in[i] = (const float*)d_in[i];
    a.out = (float*)d_out; a.ws = (unsigned char*)d_ws;
#if N_LAUNCH_MODE == 1
    a.ph_lo = 0; a.ph_hi = NPHASES;
    hipLaunchKernelGGL(hybrid_fwd, dim3(grid), dim3(NTHREADS), LDS_BYTES, stream, a);
#else
    for (int p = 0; p < NPHASES; ++p) { a.ph_lo = p; a.ph_hi = p + 1; hipLaunchKernelGGL(hybrid_fwd, dim3(grid), dim3(NTHREADS), LDS_BYTES, stream, a); }
#endif
}
```
